# Optimizing an MI355X kernel written in HIP

```python
import jax
import jax.numpy as jnp
from jax import lax
import numpy as np


D_MODEL = 1024
BATCH = 4
SEQ = 4096
DEPTH = 4

GRID_W = 64
CTX_LEN = 256
EPS = 1e-6
HG_HEADS = 4
HG_DK = 128
HG_DV = 128
HG_WIDTH = HG_HEADS * HG_DV
HG_CHUNK = 64
MLA_HEADS = 8
MLA_NOPE = 64
MLA_ROPE = 32
MLA_V = 64
MLA_Q_RANK = 384
MLA_KV_RANK = 256
MLA_WIDTH = MLA_HEADS * MLA_V
MLA_SCALE = (MLA_NOPE + MLA_ROPE) ** -0.5
Q_BLOCK = 128
ROPE_THETA = 10000.0
N_EXPERTS = 16
N_GROUPS = 4
EXPERTS_PER_GROUP = N_EXPERTS // N_GROUPS
TOP_K = 2
D_EXPERT = 512
MOE_BLOCK = 128
IN_SPLITS = (HG_HEADS * HG_DK, HG_WIDTH, HG_HEADS * HG_DK, HG_HEADS * HG_DK, HG_WIDTH,
             MLA_Q_RANK, MLA_KV_RANK + MLA_ROPE, D_MODEL, D_MODEL)
IN_DIM = sum(IN_SPLITS)

kernel_name = 'hybrid_hgrn2_mla_grouped_moe_dit'


def rmsnorm(x, g):
    xf = x.astype(jnp.float32)
    y = xf * lax.rsqrt(jnp.mean(xf * xf, axis=-1, keepdims=True) + EPS)
    return (y * g.astype(jnp.float32)).astype(x.dtype)


def modulate(h, shift, scale):
    return h * (1 + scale) + shift


def split_in(p):
    offs = [int(o) for o in np.cumsum(IN_SPLITS)[:-1]]
    return jnp.split(p, offs, axis=-1)


def to_heads(t, n_heads):
    b_, l_, w = t.shape
    return t.reshape(b_, l_, n_heads, w // n_heads).transpose(0, 2, 1, 3)


def from_heads(t):
    b_, h_, l_, d_ = t.shape
    return t.transpose(0, 2, 1, 3).reshape(b_, l_, h_ * d_)


def axial_angles(n_tok):
    rows = n_tok // GRID_W
    row = jnp.broadcast_to(jnp.arange(rows, dtype=jnp.float32)[:, None], (rows, GRID_W)).reshape(-1)
    col = jnp.broadcast_to(jnp.arange(GRID_W, dtype=jnp.float32)[None, :], (rows, GRID_W)).reshape(-1)
    axis_dim = MLA_ROPE // 2
    inv_freq = ROPE_THETA ** (-jnp.arange(0, axis_dim, 2, dtype=jnp.float32) / axis_dim)
    return row[:, None] * inv_freq, col[:, None] * inv_freq


def rotate(x, ang):
    m = ang.shape[-1]
    cos, sin = jnp.cos(ang), jnp.sin(ang)
    x1, x2 = x[..., :m], x[..., m:]
    return jnp.concatenate([x1 * cos - x2 * sin, x1 * sin + x2 * cos], axis=-1)


def rope_2d(x, ang):
    ang_r, ang_c = ang
    a = MLA_ROPE // 2
    xf = x.astype(jnp.float32)
    return jnp.concatenate([rotate(xf[..., :a], ang_r), rotate(xf[..., a:], ang_c)], axis=-1).astype(x.dtype)


def lower_bound(gamma, layer):
    p = jnp.cumsum(jax.nn.softmax(gamma.astype(jnp.float32), axis=0), axis=0)
    return (p[layer] - p[0]).reshape(HG_HEADS, 1, HG_DK)


def forget_gate(f_pre, lb):
    f = lb + (1.0 - lb) * jax.nn.sigmoid(f_pre)
    return jnp.log(f), 1.0 - f


def gla_chunk_scan(q, k, v, logf, s0):
    b_, h_, L, _ = q.shape
    dv = v.shape[-1]
    nc = L // HG_CHUNK

    def to_chunks(t):
        return jnp.moveaxis(t.reshape(b_, h_, nc, HG_CHUNK, t.shape[-1]), 2, 0)

    mask = jnp.tril(jnp.ones((HG_CHUNK, HG_CHUNK), dtype=bool))

    def step(state, inp):
        qc, kc, vc, lc = inp
        bcum = jnp.cumsum(lc, axis=2)
        o_inter = jnp.einsum('bhtk,bhkv->bhtv', qc * jnp.exp(bcum), state)
        diff = bcum[:, :, :, None, :] - bcum[:, :, None, :, :]
        decay = jnp.exp(jnp.where(mask[:, :, None], diff, -jnp.inf))
        att = jnp.einsum('bhtk,bhtsk,bhsk->bhts', qc, decay, kc)
        o = o_inter + jnp.einsum('bhts,bhsv->bhtv', att, vc)
        blast = bcum[:, :, -1:, :]
        new_state = (jnp.exp(bcum[:, :, -1, :])[..., None] * state
                     + jnp.einsum('bhsk,bhsv->bhkv', kc * jnp.exp(blast - bcum), vc))
        return new_state, o

    s_final, o = lax.scan(step, s0, (to_chunks(q), to_chunks(k), to_chunks(v), to_chunks(logf)))
    return jnp.moveaxis(o, 0, 2).reshape(b_, h_, L, dv), s_final


def hgrn2_direction(q_c, v_c, f_c, q_x, v_x, f_x, lb, reverse):
    if reverse:
        q_c, v_c, f_c, q_x, v_x, f_x = [jnp.flip(t, axis=2) for t in (q_c, v_c, f_c, q_x, v_x, f_x)]
    logf_c, k_c = forget_gate(f_c, lb)
    logf_x, k_x = forget_gate(f_x, lb)
    s0 = jnp.zeros((q_c.shape[0], HG_HEADS, HG_DK, HG_DV), jnp.float32)
    o_c, s_c = gla_chunk_scan(q_c, k_c, v_c, logf_c, s0)
    o_x, _ = gla_chunk_scan(q_x, k_x, v_x, logf_x, s_c)
    if reverse:
        o_c, o_x = jnp.flip(o_c, axis=2), jnp.flip(o_x, axis=2)
    return o_c, o_x


def hgrn2_readout(o, g, gain):
    b_, h_, L, dv = o.shape
    o = o.transpose(0, 2, 1, 3)
    o = o * lax.rsqrt(jnp.mean(o * o, axis=-1, keepdims=True) + EPS) * gain.astype(jnp.float32).reshape(h_, dv)
    return (o.reshape(b_, L, h_ * dv) * jax.nn.silu(g.astype(jnp.float32))).astype(g.dtype)


def mla_qkv(dq, dkv, q_norm_g, kv_norm_g, w_uq, w_ukv, ang):
    b_, L, _ = dq.shape
    q = (rmsnorm(dq, q_norm_g) @ w_uq).reshape(b_, L, MLA_HEADS, MLA_NOPE + MLA_ROPE).transpose(0, 2, 1, 3)
    kv = (rmsnorm(dkv[..., :MLA_KV_RANK], kv_norm_g) @ w_ukv).reshape(b_, L, MLA_HEADS, MLA_NOPE + MLA_V).transpose(0, 2, 1, 3)
    q_nope, q_pe = q[..., :MLA_NOPE], q[..., MLA_NOPE:]
    k_nope, v = kv[..., :MLA_NOPE], kv[..., MLA_NOPE:]
    k_pe = dkv[..., MLA_KV_RANK:][:, None]
    if ang is not None:
        q_pe = rope_2d(q_pe, ang)
        k_pe = rope_2d(k_pe, ang)
    q = jnp.concatenate([q_nope, q_pe], axis=-1)
    k = jnp.concatenate([k_nope, jnp.broadcast_to(k_pe, (b_, MLA_HEADS, L, MLA_ROPE))], axis=-1)
    return q, k, v


def softmax_attend(q, k, v):
    s = jnp.einsum('bhqe,bhke->bhqk', q, k, preferred_element_type=jnp.float32) * MLA_SCALE
    p = jax.nn.softmax(s, axis=-1)
    return jnp.einsum('bhqk,bhkv->bhqv', p.astype(v.dtype), v)


def blocked_attend(q, k, v):
    b_, h_, L, e = q.shape
    nb = L // Q_BLOCK
    qb = jnp.moveaxis(q.reshape(b_, h_, nb, Q_BLOCK, e), 2, 0)
    o = lax.map(lambda qq: softmax_attend(qq, k, v), qb)
    return jnp.moveaxis(o, 0, 2).reshape(b_, h_, L, v.shape[-1])


def merge_branches(a, m, gate_a, gate_b, w_pa, w_pb, w_o):
    mixed = jax.nn.sigmoid(gate_a) * (a @ w_pa) + jax.nn.sigmoid(gate_b) * (m @ w_pb)
    return mixed @ w_o


def token_mixer(hc, hx, ang, lb_f, lb_b, w_in, hg_norm_g, q_norm_g, kv_norm_g, w_uq, w_ukv, w_pa, w_pb, w_o, need_ctx):
    qc, ic, ffc, fbc, gc, dqc, dkvc, gac, gbc = split_in(hc @ w_in)
    qx, ix, ffx, fbx, gx, dqx, dkvx, gax, gbx = split_in(hx @ w_in)
    hg = lambda t: to_heads(t, HG_HEADS).astype(jnp.float32)
    qc4, ic4, qx4, ix4 = hg(qc), hg(ic), hg(qx), hg(ix)
    ocf, oxf = hgrn2_direction(qc4, ic4, hg(ffc), qx4, ix4, hg(ffx), lb_f, False)
    ocb, oxb = hgrn2_direction(qc4, ic4, hg(fbc), qx4, ix4, hg(fbx), lb_b, True)
    a_x = hgrn2_readout(oxf + oxb, gx, hg_norm_g)
    q_c, k_c, v_c = mla_qkv(dqc, dkvc, q_norm_g, kv_norm_g, w_uq, w_ukv, None)
    q_x, k_x, v_x = mla_qkv(dqx, dkvx, q_norm_g, kv_norm_g, w_uq, w_ukv, ang)
    m_x = from_heads(blocked_attend(q_x, jnp.concatenate([k_c, k_x], axis=2), jnp.concatenate([v_c, v_x], axis=2)))
    y_x = merge_branches(a_x, m_x, gax, gbx, w_pa, w_pb, w_o)
    if not need_ctx:
        return None, y_x
    a_c = hgrn2_readout(ocf + ocb, gc, hg_norm_g)
    m_c = from_heads(softmax_attend(q_c, k_c, v_c))
    y_c = merge_branches(a_c, m_c, gac, gbc, w_pa, w_pb, w_o)
    return y_c, y_x


def moe_ffn(h, w_router, router_bias, w_gate, w_up, w_down):
    n, d = h.shape
    scores = jax.nn.sigmoid(jnp.dot(h, w_router, preferred_element_type=jnp.float32))
    sel = (scores + router_bias.astype(jnp.float32)).reshape(n, N_GROUPS, EXPERTS_PER_GROUP)
    group_score = lax.top_k(sel, TOP_K)[0].sum(-1)
    g_idx = jnp.argmax(group_score, axis=-1).astype(jnp.int32)
    in_group = jnp.take_along_axis(sel, g_idx[:, None, None], axis=1)[:, 0]
    _, local = lax.top_k(in_group, TOP_K)
    experts = g_idx[:, None] * EXPERTS_PER_GROUP + local
    wts = jnp.take_along_axis(scores, experts, axis=1)
    wts = wts / jnp.sum(wts, axis=-1, keepdims=True)
    n_assign = n * TOP_K
    e_flat = experts.reshape(-1)
    tok = jnp.repeat(jnp.arange(n, dtype=jnp.int32), TOP_K)
    order = jnp.argsort(e_flat)
    e_s, tok_s, w_s = e_flat[order], tok[order], wts.reshape(-1)[order]
    counts = jnp.zeros((N_EXPERTS,), jnp.int32).at[e_flat].add(1)
    starts = jnp.cumsum(counts) - counts
    padded = (counts + MOE_BLOCK - 1) // MOE_BLOCK * MOE_BLOCK
    pad_ends = jnp.cumsum(padded)
    pad_starts = pad_ends - padded
    dest = pad_starts[e_s] + jnp.arange(n_assign, dtype=jnp.int32) - starts[e_s]
    n_blocks = -(-n_assign // MOE_BLOCK) + N_EXPERTS
    buf = jnp.zeros((n_blocks * MOE_BLOCK, d), h.dtype).at[dest].set(h[tok_s])
    block_expert = jnp.minimum(
        jnp.searchsorted(pad_ends, jnp.arange(n_blocks, dtype=jnp.int32) * MOE_BLOCK, side='right'),
        N_EXPERTS - 1)

    def expert_block(args):
        xb, e = args
        return (jax.nn.silu(xb @ w_gate[e]) * (xb @ w_up[e])) @ w_down[e]

    yb = lax.map(expert_block, (buf.reshape(n_blocks, MOE_BLOCK, d), block_expert))
    y = yb.reshape(-1, d)[dest] * w_s[:, None].astype(h.dtype)
    return jnp.zeros_like(h).at[tok_s].add(y)


def setup_inputs(seed: int = 0) -> dict:
    key = jax.random.key(seed)
    ks = jax.random.split(key, 25)
    nrm = lambda k, shape, scale: jax.random.normal(k, shape, jnp.float32) * scale
    gain = lambda k, shape: 1.0 + 0.1 * jax.random.normal(k, shape, jnp.float32)
    return {
        'x': nrm(ks[0], (BATCH, SEQ, D_MODEL), 1.0),
        'c': nrm(ks[1], (BATCH, D_MODEL), 1.0),
        'ctx': nrm(ks[2], (BATCH, CTX_LEN, D_MODEL), 1.0),
        'c_ctx': nrm(ks[3], (D_MODEL,), 1.0),
        'w_mod': nrm(ks[4], (DEPTH, D_MODEL, 6 * D_MODEL), 0.5 * D_MODEL ** -0.5),
        'b_mod': nrm(ks[5], (DEPTH, 6 * D_MODEL), 0.02),
        'norm1_g': gain(ks[6], (DEPTH, D_MODEL)),
        'norm2_g': gain(ks[7], (DEPTH, D_MODEL)),
        'w_in': nrm(ks[8], (DEPTH, D_MODEL, IN_DIM), D_MODEL ** -0.5),
        'gamma_fwd': nrm(ks[9], (DEPTH, HG_HEADS * HG_DK), 1.0),
        'gamma_bwd': nrm(ks[10], (DEPTH, HG_HEADS * HG_DK), 1.0),
        'hg_norm_g': gain(ks[11], (DEPTH, HG_WIDTH)),
        'q_norm_g': gain(ks[12], (DEPTH, MLA_Q_RANK)),
        'kv_norm_g': gain(ks[13], (DEPTH, MLA_KV_RANK)),
        'w_uq': nrm(ks[14], (DEPTH, MLA_Q_RANK, MLA_HEADS * (MLA_NOPE + MLA_ROPE)), MLA_Q_RANK ** -0.5),
        'w_ukv': nrm(ks[15], (DEPTH, MLA_KV_RANK, MLA_HEADS * (MLA_NOPE + MLA_V)), MLA_KV_RANK ** -0.5),
        'w_pa': nrm(ks[16], (DEPTH, HG_WIDTH, D_MODEL), HG_WIDTH ** -0.5),
        'w_pb': nrm(ks[17], (DEPTH, MLA_WIDTH, D_MODEL), MLA_WIDTH ** -0.5),
        'w_o': nrm(ks[18], (DEPTH, D_MODEL, D_MODEL), D_MODEL ** -0.5),
        'w_router': nrm(ks[19], (D_MODEL, N_EXPERTS), D_MODEL ** -0.5),
        'router_bias': nrm(ks[20], (N_EXPERTS,), 0.01),
        'w_gate_e': nrm(ks[21], (DEPTH, N_EXPERTS, D_MODEL, D_EXPERT), D_MODEL ** -0.5),
        'w_up_e': nrm(ks[22], (DEPTH, N_EXPERTS, D_MODEL, D_EXPERT), D_MODEL ** -0.5),
        'w_down_e': nrm(ks[23], (DEPTH, N_EXPERTS, D_EXPERT, D_MODEL), D_EXPERT ** -0.5),
        'final_g': gain(ks[24], (D_MODEL,)),
    }


def reference(x, c, ctx, c_ctx, w_mod, b_mod, norm1_g, norm2_g, w_in, gamma_fwd, gamma_bwd, hg_norm_g,
              q_norm_g, kv_norm_g, w_uq, w_ukv, w_pa, w_pb, w_o, w_router, router_bias,
              w_gate_e, w_up_e, w_down_e, final_g):
    b_, n_lat, d = x.shape
    n_ctx = ctx.shape[1]
    ang = axial_angles(n_lat)
    zx, zc = x, ctx
    for l in range(DEPTH):
        last = l == DEPTH - 1
        mx = jnp.split(jax.nn.silu(c) @ w_mod[l] + b_mod[l], 6, axis=-1)
        mc = jnp.split(jax.nn.silu(c_ctx) @ w_mod[l] + b_mod[l], 6, axis=-1)
        hx = modulate(rmsnorm(zx, norm1_g[l]), mx[0][:, None], mx[1][:, None])
        hc = modulate(rmsnorm(zc, norm1_g[l]), mc[0], mc[1])
        yc, yx = token_mixer(hc, hx, ang, lower_bound(gamma_fwd, l), lower_bound(gamma_bwd, l), w_in[l],
                             hg_norm_g[l], q_norm_g[l], kv_norm_g[l], w_uq[l], w_ukv[l], w_pa[l], w_pb[l], w_o[l],
                             not last)
        zx = zx + mx[2][:, None] * yx
        hx = modulate(rmsnorm(zx, norm2_g[l]), mx[3][:, None], mx[4][:, None])
        if last:
            fx = moe_ffn(hx.reshape(-1, d), w_router, router_bias, w_gate_e[l], w_up_e[l], w_down_e[l]).reshape(b_, n_lat, d)
        else:
            zc = zc + mc[2] * yc
            hc = modulate(rmsnorm(zc, norm2_g[l]), mc[3], mc[4])
            f = moe_ffn(jnp.concatenate([hc, hx], axis=1).reshape(-1, d), w_router, router_bias,
                        w_gate_e[l], w_up_e[l], w_down_e[l]).reshape(b_, n_ctx + n_lat, d)
            zc = zc + mc[5] * f[:, :n_ctx]
            fx = f[:, n_ctx:]
        zx = zx + mx[5][:, None] * fx
    return rmsnorm(zx, final_g)
```

```cpp
#include <hip/hip_runtime.h>
#include <cstdio>
#include <cstdint>
#ifndef MK_PER_PHASE
#define MK_PER_PHASE 0
#endif
#define GAS __attribute__((address_space(1)))
#define LAS __attribute__((address_space(3)))
constexpr int D = 1024, NB = 4, SEQ = 4096, CTX = 256, TPB = CTX + SEQ  , M = NB * TPB  , DEPTH = 4;
constexpr int IN_DIM = 5280, INP = 5376;
constexpr int C_Q = 0, C_I = 512, C_FF = 1024, C_FB = 1536, C_G = 2048, C_DQ = 2560, C_DKV = 2944, C_KPE = 3200, C_GA = 3232, C_GB = 4256;
constexpr int NE = 16, DE = 512, XROWS = 38912;
constexpr float EPS = 1e-6f;
constexpr size_t MiB = 1u << 20;
constexpr size_t WS_CTL = 0, CTL_ZERO_BYTES = 1 * MiB;
constexpr size_t WS_MOD = 1 * MiB;
constexpr size_t WS_LBT = WS_MOD + 512 * 1024;
constexpr size_t WS_ROPE = WS_LBT + 16 * 1024;
constexpr size_t WS_HIST = WS_ROPE + 4096;
constexpr size_t WS_TILE = WS_HIST + 16384;
constexpr size_t WS_ROUTE = 2 * MiB;
constexpr size_t WS_SLOT = 3 * MiB;
constexpr size_t WS_SD = 3 * MiB + 512 * 1024;
constexpr size_t WS_ST = 136 * MiB;
constexpr size_t WS_W = 4 * MiB, WS_W2 = 517 * MiB;
constexpr size_t W_IN = 0, W_UQ = W_IN + (size_t)INP * 1024 * 2, W_UKV = W_UQ + 768 * 384 * 2, W_PA = W_UKV + 1024 * 256 * 2, W_PB = W_PA + 1024 * 512 * 2,
                 W_O = W_PB + 1024 * 512 * 2, W_GU = W_O + 1024 * 1024 * 2, W_DN = W_GU + (size_t)16 * 1024 * 1024 * 2, W_END = W_DN + (size_t)16 * 1024 * 512 * 2;
static_assert(W_END <= 64 * MiB, "weights");
constexpr size_t WS_Z = 68 * MiB;
constexpr size_t WS_H = 136 * MiB;
constexpr size_t WS_P = 170 * MiB;
constexpr size_t WS_DQN = 349 * MiB, WS_DKVN = 362 * MiB;
constexpr size_t WS_XP = 170 * MiB, WS_HID = 246 * MiB, WS_Y = 284 * MiB;
constexpr int ROWCAP = 2 * M;
constexpr size_t WS_Q = 380 * MiB, WS_K = 406 * MiB, WS_V = 432 * MiB;
constexpr size_t WS_MIX = 380 * MiB;
constexpr size_t WS_OF = 449 * MiB, WS_OB = 466 * MiB;
constexpr size_t WS_A = 483 * MiB, WS_MO = 500 * MiB;
constexpr size_t WS_END = 581 * MiB;
static_assert(WS_P + (size_t)M * INP * 2 <= WS_DQN && WS_DQN + (size_t)M * 384 * 2 <= WS_DKVN && WS_DKVN + (size_t)M * 256 * 2 <= WS_Q, "R1 mixer view");
static_assert(WS_XP + (size_t)XROWS * 2048 <= WS_HID && WS_HID + (size_t)XROWS * 1024 <= WS_Y && WS_Y + (size_t)XROWS * 2048 <= WS_Q, "R1 moe view");
static_assert(WS_Q + (size_t)32 * TPB * 192 <= WS_K && WS_K + (size_t)32 * TPB * 192 <= WS_V && WS_V + (size_t)32 * TPB * 128 <= WS_OF && WS_MIX + (size_t)M * 2048 <= WS_V, "qkv");
static_assert(WS_OF + (size_t)M * 1024 <= WS_OB && WS_OB + (size_t)M * 1024 <= WS_A && WS_A + (size_t)M * 1024 <= WS_MO && WS_MO + (size_t)M * 1024 <= WS_W2 && WS_W2 + W_END <= WS_END, "tail");
namespace pg8 {
#define PG8_LAS __attribute__((address_space(3)))
typedef unsigned short bf16_t;
typedef short bf16x8 __attribute__((ext_vector_type(8)));
typedef float f32x4 __attribute__((ext_vector_type(4)));
typedef unsigned u32x4 __attribute__((ext_vector_type(4)));
constexpr int BM = 256, BK = 64, HALF = 128, HTB = HALF * BK * 2  , STAGE_BYTES = 8 * HTB, NXCD = 8, WGM = 8;

__host__ __device__ __forceinline__ int lds_byte(int r, int c) { const int st = (r >> 4) * 2 + (c >> 5), rr = r & 15, cc = c & 31, ob = rr * 64 + cc * 2; return st * 1024 + (ob ^ (((ob >> 9) & 1) << 5)); }
__host__ __device__ __forceinline__ void stage_rc(int b, int& R, int& C) { const int st = b / 1024, sb = b % 1024, swz = sb ^ (((sb >> 9) & 1) << 5); R = (st >> 1) * 16 + swz / 64; C = (st & 1) * 32 + (swz % 64) / 2; }
__host__ __device__ __forceinline__ int perm32(int rho) { const int n = rho >> 4, i = rho & 15; return 8 * (i >> 2) + 4 * n + (i & 3); }

struct Unit { int pm, pn, pb; };
struct Gemm { const bf16_t* A; const bf16_t* Bt; int M, N, K; };

struct StaticOrder {
    static constexpr bool GATHER = false;
    int nM, nN, nwg, G, c, lat;
    __host__ __device__ void init(int M, int N, int G_, int c_, int lat_ = 0) { lat = lat_; nM = lat_ ? 64 : M / BM; nN = N / BM; nwg = nM * nN; G = G_; c = c_; }
    __host__ __device__ bool next(int i, Unit& u) const {
        const long L = (long)i * G + c; if (L >= nwg) return false;
        int wgid = (int)L; { const int q = nwg / NXCD, r = nwg % NXCD, xcd = wgid % NXCD, off = wgid / NXCD; wgid = (xcd < r ? xcd * (q + 1) : r * (q + 1) + (xcd - r) * q) + off; }
        const int nig = WGM * nN, gid = wgid / nig, fm = gid * WGM, gsz = (nM - fm) < WGM ? (nM - fm) : WGM;
        u.pm = fm + ((wgid % nig) % gsz); u.pn = (wgid % nig) / gsz; u.pb = u.pn; if (lat) u.pm = (u.pm >> 4) * 17 + 1 + (u.pm & 15); return true;
    }
    __device__ __forceinline__ void a_ready(const Unit&) const {}
    __device__ __forceinline__ void done(const Unit&) const {}
};

typedef float f32x2 __attribute__((ext_vector_type(2)));
__device__ __forceinline__ unsigned cvt_pk_bf16(float lo, float hi) { unsigned r; asm volatile("v_cvt_pk_bf16_f32 %0, %1, %2" : "=v"(r) : "v"(lo), "v"(hi)); return r; }
__device__ __forceinline__ u32x4 pack8(f32x4 v0, f32x4 v1) { u32x4 w; w.x = cvt_pk_bf16(v0[0], v0[1]); w.y = cvt_pk_bf16(v0[2], v0[3]); w.z = cvt_pk_bf16(v1[0], v1[1]); w.w = cvt_pk_bf16(v1[2], v1[3]); return w; }
__device__ __forceinline__ float bf_lo(unsigned u) { return __uint_as_float(u << 16); }
__device__ __forceinline__ float bf_hi(unsigned u) { return __uint_as_float(u & 0xffff0000u); }
__device__ __forceinline__ void unpack8(u32x4 w, f32x4& v0, f32x4& v1) { v0 = (f32x4){bf_lo(w.x), bf_hi(w.x), bf_lo(w.y), bf_hi(w.y)}; v1 = (f32x4){bf_lo(w.z), bf_hi(w.z), bf_lo(w.w), bf_hi(w.w)}; }
__device__ __forceinline__ float sigmoidf_(float x) { return __builtin_amdgcn_rcpf(1.0f + __expf(-x)); }
__device__ __forceinline__ f32x4 sigmoid4(f32x4 x) { return (f32x4){sigmoidf_(x[0]), sigmoidf_(x[1]), sigmoidf_(x[2]), sigmoidf_(x[3])}; }

struct EpiStore { static constexpr bool PERM = true, AFTER_DRAIN = false; bf16_t* O; int ldc;
    __device__ __forceinline__ void operator()(const f32x4 (&acc)[2][2][4][2], const Unit& u, int wr, int wc, int fr, int fq) const {
        const int row0 = u.pm * BM + wr * 64 + fr, col0 = u.pn * BM + wc * 32 + 8 * fq;
#pragma unroll
        for (int ai = 0; ai < 2; ++ai)
#pragma unroll
            for (int m = 0; m < 4; ++m) { bf16_t* rowp = O + (size_t)(row0 + ai * HALF + m * 16) * ldc + col0;
#pragma unroll
                for (int bj = 0; bj < 2; ++bj) *(u32x4*)(rowp + bj * HALF) = pack8(acc[ai][bj][m][0], acc[ai][bj][m][1]); }
    }
};
constexpr float QSC = 0.10206207261596575f * 1.4426950408889634f;
struct EpiQ { static constexpr bool PERM = true, AFTER_DRAIN = false; bf16_t* Q; const float* rope;
    __device__ __forceinline__ void operator()(const f32x4 (&acc)[2][2][4][2], const Unit& u, int wr, int wc, int fr, int fq) const {
        const int b = u.pm / 17, tt = (u.pm % 17) * 256 + wr * 64 + fr; const bool lat = (u.pm % 17) != 0;
        const int n0 = u.pn * BM + wc * 32 + 8 * fq, n1 = n0 + HALF, h0 = n0 / 96, e0 = n0 - h0 * 96, h1 = n1 / 96, e1 = n1 - h1 * 96;
        bf16_t* base0 = Q + (size_t)(b * 8 + h0) * TPB * 96 + e0; bf16_t* base1 = Q + (size_t)(b * 8 + h1) * TPB * 96 + e1;
        const bool rp0 = lat && e0 >= 64, rp1 = lat && e1 >= 64; const int ax0 = (e0 - 64) >> 4, ax1 = (e1 - 64) >> 4;
        const float* r0 = rope + (((e0 - 64) & 15) >> 1) * 2; const float* r1 = rope + (((e1 - 64) & 15) >> 1) * 2;
#pragma unroll
        for (int ai = 0; ai < 2; ++ai)
#pragma unroll
            for (int m = 0; m < 4; ++m) { const int t = tt + ai * HALF + m * 16, p = t - 256;
                { f32x4 v0 = acc[ai][0][m][0], v1 = acc[ai][0][m][1];
                  if (rp0) { const int pos = ax0 ? (p & 63) : (p >> 6); const f32x4 c0 = *(const f32x4*)(r0 + pos * 16), c1 = *(const f32x4*)(r0 + pos * 16 + 4);
                      v0 = (f32x4){v0[0] * c0[0] - v0[1] * c0[1], v0[0] * c0[1] + v0[1] * c0[0], v0[2] * c0[2] - v0[3] * c0[3], v0[2] * c0[3] + v0[3] * c0[2]};
                      v1 = (f32x4){v1[0] * c1[0] - v1[1] * c1[1], v1[0] * c1[1] + v1[1] * c1[0], v1[2] * c1[2] - v1[3] * c1[3], v1[2] * c1[3] + v1[3] * c1[2]}; }
                  *(u32x4*)(base0 + (size_t)t * 96) = pack8(v0 * QSC, v1 * QSC); }
                { f32x4 v0 = acc[ai][1][m][0], v1 = acc[ai][1][m][1];
                  if (rp1) { const int pos = ax1 ? (p & 63) : (p >> 6); const f32x4 c0 = *(const f32x4*)(r1 + pos * 16), c1 = *(const f32x4*)(r1 + pos * 16 + 4);
                      v0 = (f32x4){v0[0] * c0[0] - v0[1] * c0[1], v0[0] * c0[1] + v0[1] * c0[0], v0[2] * c0[2] - v0[3] * c0[3], v0[2] * c0[3] + v0[3] * c0[2]};
                      v1 = (f32x4){v1[0] * c1[0] - v1[1] * c1[1], v1[0] * c1[1] + v1[1] * c1[0], v1[2] * c1[2] - v1[3] * c1[3], v1[2] * c1[3] + v1[3] * c1[2]}; }
                  *(u32x4*)(base1 + (size_t)t * 96) = pack8(v0 * QSC, v1 * QSC); }
                asm volatile("" ::: "memory"); }
    }
};
struct EpiKV { static constexpr bool PERM = true, AFTER_DRAIN = false; bf16_t* K; bf16_t* V;
    __device__ __forceinline__ void operator()(const f32x4 (&acc)[2][2][4][2], const Unit& u, int wr, int wc, int fr, int fq) const {
        const int b = u.pm / 17, tt = (u.pm % 17) * 256 + wr * 64 + fr, j0 = wc * 32 + 8 * fq;
#pragma unroll
        for (int bj = 0; bj < 2; ++bj) { const int h = 2 * u.pn + bj; const size_t hb = (size_t)(b * 8 + h) * TPB;
            bf16_t* base = (wc < 2) ? (K + hb * 96 + j0) : (V + hb * 64 + (j0 - 64)); const int pitch = (wc < 2) ? 96 : 64;
#pragma unroll
            for (int ai = 0; ai < 2; ++ai)
#pragma unroll
                for (int m = 0; m < 4; ++m) { const int t = tt + ai * HALF + m * 16; *(u32x4*)(base + (size_t)t * pitch) = pack8(acc[ai][bj][m][0], acc[ai][bj][m][1]); asm volatile("" ::: "memory"); } }
    }
};
template <bool ADD> struct EpiMerge { static constexpr bool PERM = true, AFTER_DRAIN = false, HAS_MID = false; const bf16_t* P; int gcol; bf16_t* MIX;
    __device__ __forceinline__ void operator()(const f32x4 (&acc)[2][2][4][2], const Unit& u, int wr, int wc, int fr, int fq) const {
        const int row0 = u.pm * BM + wr * 64 + fr, col0 = u.pn * BM + wc * 32 + 8 * fq;
#pragma unroll
        for (int ai = 0; ai < 2; ++ai) { u32x4 gt[4][2], mx[4][2];
#pragma unroll
            for (int m = 0; m < 4; ++m)
#pragma unroll
                for (int bj = 0; bj < 2; ++bj) { const int row = row0 + ai * HALF + m * 16, col = col0 + bj * HALF; gt[m][bj] = *(const u32x4*)(P + (size_t)row * INP + gcol + col); if (ADD) mx[m][bj] = *(const u32x4*)(MIX + (size_t)row * 1024 + col); }
#pragma unroll
            for (int m = 0; m < 4; ++m)
#pragma unroll
                for (int bj = 0; bj < 2; ++bj) { const int row = row0 + ai * HALF + m * 16, col = col0 + bj * HALF; f32x4 g0, g1; unpack8(gt[m][bj], g0, g1);
                    f32x4 v0 = sigmoid4(g0) * acc[ai][bj][m][0], v1 = sigmoid4(g1) * acc[ai][bj][m][1];
                    if (ADD) { f32x4 o0, o1; unpack8(mx[m][bj], o0, o1); v0 += o0; v1 += o1; }
                    *(u32x4*)(MIX + (size_t)row * 1024 + col) = pack8(v0, v1); }
            asm volatile("" ::: "memory"); }
    }
};
struct EpiWo { static constexpr bool PERM = false, AFTER_DRAIN = false; bf16_t* Z; const float* modl;
    __device__ __forceinline__ void operator()(const f32x4 (&acc)[2][2][4][2], const Unit& u, int wr, int wc, int fr, int fq) const {
        const int row0 = u.pm * BM + wr * 64 + fr, col0 = u.pn * BM + wc * 32 + 4 * fq; const int ms = (u.pm % 17 == 0) ? 4 : u.pm / 17; const float* gate = modl + ms * 6144 + 2 * 1024;
        f32x4 gv[2][2];
#pragma unroll
        for (int bj = 0; bj < 2; ++bj)
#pragma unroll
            for (int n = 0; n < 2; ++n) gv[bj][n] = *(const f32x4*)(gate + col0 + bj * HALF + n * 16);
#pragma unroll
        for (int ai = 0; ai < 2; ++ai) { unsigned long long zo[4][2][2];
#pragma unroll
            for (int m = 0; m < 4; ++m)
#pragma unroll
                for (int bj = 0; bj < 2; ++bj)
#pragma unroll
                    for (int n = 0; n < 2; ++n) zo[m][bj][n] = *(const unsigned long long*)(Z + (size_t)(row0 + ai * HALF + m * 16) * 1024 + col0 + bj * HALF + n * 16);
#pragma unroll
            for (int m = 0; m < 4; ++m)
#pragma unroll
                for (int bj = 0; bj < 2; ++bj)
#pragma unroll
                    for (int n = 0; n < 2; ++n) { const unsigned lo = (unsigned)zo[m][bj][n], hi = (unsigned)(zo[m][bj][n] >> 32);
                        const f32x4 zn = (f32x4){bf_lo(lo), bf_hi(lo), bf_lo(hi), bf_hi(hi)} + gv[bj][n] * acc[ai][bj][m][n];
                        *(unsigned long long*)(Z + (size_t)(row0 + ai * HALF + m * 16) * 1024 + col0 + bj * HALF + n * 16) = (unsigned long long)cvt_pk_bf16(zn[0], zn[1]) | ((unsigned long long)cvt_pk_bf16(zn[2], zn[3]) << 32); }
            asm volatile("" ::: "memory"); }
    }
};
struct EpiGU { static constexpr bool PERM = true, AFTER_DRAIN = false; bf16_t* HID;
    __device__ __forceinline__ void operator()(const f32x4 (&acc)[2][2][4][2], const Unit& u, int wr, int wc, int fr, int fq) const {
        const int row0 = u.pm * BM + wr * 64 + fr, col0 = u.pn * HALF + wc * 32 + 8 * fq;
#pragma unroll
        for (int ai = 0; ai < 2; ++ai)
#pragma unroll
            for (int m = 0; m < 4; ++m) { const f32x4 g0 = acc[ai][0][m][0], g1 = acc[ai][0][m][1], u0 = acc[ai][1][m][0], u1 = acc[ai][1][m][1];
                *(u32x4*)(HID + (size_t)(row0 + ai * HALF + m * 16) * 512 + col0) = pack8(g0 * sigmoid4(g0) * u0, g1 * sigmoid4(g1) * u1); }
    }
};
struct MoeOrder { static constexpr bool GATHER = false; int nunits, G, c; const PG8_LAS int* tab;
    __device__ __forceinline__ bool next(int i, Unit& u) const { const int L = i * G + c; if (L >= nunits) return false; const int j = L >> 2; u.pm = j; u.pn = L & 3; u.pb = tab[64 + j] * 4 + (L & 3); return true; }
    __device__ __forceinline__ void a_ready(const Unit&) const {}
    __device__ __forceinline__ void done(const Unit&) const {}
};
struct MoeGatherOrder { static constexpr bool GATHER = true; int nunits, G, c; const PG8_LAS int* tab; const int* rowtok; int cap;
    __device__ __forceinline__ bool next(int i, Unit& u) const { const int L = i * G + c; if (L >= nunits) return false; const int j = L >> 2; u.pm = j; u.pn = L & 3; u.pb = tab[64 + j] * 4 + (L & 3); return true; }
    __device__ __forceinline__ void rows(const Unit& u, const int (&RA)[2], const int (&CA)[2], int K, unsigned (&v0)[2], unsigned (&v1)[2]) const {
        const int e = tab[64 + u.pm], last = tab[e] - 1, r0 = u.pm * BM - tab[16 + e]; const int* rt = rowtok + (size_t)e * cap;
#pragma unroll
        for (int i = 0; i < 2; ++i) { const int k0 = r0 + RA[i], k1 = k0 + HALF;
            v0[i] = (unsigned)rt[k0 < last ? k0 : last] * (unsigned)(K * 2) + (unsigned)(CA[i] * 2); v1[i] = (unsigned)rt[k1 < last ? k1 : last] * (unsigned)(K * 2) + (unsigned)(CA[i] * 2); } }
    __device__ __forceinline__ void a_ready(const Unit&) const {}
    __device__ __forceinline__ void done(const Unit&) const {}
};
template <class Epi, class Sched, bool ALIGN_EPI = false, bool SP2 = false>
__device__ __forceinline__ void gemm_phase(PG8_LAS unsigned char* lds, const Gemm g, const Sched& S, const Epi& E, int tid_in) {
    int tid_ = tid_in; asm volatile("" : "+v"(tid_));
    const int tid = tid_, wid = __builtin_amdgcn_readfirstlane(tid >> 6), lane = tid & 63, wr = wid >> 2, wc = wid & 3, fr = lane & 15, fq = lane >> 4;
    const int K = g.K, nt = K / BK;
    constexpr bool GATHER = Sched::GATHER; static_assert(!GATHER || SP2, "gathered A rows: SP2 loop only");
    unsigned voffA[2], voffB[2]; int RA[2], CA[2];
#pragma unroll
    for (int i = 0; i < 2; ++i) { int R, C; stage_rc(tid * 16 + i * 8192, R, C); const int Rb = Epi::PERM ? ((R & ~31) + perm32(R & 31)) : R; RA[i] = R; CA[i] = C;
        voffA[i] = (unsigned)(R * K + C) * 2u; voffB[i] = (unsigned)(Rb * K + C) * 2u; }
    unsigned vC0[2] = {voffA[0], voffA[1]}, vC1[2] = {voffA[0], voffA[1]}, vN0[2] = {voffA[0], voffA[1]}, vN1[2] = {voffA[0], voffA[1]};
    const size_t kstep = (size_t)(BK * 2);
    const size_t hstep = (size_t)HALF * K * 2;
    const size_t tstep = 2 * hstep;
    const size_t hstepA = GATHER ? (size_t)0 : hstep;
    const unsigned ldsw = (unsigned)wid * 1024u;
    const int aoff = lds_byte(wr * 64 + fr, fq * 8), boff = lds_byte(wc * 32 + fr, fq * 8);
#define PG8_SA(b, h) (((b) * 2 + (h)) * HTB)
#define PG8_SB(b, h) ((4 + (b) * 2 + (h)) * HTB)
#define PG8_STAGE(bufoff, gbase, voff) do { _Pragma("unroll") for (int _i = 0; _i < 2; ++_i) \
        __builtin_amdgcn_global_load_lds((const unsigned*)((const char*)(gbase) + (voff)[_i]), (PG8_LAS unsigned*)(lds + (bufoff) + ldsw + _i * 8192), 16, 0, 0); } while (0)
#define PG8_LDA(dst, b, h) do { _Pragma("unroll") for (int m = 0; m < 4; ++m) _Pragma("unroll") for (int k = 0; k < 2; ++k) dst[m][k] = *(const PG8_LAS bf16x8*)(lds + PG8_SA(b, h) + aoff + m * 2048 + k * 1024); } while (0)
#define PG8_LDB(dst, b, h) do { _Pragma("unroll") for (int n = 0; n < 2; ++n) _Pragma("unroll") for (int k = 0; k < 2; ++k) dst[n][k] = *(const PG8_LAS bf16x8*)(lds + PG8_SB(b, h) + boff + n * 2048 + k * 1024); } while (0)
#define PG8_MMA(ai, bj, At, Bt) do { __builtin_amdgcn_s_setprio(1); _Pragma("unroll") for (int m = 0; m < 4; ++m) _Pragma("unroll") for (int n = 0; n < 2; ++n) _Pragma("unroll") for (int k = 0; k < 2; ++k) \
        acc[ai][bj][m][n] = __builtin_amdgcn_mfma_f32_16x16x32_bf16(Bt[n][k], At[m][k], acc[ai][bj][m][n], 0, 0, 0); __builtin_amdgcn_s_setprio(0); } while (0)
#define PG8_WAIT_V(n) asm volatile("s_waitcnt vmcnt(" #n ")" ::: "memory")
#define PG8_WAIT_L(n) asm volatile("s_waitcnt lgkmcnt(" #n ")" ::: "memory")
#define PG8_BAR __builtin_amdgcn_s_barrier()
#define PG8_SCHED __builtin_amdgcn_sched_barrier(0)
    Unit cur, nxt; int ui = 0;
    if (!S.next(0, cur)) return;
    f32x4 acc[2][2][4][2];
#pragma unroll
    for (int a = 0; a < 2; ++a)
#pragma unroll
        for (int b = 0; b < 2; ++b)
#pragma unroll
            for (int m = 0; m < 4; ++m)
#pragma unroll
                for (int n = 0; n < 2; ++n) acc[a][b][m][n] = (f32x4){0.f, 0.f, 0.f, 0.f};
    bf16x8 At[4][2], B0[2][2], B1[2][2];
    const char* cA = GATHER ? (const char*)g.A : (const char*)g.A + (size_t)cur.pm * tstep; const char* cB = (const char*)g.Bt + (size_t)cur.pb * tstep;
    if constexpr (GATHER) S.rows(cur, RA, CA, K, vC0, vC1);
    S.a_ready(cur);
    if constexpr (SP2) {
        PG8_STAGE(PG8_SB(0, 0), cB, voffB); PG8_STAGE(PG8_SB(0, 1), cB + hstep, voffB); PG8_STAGE(PG8_SA(0, 0), cA, vC0); PG8_STAGE(PG8_SA(0, 1), cA + hstepA, vC1);
        if (wr == 1) PG8_BAR;
        PG8_WAIT_V(2); PG8_BAR;
        PG8_STAGE(PG8_SB(1, 0), cB + kstep, voffB); PG8_STAGE(PG8_SA(1, 0), cA + kstep, vC0); PG8_STAGE(PG8_SB(1, 1), cB + hstep + kstep, voffB);
        PG8_WAIT_V(6); PG8_BAR;
    } else {
        PG8_STAGE(PG8_SB(0, 0), cB, voffB); PG8_STAGE(PG8_SA(0, 0), cA, voffA); PG8_STAGE(PG8_SB(0, 1), cB + hstep, voffB); PG8_STAGE(PG8_SA(0, 1), cA + hstep, voffA);
        if (wr == 1) PG8_BAR;
        PG8_WAIT_V(4); PG8_BAR;
        PG8_STAGE(PG8_SB(1, 0), cB + kstep, voffB); PG8_STAGE(PG8_SA(1, 0), cA + kstep, voffA); PG8_STAGE(PG8_SB(1, 1), cB + hstep + kstep, voffB);
        PG8_WAIT_V(6); PG8_BAR;
    }
    for (;;) {
        const bool has_next = S.next(ui + 1, nxt);
        const char* nA = (has_next && !GATHER) ? (const char*)g.A + (size_t)nxt.pm * tstep : cA;
        if constexpr (GATHER) { if (has_next) S.rows(nxt, RA, CA, K, vN0, vN1); else { vN0[0] = vC0[0]; vN0[1] = vC0[1]; vN1[0] = vC1[0]; vN1[1] = vC1[1]; } }
        const char* nB = has_next ? (const char*)g.Bt + (size_t)nxt.pb * tstep : cB;
        for (int t = 0; t < nt; t += 2) {
            const bool last = (t == nt - 2);
            const char* a1 = cA + (size_t)(t + 1) * kstep;
            const char* a2 = last ? nA : cA + (size_t)(t + 2) * kstep; const char* b2 = last ? nB : cB + (size_t)(t + 2) * kstep;
            const char* a3 = a2 + kstep; const char* b3 = b2 + kstep;
            if (last && has_next) S.a_ready(nxt);
            unsigned w0[2], w1[2];
            if constexpr (GATHER) { w0[0] = last ? vN0[0] : vC0[0]; w0[1] = last ? vN0[1] : vC0[1]; w1[0] = last ? vN1[0] : vC1[0]; w1[1] = last ? vN1[1] : vC1[1]; } else { w0[0] = w1[0] = voffA[0]; w0[1] = w1[1] = voffA[1]; }
            if constexpr (SP2) {
            PG8_LDB(B0, 0, 0); PG8_LDB(B1, 0, 1); PG8_SCHED; PG8_LDA(At, 0, 0); PG8_STAGE(PG8_SA(1, 1), a1 + hstepA, vC1);
            PG8_WAIT_V(8); PG8_WAIT_L(0); PG8_BAR; PG8_MMA(0, 0, At, B0); PG8_MMA(0, 1, At, B1); PG8_BAR; PG8_SCHED;
            PG8_LDA(At, 0, 1); PG8_STAGE(PG8_SB(0, 0), b2, voffB); PG8_STAGE(PG8_SB(0, 1), b2 + hstep, voffB); PG8_STAGE(PG8_SA(0, 0), a2, w0);
            PG8_WAIT_V(8); PG8_WAIT_L(0); PG8_BAR; PG8_MMA(1, 0, At, B0); PG8_MMA(1, 1, At, B1); PG8_BAR; PG8_SCHED;
            PG8_LDB(B0, 1, 0); PG8_LDB(B1, 1, 1); PG8_SCHED; PG8_LDA(At, 1, 0); PG8_STAGE(PG8_SA(0, 1), a2 + hstepA, w1);
            PG8_WAIT_V(8); PG8_WAIT_L(0); PG8_BAR; PG8_MMA(0, 0, At, B0); PG8_MMA(0, 1, At, B1); PG8_BAR; PG8_SCHED;
            PG8_LDA(At, 1, 1); PG8_STAGE(PG8_SB(1, 0), b3, voffB); PG8_STAGE(PG8_SB(1, 1), b3 + hstep, voffB); PG8_STAGE(PG8_SA(1, 0), a3, w0);
            PG8_WAIT_V(8); PG8_WAIT_L(0); PG8_BAR; PG8_MMA(1, 0, At, B0); PG8_MMA(1, 1, At, B1); PG8_BAR; PG8_SCHED;
            } else {
            PG8_LDB(B0, 0, 0); PG8_SCHED; PG8_LDA(At, 0, 0); PG8_STAGE(PG8_SA(1, 1), a1 + hstep, voffA);
            PG8_WAIT_L(8); PG8_BAR; PG8_WAIT_L(0); PG8_MMA(0, 0, At, B0); PG8_BAR; PG8_SCHED;
            PG8_LDB(B1, 0, 1); PG8_STAGE(PG8_SB(0, 0), b2, voffB);
            PG8_BAR; PG8_WAIT_L(0); PG8_MMA(0, 1, At, B1); PG8_BAR;
            PG8_LDA(At, 0, 1); PG8_STAGE(PG8_SA(0, 0), a2, voffA);
            PG8_BAR; PG8_WAIT_L(0); PG8_MMA(1, 0, At, B0); PG8_BAR; PG8_SCHED;
            PG8_STAGE(PG8_SB(0, 1), b2 + hstep, voffB);
            PG8_WAIT_V(6); PG8_BAR; PG8_MMA(1, 1, At, B1); PG8_BAR;
            PG8_LDB(B0, 1, 0); PG8_SCHED; PG8_LDA(At, 1, 0); PG8_STAGE(PG8_SA(0, 1), a2 + hstep, voffA);
            PG8_WAIT_L(8); PG8_BAR; PG8_WAIT_L(0); PG8_MMA(0, 0, At, B0); PG8_BAR; PG8_SCHED;
            PG8_LDB(B1, 1, 1); PG8_STAGE(PG8_SB(1, 0), b3, voffB);
            PG8_BAR; PG8_WAIT_L(0); PG8_MMA(0, 1, At, B1); PG8_BAR;
            PG8_LDA(At, 1, 1); PG8_STAGE(PG8_SA(1, 0), a3, voffA);
            PG8_BAR; PG8_WAIT_L(0); PG8_MMA(1, 0, At, B0); PG8_BAR; PG8_SCHED;
            PG8_STAGE(PG8_SB(1, 1), b3 + hstep, voffB);
            PG8_WAIT_V(6); PG8_BAR; PG8_MMA(1, 1, At, B1); PG8_BAR;
            }
        }
        if constexpr (ALIGN_EPI) { if (wr == 0) PG8_BAR; }
        if constexpr (!Epi::AFTER_DRAIN) { int ln2; asm volatile("v_mbcnt_lo_u32_b32 %0, -1, 0\n\tv_mbcnt_hi_u32_b32 %0, -1, %0" : "=v"(ln2)); const int fr2 = ln2 & 15, fq2 = ln2 >> 4; E(acc, cur, wr, wc, fr2, fq2); S.done(cur); }
        if (!has_next) break;
#pragma unroll
        for (int a = 0; a < 2; ++a)
#pragma unroll
            for (int b = 0; b < 2; ++b)
#pragma unroll
                for (int m = 0; m < 4; ++m)
#pragma unroll
                    for (int n = 0; n < 2; ++n) acc[a][b][m][n] = (f32x4){0.f, 0.f, 0.f, 0.f};
        cur = nxt; cA = nA; cB = nB; ++ui;
        if constexpr (GATHER) { vC0[0] = vN0[0]; vC0[1] = vN0[1]; vC1[0] = vN1[0]; vC1[1] = vN1[1]; }
        if constexpr (ALIGN_EPI) { if (wr == 1) PG8_BAR; }
    }
    PG8_WAIT_V(0);
    if constexpr (!ALIGN_EPI) { if (wr == 0) PG8_BAR; }
    PG8_BAR;
    if constexpr (Epi::AFTER_DRAIN) { E.fused(acc, cur, wr, wc, fr, fq, lds, wid, lane); S.done(cur); }
#undef PG8_SA
#undef PG8_SB
#undef PG8_STAGE
#undef PG8_LDA
#undef PG8_LDB
#undef PG8_MMA
#undef PG8_WAIT_V
#undef PG8_WAIT_L
#undef PG8_BAR
#undef PG8_SCHED
}
}

namespace att {
typedef unsigned short bf16_t;
typedef short bf16x8 __attribute__((ext_vector_type(8)));
typedef short s16x4 __attribute__((ext_vector_type(4)));
typedef float f32x16 __attribute__((ext_vector_type(16)));
typedef unsigned u32x4 __attribute__((ext_vector_type(4)));
constexpr int NW = 8, QBLK = 32, KVBLK = 64, DQK = 96, DV = 64;
constexpr float SCALE = 0.10206207261596575f;
constexpr float THR = 8.f;
constexpr int SHM_V = KVBLK * DV * 2  , SHM_K = KVBLK * 256  ;
constexpr int NBUF = 4;
constexpr int LDS_V = 0, LDS_K = NBUF * SHM_V, LDS_WS = LDS_K + NBUF * SHM_K, LDS_BYTES = LDS_WS + NW * 64 * 4;
#define KSWZ(row, colB) ((row) * 256 + ((colB) ^ (((row) & 7) << 4)))
#define SBAR() __builtin_amdgcn_sched_barrier(0)
__device__ __forceinline__ int crow(int r, int hi) { return (r & 3) + 8 * (r >> 2) + 4 * hi; }
__device__ __forceinline__ unsigned cvtpk(float lo, float hi) { unsigned r; asm volatile("v_cvt_pk_bf16_f32 %0, %1, %2" : "=v"(r) : "v"(lo), "v"(hi)); return r; }
template <bool FIRST> __device__ __forceinline__ void partialSM(f32x16& p0, f32x16& p1, float& m_reg, f32x16& negm, float& alpha) {
  constexpr float THRL = THR * 1.4426950408889634f;
  float pmax = p0[0];
#pragma unroll
  for (int r = 1; r < 16; ++r) pmax = fmaxf(pmax, p0[r]);
#pragma unroll
  for (int r = 0; r < 16; ++r) pmax = fmaxf(pmax, p1[r]);
  { auto rr = __builtin_amdgcn_permlane32_swap(__float_as_uint(pmax), __float_as_uint(pmax), false, false);
    pmax = fmaxf(__uint_as_float(rr[0]), __uint_as_float(rr[1])); }
  if (!FIRST && __builtin_expect(__all(pmax <= THRL), 1)) { alpha = 1.f; }
  else { const float delta = FIRST ? pmax : fmaxf(pmax, 0.f); alpha = FIRST ? 1.f : __builtin_amdgcn_exp2f(-delta); m_reg += delta;
#pragma unroll
    for (int r = 0; r < 16; ++r) { negm[r] -= delta; p0[r] -= delta; p1[r] -= delta; } }
#pragma unroll
  for (int r = 0; r < 16; ++r) p0[r] = __builtin_amdgcn_exp2f(p0[r]);
}
__device__ __forceinline__ void finishSM(f32x16& p0, f32x16& p1, bf16x8& pa0, bf16x8& pa1, bf16x8& pa2, bf16x8& pa3) {
#pragma unroll
  for (int r = 0; r < 16; ++r) p1[r] = __builtin_amdgcn_exp2f(p1[r]);
#define PK4(P, BASE, OUT) do { unsigned a0 = cvtpk(P[BASE + 0], P[BASE + 1]), a1 = cvtpk(P[BASE + 2], P[BASE + 3]);   \
    unsigned b0 = cvtpk(P[BASE + 4], P[BASE + 5]), b1 = cvtpk(P[BASE + 6], P[BASE + 7]);                              \
    auto r0 = __builtin_amdgcn_permlane32_swap(a0, b0, false, false); auto r1 = __builtin_amdgcn_permlane32_swap(a1, b1, false, false); \
    u32x4 w = {r0[0], r1[0], r0[1], r1[1]}; OUT = *reinterpret_cast<bf16x8*>(&w); } while (0)
  PK4(p0, 0, pa0); PK4(p0, 8, pa1); PK4(p1, 0, pa2); PK4(p1, 8, pa3);
#undef PK4
}
template <int OFF> __device__ __forceinline__ bf16x8 krd(int addr) { bf16x8 r; asm volatile("ds_read_b128 %0, %1 offset:%2" : "=&v"(r) : "v"(addr), "i"(OFF) : "memory"); return r; }
template <int KOFF> __device__ __forceinline__ void qkt(f32x16& p0, f32x16& p1, const int (&ka)[6], const bf16x8* qr, const f32x16& negm) {
#define KA(d0) krd<KOFF>(ka[d0])
#define KB(d0) krd<KOFF + 8192>(ka[d0])
  const bf16x8 a0 = KA(0), b0 = KB(0), a1 = KA(1), b1 = KB(1), a2 = KA(2), b2 = KB(2);
  asm volatile("s_waitcnt lgkmcnt(4)" ::: "memory"); SBAR();
  p0 = __builtin_amdgcn_mfma_f32_32x32x16_bf16(a0, qr[0], negm, 0, 0, 0); p1 = __builtin_amdgcn_mfma_f32_32x32x16_bf16(b0, qr[0], negm, 0, 0, 0);
  const bf16x8 a3 = KA(3), b3 = KB(3);
  asm volatile("s_waitcnt lgkmcnt(4)" ::: "memory"); SBAR();
  p0 = __builtin_amdgcn_mfma_f32_32x32x16_bf16(a1, qr[1], p0, 0, 0, 0); p1 = __builtin_amdgcn_mfma_f32_32x32x16_bf16(b1, qr[1], p1, 0, 0, 0);
  const bf16x8 a4 = KA(4), b4 = KB(4);
  asm volatile("s_waitcnt lgkmcnt(4)" ::: "memory"); SBAR();
  p0 = __builtin_amdgcn_mfma_f32_32x32x16_bf16(a2, qr[2], p0, 0, 0, 0); p1 = __builtin_amdgcn_mfma_f32_32x32x16_bf16(b2, qr[2], p1, 0, 0, 0);
  const bf16x8 a5 = KA(5), b5 = KB(5);
  asm volatile("s_waitcnt lgkmcnt(4)" ::: "memory"); SBAR();
  p0 = __builtin_amdgcn_mfma_f32_32x32x16_bf16(a3, qr[3], p0, 0, 0, 0); p1 = __builtin_amdgcn_mfma_f32_32x32x16_bf16(b3, qr[3], p1, 0, 0, 0);
  asm volatile("s_waitcnt lgkmcnt(2)" ::: "memory"); SBAR();
  p0 = __builtin_amdgcn_mfma_f32_32x32x16_bf16(a4, qr[4], p0, 0, 0, 0); p1 = __builtin_amdgcn_mfma_f32_32x32x16_bf16(b4, qr[4], p1, 0, 0, 0);
  asm volatile("s_waitcnt lgkmcnt(0)" ::: "memory"); SBAR();
  p0 = __builtin_amdgcn_mfma_f32_32x32x16_bf16(a5, qr[5], p0, 0, 0, 0); p1 = __builtin_amdgcn_mfma_f32_32x32x16_bf16(b5, qr[5], p1, 0, 0, 0);
#undef KA
#undef KB
}
template <int KOFF> __device__ __forceinline__ void kpre(const int (&ka)[6], bf16x8 (&kf)[6]) {
  kf[0] = krd<KOFF>(ka[0]); kf[1] = krd<KOFF + 8192>(ka[0]); kf[2] = krd<KOFF>(ka[1]); kf[3] = krd<KOFF + 8192>(ka[1]); kf[4] = krd<KOFF>(ka[2]); kf[5] = krd<KOFF + 8192>(ka[2]); }
template <int KOFF> __device__ __forceinline__ void qkt_pre(f32x16& p0, f32x16& p1, const int (&ka)[6], const bf16x8* qr, const f32x16& negm, const bf16x8 (&kf)[6]) {
#define KA(d0) krd<KOFF>(ka[d0])
#define KB(d0) krd<KOFF + 8192>(ka[d0])
  const bf16x8 a3 = KA(3), b3 = KB(3), a4 = KA(4), b4 = KB(4);
  p0 = __builtin_amdgcn_mfma_f32_32x32x16_bf16(kf[0], qr[0], negm, 0, 0, 0); p1 = __builtin_amdgcn_mfma_f32_32x32x16_bf16(kf[1], qr[0], negm, 0, 0, 0);
  const bf16x8 a5 = KA(5), b5 = KB(5); SBAR();
  p0 = __builtin_amdgcn_mfma_f32_32x32x16_bf16(kf[2], qr[1], p0, 0, 0, 0); p1 = __builtin_amdgcn_mfma_f32_32x32x16_bf16(kf[3], qr[1], p1, 0, 0, 0);
  p0 = __builtin_amdgcn_mfma_f32_32x32x16_bf16(kf[4], qr[2], p0, 0, 0, 0); p1 = __builtin_amdgcn_mfma_f32_32x32x16_bf16(kf[5], qr[2], p1, 0, 0, 0);
  asm volatile("s_waitcnt lgkmcnt(4)" ::: "memory"); SBAR();
  p0 = __builtin_amdgcn_mfma_f32_32x32x16_bf16(a3, qr[3], p0, 0, 0, 0); p1 = __builtin_amdgcn_mfma_f32_32x32x16_bf16(b3, qr[3], p1, 0, 0, 0);
  asm volatile("s_waitcnt lgkmcnt(2)" ::: "memory"); SBAR();
  p0 = __builtin_amdgcn_mfma_f32_32x32x16_bf16(a4, qr[4], p0, 0, 0, 0); p1 = __builtin_amdgcn_mfma_f32_32x32x16_bf16(b4, qr[4], p1, 0, 0, 0);
  asm volatile("s_waitcnt lgkmcnt(0)" ::: "memory"); SBAR();
  p0 = __builtin_amdgcn_mfma_f32_32x32x16_bf16(a5, qr[5], p0, 0, 0, 0); p1 = __builtin_amdgcn_mfma_f32_32x32x16_bf16(b5, qr[5], p1, 0, 0, 0);
#undef KA
#undef KB
}
template <int KOFF> __device__ __forceinline__ void qkt_fin(f32x16& p0, f32x16& p1, const int (&ka)[6], const bf16x8* qr, const f32x16& negm, f32x16& q0, f32x16& q1, bf16x8& pa0, bf16x8& pa1, bf16x8& pa2, bf16x8& pa3) {
#define KA(d0) krd<KOFF>(ka[d0])
#define KB(d0) krd<KOFF + 8192>(ka[d0])
#define PK4(P, BASE, OUT) do { unsigned a0_ = cvtpk(P[BASE + 0], P[BASE + 1]), a1_ = cvtpk(P[BASE + 2], P[BASE + 3]);   \
    unsigned b0_ = cvtpk(P[BASE + 4], P[BASE + 5]), b1_ = cvtpk(P[BASE + 6], P[BASE + 7]);                              \
    auto r0_ = __builtin_amdgcn_permlane32_swap(a0_, b0_, false, false); auto r1_ = __builtin_amdgcn_permlane32_swap(a1_, b1_, false, false); \
    u32x4 w_ = {r0_[0], r1_[0], r0_[1], r1_[1]}; OUT = *reinterpret_cast<bf16x8*>(&w_); } while (0)
#define EX(i) q1[i] = __builtin_amdgcn_exp2f(q1[i])
  const bf16x8 a0 = KA(0), b0 = KB(0), a1 = KA(1), b1 = KB(1), a2 = KA(2), b2 = KB(2);
  asm volatile("s_waitcnt lgkmcnt(4)" ::: "memory"); SBAR();
  p0 = __builtin_amdgcn_mfma_f32_32x32x16_bf16(a0, qr[0], negm, 0, 0, 0); p1 = __builtin_amdgcn_mfma_f32_32x32x16_bf16(b0, qr[0], negm, 0, 0, 0);
  PK4(q0, 0, pa0); EX(0); EX(1);
  const bf16x8 a3 = KA(3), b3 = KB(3);
  asm volatile("s_waitcnt lgkmcnt(4)" ::: "memory"); SBAR();
  p0 = __builtin_amdgcn_mfma_f32_32x32x16_bf16(a1, qr[1], p0, 0, 0, 0); p1 = __builtin_amdgcn_mfma_f32_32x32x16_bf16(b1, qr[1], p1, 0, 0, 0);
  PK4(q0, 8, pa1); EX(2); EX(3);
  const bf16x8 a4 = KA(4), b4 = KB(4);
  asm volatile("s_waitcnt lgkmcnt(4)" ::: "memory"); SBAR();
  p0 = __builtin_amdgcn_mfma_f32_32x32x16_bf16(a2, qr[2], p0, 0, 0, 0); p1 = __builtin_amdgcn_mfma_f32_32x32x16_bf16(b2, qr[2], p1, 0, 0, 0);
  EX(4); EX(5); EX(6); EX(7);
  const bf16x8 a5 = KA(5), b5 = KB(5);
  asm volatile("s_waitcnt lgkmcnt(4)" ::: "memory"); SBAR();
  p0 = __builtin_amdgcn_mfma_f32_32x32x16_bf16(a3, qr[3], p0, 0, 0, 0); p1 = __builtin_amdgcn_mfma_f32_32x32x16_bf16(b3, qr[3], p1, 0, 0, 0);
  EX(8); EX(9); EX(10); EX(11);
  asm volatile("s_waitcnt lgkmcnt(2)" ::: "memory"); SBAR();
  p0 = __builtin_amdgcn_mfma_f32_32x32x16_bf16(a4, qr[4], p0, 0, 0, 0); p1 = __builtin_amdgcn_mfma_f32_32x32x16_bf16(b4, qr[4], p1, 0, 0, 0);
  EX(12); EX(13); EX(14); EX(15);
  asm volatile("s_waitcnt lgkmcnt(0)" ::: "memory"); SBAR();
  p0 = __builtin_amdgcn_mfma_f32_32x32x16_bf16(a5, qr[5], p0, 0, 0, 0); p1 = __builtin_amdgcn_mfma_f32_32x32x16_bf16(b5, qr[5], p1, 0, 0, 0);
  PK4(q1, 0, pa2); PK4(q1, 8, pa3);
#undef EX
#undef PK4
#undef KA
#undef KB
}
__device__ __forceinline__ int v_st(int k, int c) { const int kk = (k & ~0xC) | ((k & 4) << 1) | ((k & 8) >> 1); return ((kk >> 3) * 2 + (c >> 5)) * 512 + ((kk & 7) * 32 + (c & 31)) * 2; }
__device__ __forceinline__ int v_rd_base(int lane) { return ((lane & 3) << 3) | (((lane >> 2) & 3) << 6) | (((lane >> 4) & 1) << 5) | (((lane >> 5) & 1) << 8); }
constexpr int v_rd_off(int d0, int ks, int half) { return d0 * 512 + ks * 2048 + half * 1024; }
template <int OFF> __device__ __forceinline__ s16x4 tr_read(int vb) {
  s16x4 r; asm volatile("ds_read_b64_tr_b16 %0, %1 offset:%2" : "=&v"(r) : "v"(vb), "i"(OFF) : "memory"); return r; }
template <int VOFF, bool SPLIT> __device__ __forceinline__ void pv_d0(f32x16* o, int vb, bf16x8 pa0, bf16x8 pa1, bf16x8 pa2, bf16x8 pa3) {
#define PK(L, H) (bf16x8){L[0], L[1], L[2], L[3], H[0], H[1], H[2], H[3]}
  if constexpr (SPLIT) {
    const bf16x8 ones = {0x3F80, 0x3F80, 0x3F80, 0x3F80, 0x3F80, 0x3F80, 0x3F80, 0x3F80};
    { const s16x4 l0 = tr_read<VOFF + v_rd_off(0, 0, 0)>(vb), h0 = tr_read<VOFF + v_rd_off(0, 0, 1)>(vb), m0 = tr_read<VOFF + v_rd_off(1, 0, 0)>(vb), g0 = tr_read<VOFF + v_rd_off(1, 0, 1)>(vb);
      const s16x4 l1 = tr_read<VOFF + v_rd_off(0, 1, 0)>(vb), h1 = tr_read<VOFF + v_rd_off(0, 1, 1)>(vb), m1 = tr_read<VOFF + v_rd_off(1, 1, 0)>(vb), g1 = tr_read<VOFF + v_rd_off(1, 1, 1)>(vb);
      asm volatile("s_waitcnt lgkmcnt(4)" ::: "memory"); SBAR();
      o[0] = __builtin_amdgcn_mfma_f32_32x32x16_bf16(pa0, PK(l0, h0), o[0], 0, 0, 0); o[1] = __builtin_amdgcn_mfma_f32_32x32x16_bf16(pa0, PK(m0, g0), o[1], 0, 0, 0);
      asm volatile("s_waitcnt lgkmcnt(0)" ::: "memory"); SBAR();
      o[0] = __builtin_amdgcn_mfma_f32_32x32x16_bf16(pa1, PK(l1, h1), o[0], 0, 0, 0); o[1] = __builtin_amdgcn_mfma_f32_32x32x16_bf16(pa1, PK(m1, g1), o[1], 0, 0, 0); SBAR(); }
    { const s16x4 l2 = tr_read<VOFF + v_rd_off(0, 2, 0)>(vb), h2 = tr_read<VOFF + v_rd_off(0, 2, 1)>(vb), m2 = tr_read<VOFF + v_rd_off(1, 2, 0)>(vb), g2 = tr_read<VOFF + v_rd_off(1, 2, 1)>(vb);
      const s16x4 l3 = tr_read<VOFF + v_rd_off(0, 3, 0)>(vb), h3 = tr_read<VOFF + v_rd_off(0, 3, 1)>(vb), m3 = tr_read<VOFF + v_rd_off(1, 3, 0)>(vb), g3 = tr_read<VOFF + v_rd_off(1, 3, 1)>(vb);
      o[2] = __builtin_amdgcn_mfma_f32_32x32x16_bf16(pa0, ones, o[2], 0, 0, 0); o[2] = __builtin_amdgcn_mfma_f32_32x32x16_bf16(pa1, ones, o[2], 0, 0, 0);
      o[2] = __builtin_amdgcn_mfma_f32_32x32x16_bf16(pa2, ones, o[2], 0, 0, 0); o[2] = __builtin_amdgcn_mfma_f32_32x32x16_bf16(pa3, ones, o[2], 0, 0, 0);
      asm volatile("s_waitcnt lgkmcnt(4)" ::: "memory"); SBAR();
      o[0] = __builtin_amdgcn_mfma_f32_32x32x16_bf16(pa2, PK(l2, h2), o[0], 0, 0, 0); o[1] = __builtin_amdgcn_mfma_f32_32x32x16_bf16(pa2, PK(m2, g2), o[1], 0, 0, 0);
      asm volatile("s_waitcnt lgkmcnt(0)" ::: "memory"); SBAR();
      o[0] = __builtin_amdgcn_mfma_f32_32x32x16_bf16(pa3, PK(l3, h3), o[0], 0, 0, 0); o[1] = __builtin_amdgcn_mfma_f32_32x32x16_bf16(pa3, PK(m3, g3), o[1], 0, 0, 0); }
  } else {

  const s16x4 l0 = tr_read<VOFF + v_rd_off(0, 0, 0)>(vb), h0 = tr_read<VOFF + v_rd_off(0, 0, 1)>(vb), m0 = tr_read<VOFF + v_rd_off(1, 0, 0)>(vb), g0 = tr_read<VOFF + v_rd_off(1, 0, 1)>(vb);
  const s16x4 l1 = tr_read<VOFF + v_rd_off(0, 1, 0)>(vb), h1 = tr_read<VOFF + v_rd_off(0, 1, 1)>(vb), m1 = tr_read<VOFF + v_rd_off(1, 1, 0)>(vb), g1 = tr_read<VOFF + v_rd_off(1, 1, 1)>(vb);
  const s16x4 l2 = tr_read<VOFF + v_rd_off(0, 2, 0)>(vb), h2 = tr_read<VOFF + v_rd_off(0, 2, 1)>(vb), m2 = tr_read<VOFF + v_rd_off(1, 2, 0)>(vb), g2 = tr_read<VOFF + v_rd_off(1, 2, 1)>(vb);
  const s16x4 l3 = tr_read<VOFF + v_rd_off(0, 3, 0)>(vb), h3 = tr_read<VOFF + v_rd_off(0, 3, 1)>(vb), m3 = tr_read<VOFF + v_rd_off(1, 3, 0)>(vb), g3 = tr_read<VOFF + v_rd_off(1, 3, 1)>(vb);
  asm volatile("s_waitcnt lgkmcnt(12)" ::: "memory"); SBAR();
  o[0] = __builtin_amdgcn_mfma_f32_32x32x16_bf16(pa0, PK(l0, h0), o[0], 0, 0, 0); o[1] = __builtin_amdgcn_mfma_f32_32x32x16_bf16(pa0, PK(m0, g0), o[1], 0, 0, 0);
  asm volatile("s_waitcnt lgkmcnt(8)" ::: "memory"); SBAR();
  o[0] = __builtin_amdgcn_mfma_f32_32x32x16_bf16(pa1, PK(l1, h1), o[0], 0, 0, 0); o[1] = __builtin_amdgcn_mfma_f32_32x32x16_bf16(pa1, PK(m1, g1), o[1], 0, 0, 0);
  asm volatile("s_waitcnt lgkmcnt(4)" ::: "memory"); SBAR();
  o[0] = __builtin_amdgcn_mfma_f32_32x32x16_bf16(pa2, PK(l2, h2), o[0], 0, 0, 0); o[1] = __builtin_amdgcn_mfma_f32_32x32x16_bf16(pa2, PK(m2, g2), o[1], 0, 0, 0);
  asm volatile("s_waitcnt lgkmcnt(0)" ::: "memory"); SBAR();
  o[0] = __builtin_amdgcn_mfma_f32_32x32x16_bf16(pa3, PK(l3, h3), o[0], 0, 0, 0); o[1] = __builtin_amdgcn_mfma_f32_32x32x16_bf16(pa3, PK(m3, g3), o[1], 0, 0, 0);
  { const bf16x8 ones = {0x3F80, 0x3F80, 0x3F80, 0x3F80, 0x3F80, 0x3F80, 0x3F80, 0x3F80};
    o[2] = __builtin_amdgcn_mfma_f32_32x32x16_bf16(pa0, ones, o[2], 0, 0, 0); o[2] = __builtin_amdgcn_mfma_f32_32x32x16_bf16(pa1, ones, o[2], 0, 0, 0);
    o[2] = __builtin_amdgcn_mfma_f32_32x32x16_bf16(pa2, ones, o[2], 0, 0, 0); o[2] = __builtin_amdgcn_mfma_f32_32x32x16_bf16(pa3, ones, o[2], 0, 0, 0); }
  }
#undef PK
}
__device__ __forceinline__ unsigned short f2bf(float f) { unsigned u = __float_as_uint(f); return (unsigned short)((u + 0x7fffu + ((u >> 16) & 1u)) >> 16); }

struct NoHook { static constexpr bool ACTIVE = false; __device__ __forceinline__ void issue(int) {} __device__ __forceinline__ void finish() {} };
template <class HK> __device__ __forceinline__ void attn_unit(const bf16_t* __restrict__ Qb, const bf16_t* __restrict__ Kh, const bf16_t* __restrict__ Vh, bf16_t* __restrict__ Ob, int opitch, int seq, LAS char* lds, int tid_in, HK& hk) {
  int tid_ = tid_in; asm volatile("" : "+v"(tid_));
  const int tid = tid_, wid = tid >> 6, lane = tid & 63, r32 = lane & 31, hi = lane >> 5;
  LAS char* V_lds = lds + LDS_V; LAS char* K_lds = lds + LDS_K;
  LAS float* ws = (LAS float*)(lds + LDS_WS) + wid * 64; LAS float* li_l = ws; LAS float* al_l = ws + 32;
  float m_reg = 0.f; f32x16 o[3] = {}; f32x16 negm = {}; bf16x8 qr[6];
  const bf16_t* Qw = Qb + (size_t)(wid * QBLK + r32) * DQK + hi * 8;
#pragma unroll
  for (int d0 = 0; d0 < 6; ++d0) qr[d0] = *(const bf16x8*)(Qw + d0 * 16);
  const int vr = tid >> 3, vc = (tid & 7) * 8, vst = v_st(vr, vc);
  const int c1 = (tid + 512) % 768, kr0 = tid / 12, kc0 = (tid % 12) * 8, kr1 = c1 / 12, kc1 = (c1 % 12) * 8;
  const int kst0 = KSWZ(kr0, kc0 * 2), kst1 = KSWZ(kr1, kc1 * 2);
  const int vb0 = (int)(uintptr_t)V_lds + v_rd_base(lane);
  int ka[6];
#pragma unroll
  for (int d0 = 0; d0 < 6; ++d0) ka[d0] = (int)(uintptr_t)K_lds + r32 * 256 + ((d0 * 32 + hi * 16) ^ ((r32 & 7) << 4));
  bf16x8 sv0, sk00, sk01, sv1, sk10, sk11;
#define SLOAD0(k0) do { sv0 = *(const bf16x8*)(Vh + (size_t)((k0) + vr) * DV + vc); sk00 = *(const bf16x8*)(Kh + (size_t)((k0) + kr0) * DQK + kc0); sk01 = *(const bf16x8*)(Kh + (size_t)((k0) + kr1) * DQK + kc1); } while (0)
#define SLOAD1(k0) do { sv1 = *(const bf16x8*)(Vh + (size_t)((k0) + vr) * DV + vc); sk10 = *(const bf16x8*)(Kh + (size_t)((k0) + kr0) * DQK + kc0); sk11 = *(const bf16x8*)(Kh + (size_t)((k0) + kr1) * DQK + kc1); } while (0)
#define SWRITE0(b) do { *(LAS bf16x8*)(V_lds + (b) * SHM_V + vst) = sv0; *(LAS bf16x8*)(K_lds + (b) * SHM_K + kst0) = sk00; *(LAS bf16x8*)(K_lds + (b) * SHM_K + kst1) = sk01; } while (0)
#define SWRITE1(b) do { *(LAS bf16x8*)(V_lds + (b) * SHM_V + vst) = sv1; *(LAS bf16x8*)(K_lds + (b) * SHM_K + kst0) = sk10; *(LAS bf16x8*)(K_lds + (b) * SHM_K + kst1) = sk11; } while (0)
#define SWAIT() asm volatile("s_waitcnt vmcnt(3)" ::: "memory")
#define SWAITH(n) do { if constexpr (HK::ACTIVE) asm volatile("s_waitcnt vmcnt(" #n ")" ::: "memory"); else asm volatile("s_waitcnt vmcnt(3)" ::: "memory"); } while (0)
#define RESC(a) do { if (__any((a) < 1.f)) { if (hi == 0) al_l[r32] = (a); asm volatile("s_waitcnt lgkmcnt(0)" ::: "memory"); \
    _Pragma("unroll") for (int d = 0; d < 3; ++d) _Pragma("unroll") for (int r = 0; r < 16; ++r) o[d][r] *= al_l[crow(r, hi)]; } } while (0)
  f32x16 pA0, pA1, pB0, pB1; float alA, alB; bf16x8 pa0, pa1, pa2, pa3; const int NT = seq / KVBLK;
  SLOAD0(0); asm volatile("s_waitcnt vmcnt(0)" ::: "memory"); SWRITE0(0); __syncthreads();
  qkt<0>(pA0, pA1, ka, qr, negm); partialSM<true>(pA0, pA1, m_reg, negm, alA);
  if constexpr (HK::ACTIVE) hk.issue(0);
  SLOAD1(KVBLK); if (2 < NT) SLOAD0(2 * KVBLK);
  SWAIT(); SWRITE1(1); __syncthreads();
#define ATT_STEP(j_, PC0, PC1, ALC, PP0, PP1, ALP, KB, VB, WB, LD, WR, DO_LD, DO_WR, HOOK, WN) do { \
    SBAR(); { f32x16 nm_; if constexpr (HK::ACTIVE) { _Pragma("unroll") for (int r_ = 0; r_ < 16; ++r_) nm_[r_] = -m_reg; } else nm_ = negm; qkt_fin<(KB) * SHM_K>(PC0, PC1, ka, qr, nm_, PP0, PP1, pa0, pa1, pa2, pa3); } SBAR(); \
    if constexpr (HK::ACTIVE && HOOK) hk.finish(); if (DO_LD) SLOAD##LD(((j_) + 2) * KVBLK); if constexpr (HK::ACTIVE && HOOK) hk.issue(((j_) >> 2) + 1); SBAR(); \
    pv_d0<(VB) * SHM_V, HK::ACTIVE>(o, vb0, pa0, pa1, pa2, pa3); if constexpr (HK::ACTIVE) { f32x16 dm_ = {}; partialSM<false>(PC0, PC1, m_reg, dm_, ALC); } else partialSM<false>(PC0, PC1, m_reg, negm, ALC); \
    if (DO_WR) { SWAITH(WN); SWRITE##WR(WB); } \
    RESC(ALC); __syncthreads(); } while (0)
  int j = 1;
  for (; j < NT - 3; j += 4) {
    ATT_STEP(j,     pB0, pB1, alB, pA0, pA1, alA, 1, 0, 2, 1, 0, true, true, true, 11);
    ATT_STEP(j + 1, pA0, pA1, alA, pB0, pB1, alB, 2, 1, 3, 0, 1, true, true, false, 7);
    ATT_STEP(j + 2, pB0, pB1, alB, pA0, pA1, alA, 3, 2, 0, 1, 0, true, true, false, 3);
    ATT_STEP(j + 3, pA0, pA1, alA, pB0, pB1, alB, 0, 3, 1, 0, 1, true, true, false, 3);
  }
  if constexpr (HK::ACTIVE) hk.finish();
  ATT_STEP(j,     pB0, pB1, alB, pA0, pA1, alA, 1, 0, 2, 1, 0, true, true, false, 3);
  ATT_STEP(j + 1, pA0, pA1, alA, pB0, pB1, alB, 2, 1, 3, 0, 1, false, true, false, 3);
  ATT_STEP(j + 2, pB0, pB1, alB, pA0, pA1, alA, 3, 2, 0, 1, 0, false, false, false, 3);
#undef ATT_STEP
  finishSM(pB0, pB1, pa0, pa1, pa2, pa3); SBAR();
  pv_d0<3 * SHM_V, HK::ACTIVE>(o, vb0, pa0, pa1, pa2, pa3);
  float rli[16];
#pragma unroll
  for (int r = 0; r < 16; ++r) rli[r] = __builtin_amdgcn_rcpf(o[2][r]);
  bf16_t* Ow = Ob + (size_t)(wid * QBLK) * opitch;
#pragma unroll
  for (int r = 0; r < 16; ++r) { const int orow = crow(r, hi);
#pragma unroll
    for (int d0 = 0; d0 < 2; ++d0) Ow[(size_t)orow * opitch + d0 * 32 + r32] = f2bf(o[d0][r] * rli[r]); }
  __syncthreads();
#undef SLOAD0
#undef SLOAD1
#undef SWRITE0
#undef SWRITE1
#undef SWAIT
#undef SWAITH
#undef RESC
}

constexpr int PP_CNT_OFF = 131072 + 320 + 20 * 4;
template <class HK> __device__ __forceinline__ void attn_unit_pp(const bf16_t* __restrict__ Qb, const bf16_t* __restrict__ Kh, const bf16_t* __restrict__ Vh, bf16_t* __restrict__ Ob, int opitch, int seq, LAS char* lds, int tid_in, HK&) {
  int tid_ = tid_in; asm volatile("" : "+v"(tid_));
  const int tid = tid_, wid = tid >> 6, lane = tid & 63, r32 = lane & 31, hi = lane >> 5;
  int grp; { const unsigned simd = ((unsigned)__builtin_amdgcn_s_getreg(63492) >> 4) & 3u; unsigned old_ = 0u; if (lane == 0) old_ = __hip_atomic_fetch_add((LAS unsigned*)(lds + PP_CNT_OFF) + simd, 1u, __ATOMIC_RELAXED, __HIP_MEMORY_SCOPE_WORKGROUP); grp = __builtin_amdgcn_readfirstlane(old_) & 1; }
  LAS char* V_lds = lds + LDS_V; LAS char* K_lds = lds + LDS_K;
  LAS float* ws = (LAS float*)(lds + LDS_WS) + wid * 64; LAS float* al_l = ws + 32;
  float m_reg = 0.f; f32x16 o[3] = {}; f32x16 negm = {}; bf16x8 qr[6];
  const bf16_t* Qw = Qb + (size_t)(wid * QBLK + r32) * DQK + hi * 8;
#pragma unroll
  for (int d0 = 0; d0 < 6; ++d0) qr[d0] = *(const bf16x8*)(Qw + d0 * 16);
  const int vr = tid >> 3, vc = (tid & 7) * 8, vst = v_st(vr, vc);
  const int c1 = (tid + 512) % 768, kr0 = tid / 12, kc0 = (tid % 12) * 8, kr1 = c1 / 12, kc1 = (c1 % 12) * 8;
  const int kst0 = KSWZ(kr0, kc0 * 2), kst1 = KSWZ(kr1, kc1 * 2);
  const int vb0 = (int)(uintptr_t)V_lds + v_rd_base(lane);
  int ka[6];
#pragma unroll
  for (int d0 = 0; d0 < 6; ++d0) ka[d0] = (int)(uintptr_t)K_lds + r32 * 256 + ((d0 * 32 + hi * 16) ^ ((r32 & 7) << 4));
  bf16x8 sv0, sk00, sk01, sv1, sk10, sk11;
#define SLOAD0(k0) do { sv0 = *(const bf16x8*)(Vh + (size_t)((k0) + vr) * DV + vc); sk00 = *(const bf16x8*)(Kh + (size_t)((k0) + kr0) * DQK + kc0); sk01 = *(const bf16x8*)(Kh + (size_t)((k0) + kr1) * DQK + kc1); } while (0)
#define SLOAD1(k0) do { sv1 = *(const bf16x8*)(Vh + (size_t)((k0) + vr) * DV + vc); sk10 = *(const bf16x8*)(Kh + (size_t)((k0) + kr0) * DQK + kc0); sk11 = *(const bf16x8*)(Kh + (size_t)((k0) + kr1) * DQK + kc1); } while (0)
#define SWRITE0(b) do { *(LAS bf16x8*)(V_lds + (b) * SHM_V + vst) = sv0; *(LAS bf16x8*)(K_lds + (b) * SHM_K + kst0) = sk00; *(LAS bf16x8*)(K_lds + (b) * SHM_K + kst1) = sk01; } while (0)
#define SWRITE1(b) do { *(LAS bf16x8*)(V_lds + (b) * SHM_V + vst) = sv1; *(LAS bf16x8*)(K_lds + (b) * SHM_K + kst0) = sk10; *(LAS bf16x8*)(K_lds + (b) * SHM_K + kst1) = sk11; } while (0)
#define SWAIT() asm volatile("s_waitcnt vmcnt(3)" ::: "memory")
#define RESC(a) do { if (__any((a) < 1.f)) { if (hi == 0) al_l[r32] = (a); asm volatile("s_waitcnt lgkmcnt(0)" ::: "memory"); \
    _Pragma("unroll") for (int d = 0; d < 3; ++d) _Pragma("unroll") for (int r = 0; r < 16; ++r) o[d][r] *= al_l[crow(r, hi)]; } } while (0)
#define PBAR() do { asm volatile("s_waitcnt lgkmcnt(0)" ::: "memory"); __builtin_amdgcn_s_barrier(); asm volatile("" ::: "memory"); } while (0)
  f32x16 p0, p1; float al; bf16x8 pa0, pa1, pa2, pa3; const int NT = seq / KVBLK;
  SLOAD0(0); SLOAD1(KVBLK); asm volatile("s_waitcnt vmcnt(0)" ::: "memory"); SWRITE0(0); SWRITE1(1);
  SLOAD0(2 * KVBLK); SLOAD1(3 * KVBLK);
  __syncthreads();
  bf16x8 kf[6]; kpre<0>(ka, kf);
  if (grp == 1) PBAR();
#define PP_STEP(t_, KB, VBP, WB, SL, FIRST_) do { \
    SBAR(); qkt_pre<(KB) * SHM_K>(p0, p1, ka, qr, negm, kf); SBAR(); \
    if (!(FIRST_)) { pv_d0<(VBP) * SHM_V, false>(o, vb0, pa0, pa1, pa2, pa3); SBAR(); } \
    PBAR(); \
    partialSM<FIRST_>(p0, p1, m_reg, negm, al); if (!(FIRST_)) RESC(al); finishSM(p0, p1, pa0, pa1, pa2, pa3); SBAR(); \
    if ((t_) + 2 < NT) { SWAIT(); SWRITE##SL(WB); } SLOAD##SL(((t_) + 4 < NT ? (t_) + 4 : NT - 1) * KVBLK); \
    SBAR(); kpre<(((KB) + 1) & 3) * SHM_K>(ka, kf); \
    PBAR(); } while (0)
  PP_STEP(0, 0, 3, 2, 0, true); PP_STEP(1, 1, 0, 3, 1, false); PP_STEP(2, 2, 1, 0, 0, false); PP_STEP(3, 3, 2, 1, 1, false);
#pragma unroll 1
  for (int t = 4; t < NT; t += 4) { PP_STEP(t, 0, 3, 2, 0, false); PP_STEP(t + 1, 1, 0, 3, 1, false); PP_STEP(t + 2, 2, 1, 0, 0, false); PP_STEP(t + 3, 3, 2, 1, 1, false); }
#undef PP_STEP
  SBAR(); pv_d0<3 * SHM_V, false>(o, vb0, pa0, pa1, pa2, pa3);
  if (grp == 0) PBAR();
  float rli[16];
#pragma unroll
  for (int r = 0; r < 16; ++r) rli[r] = __builtin_amdgcn_rcpf(o[2][r]);
  bf16_t* Ow = Ob + (size_t)(wid * QBLK) * opitch;
#pragma unroll
  for (int r = 0; r < 16; ++r) { const int orow = crow(r, hi);
#pragma unroll
    for (int d0 = 0; d0 < 2; ++d0) Ow[(size_t)orow * opitch + d0 * 32 + r32] = f2bf(o[d0][r] * rli[r]); }
  __syncthreads();
#undef PBAR
#undef SLOAD0
#undef SLOAD1
#undef SWRITE0
#undef SWRITE1
#undef SWAIT
#undef RESC
}
#undef KSWZ
#undef SBAR
}

typedef unsigned short bf16_t;
typedef unsigned u32x4 __attribute__((ext_vector_type(4)));
typedef unsigned u32x2 __attribute__((ext_vector_type(2)));
typedef float f32x4 __attribute__((ext_vector_type(4)));
typedef float f32x2 __attribute__((ext_vector_type(2)));
typedef GAS unsigned gu32;
#define RLX_AGENT __ATOMIC_RELAXED, __HIP_MEMORY_SCOPE_AGENT
#define LDS_WAIT() asm volatile("s_waitcnt lgkmcnt(0)" ::: "memory")
#define VM_WAIT() asm volatile("s_waitcnt vmcnt(0)" ::: "memory")
__device__ __forceinline__ unsigned f2bf(float f) { unsigned u = __builtin_bit_cast(unsigned, f); return (u + 0x7fffu + ((u >> 16) & 1u)) >> 16; }
__device__ __forceinline__ unsigned pk2(float lo, float hi) { return f2bf(lo) | (f2bf(hi) << 16); }
__device__ __forceinline__ float bflo(unsigned u) { return __uint_as_float(u << 16); }
__device__ __forceinline__ float bfhi(unsigned u) { return __uint_as_float(u & 0xffff0000u); }
__device__ __forceinline__ float bf1(bf16_t h) { return __uint_as_float(((unsigned)h) << 16); }
__device__ __forceinline__ float sigm(float x) { return 1.0f / (1.0f + __expf(-x)); }
__device__ __forceinline__ float lane_xor(float v, int lane, int o) { return __int_as_float(__builtin_amdgcn_ds_bpermute((lane ^ o) << 2, __float_as_int(v))); }
__device__ __forceinline__ float wave_sum(float v, int lane) {
#pragma unroll
    for (int o = 1; o < 64; o <<= 1) v += lane_xor(v, lane, o);
    return v;
}
#define XB_TMO      128
#define XB_XCNT(j)  (256  + 64 * (j))
#define XB_XSUB(j)  (1280 + 64 * (j))
#define XB_XGEN(j)  (2304 + 64 * (j))
#define XB_TOP      3328
#define XB_TOPGEN   3392
#define XCD_BAR_WORDS 3456
#define XB_SPIN_CAP (1u << 18)

__device__ __forceinline__ unsigned xb_ld(unsigned* p)              { return __hip_atomic_load(p, __ATOMIC_RELAXED, __HIP_MEMORY_SCOPE_AGENT); }
__device__ __forceinline__ unsigned xb_add(unsigned* p, unsigned v) { return __hip_atomic_fetch_add(p, v, __ATOMIC_RELAXED, __HIP_MEMORY_SCOPE_AGENT); }
__device__ __forceinline__ unsigned xb_xcc_id() { return (unsigned)__builtin_amdgcn_s_getreg((3 << 11) | 20) & 0xFu; }
#define XB_SPIN(cond, bar) do { unsigned _sp = 0; while (cond) { __builtin_amdgcn_s_sleep(1); \
    if ((++_sp & 255u) == 0u) { if (xb_ld(&(bar)[XB_TMO])) break; if (_sp > XB_SPIN_CAP) { atomicAdd(&(bar)[XB_TMO], 1u); break; } } } } while (0)

struct XcdBarrier {
    unsigned* bar; unsigned x;
    volatile LAS unsigned* st;
};

__device__ __forceinline__ XcdBarrier xcd_barrier_post(unsigned* bar, volatile LAS unsigned* st) {
    XcdBarrier b; b.bar = bar; b.x = xb_xcc_id(); b.st = st;
    if (threadIdx.x == 0) (void)xb_add(&bar[XB_XCNT(b.x)], 1u);
    return b;
}
__device__ __forceinline__ void xcd_barrier_complete(unsigned* bar, unsigned x, unsigned& nloc, unsigned& nx) {
    const unsigned G = gridDim.x * gridDim.y * gridDim.z;
    unsigned sum, cnt, mine, sp = 0u;
    for (;;) {
        sum = 0u; cnt = 0u; mine = 0u;
#pragma unroll
        for (unsigned j = 0; j < 16; ++j) { const unsigned c = xb_ld(&bar[XB_XCNT(j)]); sum += c; cnt += (c > 0u) ? 1u : 0u; mine = (j == x) ? c : mine; }
        if (sum == G) break;
        __builtin_amdgcn_s_sleep(1);
        if ((++sp & 255u) == 0u) { if (xb_ld(&bar[XB_TMO])) break; if (sp > XB_SPIN_CAP) { atomicAdd(&bar[XB_TMO], 1u); break; } }
    }
    nloc = mine > 0u ? mine : 1u; nx = cnt > 0u ? cnt : 1u;
}

__device__ __forceinline__ void xcd_barrier(const XcdBarrier& b) {
    asm volatile("s_waitcnt vmcnt(0)" ::: "memory");
    __syncthreads();
    if (threadIdx.x == 0) {
        unsigned* bar = b.bar;
        __builtin_amdgcn_s_waitcnt(0);
        unsigned nloc = b.st[0], nx = b.st[1];
        if (nloc == 0u) { xcd_barrier_complete(bar, b.x, nloc, nx); b.st[0] = nloc; b.st[1] = nx; }
        const unsigned old = xb_add(&bar[XB_XSUB(b.x)], 1u);
        const unsigned gen = old / nloc;
        if (old + 1u == (gen + 1u) * nloc) {
            __builtin_amdgcn_fence(__ATOMIC_RELEASE, "agent");
            asm volatile("s_waitcnt vmcnt(0)" ::: "memory");
            const unsigned og = xb_add(&bar[XB_TOP], 1u);
            const unsigned tg = og / nx;
            if (og + 1u == (tg + 1u) * nx) xb_add(&bar[XB_TOPGEN], 1u);
            else XB_SPIN(xb_ld(&bar[XB_TOPGEN]) == tg, bar);
            __builtin_amdgcn_fence(__ATOMIC_ACQUIRE, "agent");
            xb_add(&bar[XB_XGEN(b.x)], 1u);
            asm volatile("s_waitcnt vmcnt(0)" ::: "memory");
        } else {
            XB_SPIN(xb_ld(&bar[XB_XGEN(b.x)]) == gen, bar);
            __builtin_amdgcn_fence(__ATOMIC_ACQUIRE, "agent");
            asm volatile("s_waitcnt vmcnt(0)" ::: "memory");
        }
    }
    __syncthreads();
}

constexpr int NWAVES = 8;
constexpr int RING_BYTES = 131072, MISC_OFF = RING_BYTES + 320, MOETAB_OFF = RING_BYTES + 1024, LDS_BYTES = 147456;
constexpr int CW_BAR = 4096;
struct Fr {
    LAS unsigned char* lds; int tid, lane, wave, gw, NGW, G, blk;
    const float* in[25]; float* out; unsigned char* ws;
};
enum { I_X = 0, I_C, I_CTX, I_CCTX, I_WMOD, I_BMOD, I_N1G, I_N2G, I_WIN, I_GF, I_GB, I_HGG, I_QNG, I_KVNG, I_WUQ, I_WUKV, I_WPA, I_WPB, I_WO, I_WR, I_RB, I_WG, I_WU, I_WD, I_FG };

__device__ __forceinline__ void mod_items(const Fr& F, int lm, int j, int n) {
    LAS float* sc = (LAS float*)F.lds; LAS float* red = sc + 5120;
    for (int i = F.tid; i < 5120; i += 512) { const int s = i >> 10, k = i & 1023; const float x = (s < 4) ? F.in[I_C][s * 1024 + k] : F.in[I_CCTX][k]; sc[i] = x * sigm(x); }
    __syncthreads();
    float* MOD = (float*)(F.ws + WS_MOD);
    for (int cg = j; cg < 192; cg += n) {
        const int cl = F.tid & 31, ks = F.tid >> 5;
        const float* wp = F.in[I_WMOD] + ((size_t)lm * 1024 + ks * 64) * 6144 + cg * 32 + cl;
        float a0 = 0.f, a1 = 0.f, a2 = 0.f, a3 = 0.f, a4 = 0.f; float w[64];
#pragma unroll
        for (int k = 0; k < 64; ++k) w[k] = wp[(size_t)k * 6144];
#pragma unroll
        for (int k = 0; k < 64; ++k) { const int kk = ks * 64 + k; a0 += sc[kk] * w[k]; a1 += sc[1024 + kk] * w[k]; a2 += sc[2048 + kk] * w[k]; a3 += sc[3072 + kk] * w[k]; a4 += sc[4096 + kk] * w[k]; }
        red[(ks * 5 + 0) * 32 + cl] = a0; red[(ks * 5 + 1) * 32 + cl] = a1; red[(ks * 5 + 2) * 32 + cl] = a2; red[(ks * 5 + 3) * 32 + cl] = a3; red[(ks * 5 + 4) * 32 + cl] = a4;
        __syncthreads();
        if (F.tid < 160) { const int s = F.tid >> 5, c = F.tid & 31; float v = F.in[I_BMOD][lm * 6144 + cg * 32 + c];
#pragma unroll
            for (int q = 0; q < 16; ++q) v += red[(q * 5 + s) * 32 + c];
            MOD[(size_t)(lm * 5 + s) * 6144 + cg * 32 + c] = v; }
        __syncthreads();
    }
}
__device__ __forceinline__ void p0_setup(const Fr& F) {
    mod_items(F, 0, F.blk, F.G);
    const int gi = F.blk * 512 + F.tid;
    if (gi < 1024) { const int dir = gi >> 9, j = gi & 511; const float* gm = F.in[dir ? I_GB : I_GF];
        const float g0 = gm[j], g1 = gm[512 + j], g2 = gm[1024 + j], g3 = gm[1536 + j], mx = fmaxf(fmaxf(g0, g1), fmaxf(g2, g3));
        const float e0 = __expf(g0 - mx), e1 = __expf(g1 - mx), e2 = __expf(g2 - mx), e3 = __expf(g3 - mx), inv = 1.0f / (e0 + e1 + e2 + e3);
        float* LBT = (float*)(F.ws + WS_LBT);
        LBT[(0 * 2 + dir) * 512 + j] = 0.f; LBT[(1 * 2 + dir) * 512 + j] = e1 * inv; LBT[(2 * 2 + dir) * 512 + j] = (e1 + e2) * inv; LBT[(3 * 2 + dir) * 512 + j] = (e1 + e2 + e3) * inv; }
    if (gi >= 1024 && gi < 1536) { const int idx = gi - 1024, pos = idx >> 3, i = idx & 7; const float ang = (float)pos * exp2f(-(float)i * 1.6609640474436813f);
        float* RP = (float*)(F.ws + WS_ROPE); RP[idx * 2] = __cosf(ang); RP[idx * 2 + 1] = __sinf(ang); }
}

__device__ __forceinline__ void tr_item(const float* wsrc  , int ldw, int K, bf16_t* WT  , int k0, LAS float* scr, int lane) {
#pragma unroll 8
    for (int i = 0; i < 32; ++i) { const int kk = 2 * i + (lane >> 5); scr[kk * 33 + (lane & 31)] = wsrc ? wsrc[(size_t)(k0 + kk) * ldw] : 0.f; }
    LDS_WAIT(); asm volatile("" ::: "memory");
    const int c = lane & 7;
#pragma unroll
    for (int j = 0; j < 4; ++j) { const int n = (lane >> 3) + 8 * j; const LAS float* s = scr + (8 * c) * 33 + n;
        u32x4 o; o.x = pk2(s[0 * 33], s[1 * 33]); o.y = pk2(s[2 * 33], s[3 * 33]); o.z = pk2(s[4 * 33], s[5 * 33]); o.w = pk2(s[6 * 33], s[7 * 33]);
        *(u32x4*)(WT + (size_t)n * K + k0 + 8 * c) = o; }
    LDS_WAIT(); asm volatile("" ::: "memory");
}
__device__ __forceinline__ void tr64_item(const float* src  , int ldw, bool valid, bf16_t* dst  , int K, LAS bf16_t* scr, int lane) {
    const int g = lane >> 4, n4 = (lane & 15) * 4; f32x4 v[16];
#pragma unroll
    for (int i = 0; i < 16; ++i) v[i] = valid ? *(const f32x4*)(src + (size_t)(16 * g + i) * ldw + n4) : (f32x4){0.f, 0.f, 0.f, 0.f};
#pragma unroll
    for (int c = 0; c < 4; ++c)
#pragma unroll
        for (int ip = 0; ip < 8; ++ip) *(LAS unsigned*)(scr + (n4 + c) * 72 + 16 * g + 2 * ip) = pk2(v[2 * ip][c], v[2 * ip + 1][c]);
    LDS_WAIT(); asm volatile("" ::: "memory");
#pragma unroll
    for (int j = 0; j < 8; ++j) { const int n = (lane >> 3) + 8 * j; *(u32x4*)(dst + (size_t)n * K + 8 * (lane & 7)) = *(const LAS u32x4*)(scr + n * 72 + 8 * (lane & 7)); }
    LDS_WAIT(); asm volatile("" ::: "memory");
}
constexpr int CV_IN = 16 * 84, CV_UQ = 6 * 24, CV_UKV = 4 * 16, CV_PA = 8 * 16, CV_PB = 8 * 16, CV_O = 16 * 16, CV_GU = 16 * 256, CV_DN = 16 * 128;
constexpr int CV_NITEMS = CV_IN + CV_UQ + CV_UKV + CV_PA + CV_PB + CV_O + CV_GU + CV_DN;
constexpr int CW_QHEAD = 8192, CW_ARR = 8192 + 64 * 8, CW_GCNT = 16384;
struct CvDesc { const float* src; const float* srcz; bf16_t* dst; int ldw, K; bool valid; bool edge; bool none; };
constexpr int CV_T64 = CV_GU + CV_DN + CV_IN + CV_O + CV_PA + CV_PB + CV_UKV;
__device__ __forceinline__ CvDesc cvt_decode(const Fr& F, int l, int it, unsigned char* wb) {
    CvDesc d; d.valid = true; d.edge = false; d.none = false; d.srcz = nullptr; int r = it; const int c4 = 4 * (F.lane & 15);
    if (r < CV_GU) { const int e = r >> 8, q = r & 255, kb = q >> 4, nb = q & 15, n0 = nb * 64, pn = n0 >> 8, w = n0 & 255;
        d.src = (w < 128 ? F.in[I_WG] : F.in[I_WU]) + ((size_t)(l * 16 + e) * 1024 + kb * 64) * 512 + 128 * pn + (w & 127); d.ldw = 512; d.K = 1024;
        d.dst = (bf16_t*)(wb + W_GU) + ((size_t)e * 1024 + n0) * 1024 + kb * 64; return d; } r -= CV_GU;
    if (r < CV_DN) { const int e = r >> 7, q = r & 127, kb = q >> 4, nb = q & 15;
        d.src = F.in[I_WD] + ((size_t)(l * 16 + e) * 512 + kb * 64) * 1024 + nb * 64; d.ldw = 1024; d.K = 512; d.dst = (bf16_t*)(wb + W_DN) + ((size_t)e * 1024 + nb * 64) * 512 + kb * 64; return d; } r -= CV_DN;
    if (r < CV_IN) { const int kb = r / 84, nb = r % 84;
        d.src = F.in[I_WIN] + ((size_t)l * 1024 + kb * 64) * IN_DIM + nb * 64; d.srcz = F.in[I_WIN] + ((size_t)l * 1024 + kb * 64) * IN_DIM; d.ldw = IN_DIM; d.K = 1024; d.valid = nb * 64 + c4 < IN_DIM; d.edge = nb * 64 + 32 == IN_DIM; d.none = nb * 64 >= IN_DIM; d.dst = (bf16_t*)(wb + W_IN) + (size_t)nb * 64 * 1024 + kb * 64; return d; } r -= CV_IN;
    if (r < CV_O) { const int kb = r >> 4, nb = r & 15;
        d.src = F.in[I_WO] + ((size_t)l * 1024 + kb * 64) * 1024 + nb * 64; d.ldw = 1024; d.K = 1024; d.dst = (bf16_t*)(wb + W_O) + (size_t)nb * 64 * 1024 + kb * 64; return d; } r -= CV_O;
    if (r < CV_PA) { const int kb = r >> 4, nb = r & 15;
        d.src = F.in[I_WPA] + ((size_t)l * 512 + kb * 64) * 1024 + nb * 64; d.ldw = 1024; d.K = 512; d.dst = (bf16_t*)(wb + W_PA) + (size_t)nb * 64 * 512 + kb * 64; return d; } r -= CV_PA;
    if (r < CV_PB) { const int kb = r >> 4, nb = r & 15;
        d.src = F.in[I_WPB] + ((size_t)l * 512 + kb * 64) * 1024 + nb * 64; d.ldw = 1024; d.K = 512; d.dst = (bf16_t*)(wb + W_PB) + (size_t)nb * 64 * 512 + kb * 64; return d; } r -= CV_PB;
    { const int kb = r >> 4, nb = r & 15;
        d.src = F.in[I_WUKV] + ((size_t)l * 256 + kb * 64) * 1024 + nb * 64; d.ldw = 1024; d.K = 256; d.dst = (bf16_t*)(wb + W_UKV) + (size_t)nb * 64 * 256 + kb * 64; return d; }
}
__device__ __forceinline__ void cvt_range(const Fr& F, int l, unsigned char* wb, int first, int stride, int end) {
    LAS float* scr = (LAS float*)(F.lds + F.wave * 16384); LAS bf16_t* scb = (LAS bf16_t*)scr;
    const int g = F.lane >> 4, n4 = (F.lane & 15) * 4;
    int it = first; CvDesc d; f32x4 v[16];
    if (it < end) { d = cvt_decode(F, l, it, wb);
#pragma unroll
        for (int i = 0; i < 16; ++i) v[i] = d.valid ? __builtin_nontemporal_load((const f32x4*)(d.src + (size_t)(16 * g + i) * d.ldw + n4)) : (f32x4){0.f, 0.f, 0.f, 0.f}; }
    while (it < end) {
        const int itn = it + stride; CvDesc dn = d; f32x4 vn[16];
        if (itn < end) { dn = cvt_decode(F, l, itn, wb);
#pragma unroll
            for (int i = 0; i < 16; ++i) vn[i] = dn.valid ? __builtin_nontemporal_load((const f32x4*)(dn.src + (size_t)(16 * g + i) * dn.ldw + n4)) : (f32x4){0.f, 0.f, 0.f, 0.f}; }
#pragma unroll
        for (int c = 0; c < 4; ++c)
#pragma unroll
            for (int ip = 0; ip < 8; ++ip) *(LAS unsigned*)(scb + (n4 + c) * 72 + 16 * g + 2 * ip) = pk2(v[2 * ip][c], v[2 * ip + 1][c]);
        LDS_WAIT(); asm volatile("" ::: "memory");
#pragma unroll
        for (int j = 0; j < 8; ++j) { const int n = (F.lane >> 3) + 8 * j; *(u32x4*)(d.dst + (size_t)n * d.K + 8 * (F.lane & 7)) = *(const LAS u32x4*)(scb + n * 72 + 8 * (F.lane & 7)); }
        LDS_WAIT(); asm volatile("" ::: "memory");
        it = itn; d = dn;
#pragma unroll
        for (int i = 0; i < 16; ++i) v[i] = vn[i];
    }
}
__device__ __forceinline__ void cvt_pull(const Fr& F, int l, unsigned char* wb, gu32*  ) {
    cvt_range(F, l, wb, F.gw, F.NGW, CV_T64);
    LAS float* scr = (LAS float*)(F.lds + F.wave * 16384); const int ln = F.lane & 31;
    for (int r = F.gw; r < CV_UQ; r += F.NGW) { const int kb = r / 24, nb = r % 24, n = nb * 32 + ln, h = n / 96, e = n - h * 96; const int sc = e < 64 ? n : h * 96 + 64 + ((e - 64) >> 4) * 16 + ((e - 64) & 1) * 8 + (((e - 64) & 15) >> 1);
        tr_item(F.in[I_WUQ] + (size_t)l * 384 * 768 + sc, 768, 384, (bf16_t*)(wb + W_UQ) + (size_t)nb * 32 * 384, kb * 64, scr, F.lane); }
}
__device__ __forceinline__ void cvt_issue(const CvDesc& d, int hf, f32x4 (&v)[8], int lane) { const int g = lane >> 3, n4 = 32 * hf + (lane & 7) * 4;
#pragma unroll
    for (int i = 0; i < 8; ++i) v[i] = (!d.none && !(d.edge && hf == 1)) ? *(const f32x4*)(d.src + (size_t)(8 * g + i) * d.ldw + n4) : (f32x4){0.f, 0.f, 0.f, 0.f}; }
__device__ __forceinline__ void cvt_finish(const CvDesc& d, int hf, const f32x4 (&v)[8], int lane) { const int g = lane >> 3, n4 = 32 * hf + (lane & 7) * 4;
#pragma unroll
    for (int cc = 0; cc < 4; ++cc) { u32x4 w; w.x = pk2(v[0][cc], v[1][cc]); w.y = pk2(v[2][cc], v[3][cc]); w.z = pk2(v[4][cc], v[5][cc]); w.w = pk2(v[6][cc], v[7][cc]);
        *(u32x4*)(d.dst + (size_t)(n4 + cc) * d.K + 8 * g) = w; } }
__device__ __forceinline__ void cvt_issue_q(const CvDesc& d, int qt, f32x4 (&v)[4], int lane) { const int g = lane >> 2, n4 = 16 * qt + (lane & 3) * 4; const bool ok = !d.none && !(d.edge && qt >= 2); const float* sp = ok ? d.src + n4 : d.srcz + (lane & 3) * 4;
#pragma unroll
    for (int i = 0; i < 4; ++i) v[i] = __builtin_nontemporal_load((const f32x4*)(sp + (size_t)(4 * g + i) * d.ldw)); }
__device__ __forceinline__ void cvt_finish_q(const CvDesc& d, int qt, const f32x4 (&v)[4], int lane) { const int g = lane >> 2, n4 = 16 * qt + (lane & 3) * 4; const unsigned keep = (!d.none && !(d.edge && qt >= 2)) ? 0xffffffffu : 0u;
#pragma unroll
    for (int cc = 0; cc < 4; ++cc) { u32x2 w; w.x = att::cvtpk(v[0][cc], v[1][cc]) & keep; w.y = att::cvtpk(v[2][cc], v[3][cc]) & keep; __builtin_nontemporal_store(w, (u32x2*)(d.dst + (size_t)(n4 + cc) * d.K + 4 * g)); } }
struct CvHook { static constexpr bool ACTIVE = true; const Fr& F; int l; unsigned char* wb; f32x4 v[4]; int q;
    static __device__ __forceinline__ int lane_now() { int t_; asm volatile("v_mbcnt_lo_u32_b32 %0, -1, 0\n\tv_mbcnt_hi_u32_b32 %0, -1, %0" : "=v"(t_)); return t_; }
    __device__ __forceinline__ void issue(int slot) { int qq = slot * F.NGW + F.gw; if (qq >= 4 * CV_T64) qq -= 4 * CV_T64; q = qq; const CvDesc d = cvt_decode(F, l, qq >> 2, wb); cvt_issue_q(d, qq & 3, v, lane_now()); }
    __device__ __forceinline__ void finish() { const CvDesc d = cvt_decode(F, l, q >> 2, wb); cvt_finish_q(d, q & 3, v, lane_now()); }
};
__device__ __forceinline__ void cvt_uq(const Fr& F, int l, unsigned char* wb) {
    LAS float* scr = (LAS float*)(F.lds + F.wave * 16384); const int ln = F.lane & 31;
    for (int r = F.gw; r < CV_UQ; r += F.NGW) { const int kb = r / 24, nb = r % 24, n = nb * 32 + ln, h = n / 96, e = n - h * 96; const int sc = e < 64 ? n : h * 96 + 64 + ((e - 64) >> 4) * 16 + ((e - 64) & 1) * 8 + (((e - 64) & 15) >> 1);
        tr_item(F.in[I_WUQ] + (size_t)l * 384 * 768 + sc, 768, 384, (bf16_t*)(wb + W_UQ) + (size_t)nb * 32 * 384, kb * 64, scr, F.lane); }
}
__device__ __forceinline__ void moe_tab(const Fr& F, int l) {
    LAS int* tab = (LAS int*)(F.lds + MOETAB_OFF); gu32* gc = (gu32*)(F.ws + WS_CTL) + CW_GCNT + 64 * l;
    if (F.tid < 16) tab[F.tid] = (int)__hip_atomic_load(gc + F.tid, RLX_AGENT);
    __syncthreads();
    if (F.tid == 0) { int run = 0;
#pragma unroll 1
        for (int e = 0; e < 16; ++e) { const int nt = (tab[e] + 255) >> 8; tab[16 + e] = run * 256;
#pragma clang loop vectorize(disable) unroll(disable)
            for (int j = 0; j < nt; ++j) tab[64 + run + j] = e;
            run += nt; }
        tab[48] = run; }
    __syncthreads();
}
template <int MODE> __device__ __forceinline__ void row_phase_a(const Fr& F, int l) {
    bf16_t* Z = (bf16_t*)(F.ws + WS_Z); const float* MOD = (const float*)(F.ws + WS_MOD);
    const LAS int* tab = (const LAS int*)(F.lds + MOETAB_OFF); if (MODE != 0) moe_tab(F, l - 1);
    for (int r0 = F.gw; r0 < M; r0 += 2 * F.NGW) {
        int rr[2], bb[2], tt[2], ms[2]; bool ok[2]; f32x4 v[2][4]; u32x2 ya[2][4], yc[2][4]; float w1[2], w2[2]; int s1[2], s2[2];
#pragma unroll
        for (int u = 0; u < 2; ++u) { rr[u] = r0 + u * F.NGW; ok[u] = rr[u] < M; const int rc = ok[u] ? rr[u] : 0; bb[u] = rc / TPB; tt[u] = rc - bb[u] * TPB; ms[u] = tt[u] < CTX ? 4 : bb[u];
            if (MODE == 2 && tt[u] < CTX) ok[u] = false;
            if (MODE != 0 && ok[u]) { const int* rt = (const int*)(F.ws + WS_ROUTE) + 8 * rr[u]; s1[u] = tab[16 + rt[0]] + rt[2]; s2[u] = tab[16 + rt[1]] + rt[3]; w1[u] = __int_as_float(rt[4]); w2[u] = __int_as_float(rt[5]); } }
#pragma unroll
        for (int u = 0; u < 2; ++u) if (ok[u]) {
            if (MODE == 0) { const f32x4* src = (const f32x4*)(tt[u] < CTX ? F.in[I_CTX] + (size_t)(bb[u] * CTX + tt[u]) * 1024 : F.in[I_X] + (size_t)(bb[u] * SEQ + tt[u] - CTX) * 1024) + F.lane;
#pragma unroll
                for (int j = 0; j < 4; ++j) v[u][j] = src[64 * j]; }
            else { const u32x2* zr = (const u32x2*)(Z + (size_t)rr[u] * 1024) + F.lane;
                const u32x2* y1 = (const u32x2*)((const bf16_t*)(F.ws + WS_Y) + (size_t)s1[u] * 1024) + F.lane; const u32x2* y2 = (const u32x2*)((const bf16_t*)(F.ws + WS_Y) + (size_t)s2[u] * 1024) + F.lane;
#pragma unroll
                for (int j = 0; j < 4; ++j) { const u32x2 zz = zr[64 * j]; v[u][j] = (f32x4){bflo(zz.x), bfhi(zz.x), bflo(zz.y), bfhi(zz.y)}; ya[u][j] = y1[64 * j]; yc[u][j] = y2[64 * j]; } } }
#pragma unroll
        for (int u = 0; u < 2; ++u) if (ok[u]) {
            if (MODE != 0) { const f32x4* g5 = (const f32x4*)(MOD + (size_t)((l - 1) * 5 + ms[u]) * 6144 + 5 * 1024) + F.lane;
#pragma unroll
                for (int j = 0; j < 4; ++j) { const u32x2 a = ya[u][j], c = yc[u][j]; const float p = w1[u], q = w2[u];
                    const f32x4 f = (f32x4){p * bflo(a.x) + q * bflo(c.x), p * bfhi(a.x) + q * bfhi(c.x), p * bflo(a.y) + q * bflo(c.y), p * bfhi(a.y) + q * bfhi(c.y)};
                    v[u][j] = v[u][j] + g5[64 * j] * f; } }
            if (MODE != 2) { u32x2* zw = (u32x2*)(Z + (size_t)rr[u] * 1024) + F.lane;
#pragma unroll
                for (int j = 0; j < 4; ++j) { u32x2 w; w.x = pk2(v[u][j].x, v[u][j].y); w.y = pk2(v[u][j].z, v[u][j].w); zw[64 * j] = w; } }
            float ss = 0.f;
#pragma unroll
            for (int j = 0; j < 4; ++j) ss += (v[u][j].x * v[u][j].x + v[u][j].y * v[u][j].y) + (v[u][j].z * v[u][j].z + v[u][j].w * v[u][j].w);
            const float rstd = 1.0f / sqrtf(wave_sum(ss, F.lane) * (1.0f / 1024.0f) + EPS);
            if (MODE == 2) { const f32x4* fg = (const f32x4*)F.in[I_FG] + F.lane; f32x4* o = (f32x4*)(F.out + (size_t)(bb[u] * SEQ + tt[u] - CTX) * 1024) + F.lane;
#pragma unroll
                for (int j = 0; j < 4; ++j) o[64 * j] = v[u][j] * rstd * fg[64 * j]; }
            else { const f32x4* g1 = (const f32x4*)(F.in[I_N1G] + l * 1024) + F.lane; const f32x4* sh = (const f32x4*)(MOD + (size_t)(l * 5 + ms[u]) * 6144) + F.lane; const f32x4* scl = sh + 256;
                u32x2* h = (u32x2*)((bf16_t*)(F.ws + WS_H) + (size_t)rr[u] * 1024) + F.lane;
#pragma unroll
                for (int j = 0; j < 4; ++j) { const f32x4 y = v[u][j] * rstd * g1[64 * j] * (1.0f + scl[64 * j]) + sh[64 * j]; u32x2 w; w.x = pk2(y.x, y.y); w.y = pk2(y.z, y.w); h[64 * j] = w; } } }
    }
}

__device__ __forceinline__ void scan_naive(const Fr& F, int l, int item) {
    const int dir = item & 1, h = (item >> 1) & 3, b = item >> 3;
    const bf16_t* P = (const bf16_t*)(F.ws + WS_P); bf16_t* O = (bf16_t*)(F.ws + (dir ? WS_OB : WS_OF));
    LAS float* qs = (LAS float*)F.lds; LAS float* fs = qs + 2048; LAS float* vs = fs + 2048; LAS float* os = vs + 2048;
    const int v = F.tid & 127, kq = F.tid >> 7;
    const float lb = ((const float*)(F.ws + WS_LBT))[(l * 2 + dir) * 512 + h * 128 + v];
    const int cf = dir ? C_FB : C_FF;
    float S[32];
#pragma unroll
    for (int i = 0; i < 32; ++i) S[i] = 0.f;
    for (int s0 = 0; s0 < TPB; s0 += 16) {
#pragma unroll
        for (int j = 0; j < 4; ++j) { const int tt = kq + 4 * j, s = s0 + tt; const int t = dir ? (s < CTX ? CTX - 1 - s : CTX + TPB - 1 - s) : s;
            const bf16_t* pr = P + (size_t)(b * TPB + t) * INP + h * 128 + v;
            qs[tt * 128 + v] = bf1(pr[C_Q]); vs[tt * 128 + v] = bf1(pr[C_I]); fs[tt * 128 + v] = lb + (1.0f - lb) * sigm(bf1(pr[cf])); }
        __syncthreads();
#pragma unroll 1
        for (int tt = 0; tt < 16; ++tt) { const float iv = vs[tt * 128 + v]; float o = 0.f;
#pragma unroll
            for (int k4 = 0; k4 < 8; ++k4) { const f32x4 f = *(const LAS f32x4*)(fs + tt * 128 + kq * 32 + 4 * k4), q = *(const LAS f32x4*)(qs + tt * 128 + kq * 32 + 4 * k4);
                S[4 * k4 + 0] = f.x * S[4 * k4 + 0] + (1.0f - f.x) * iv; o += q.x * S[4 * k4 + 0];
                S[4 * k4 + 1] = f.y * S[4 * k4 + 1] + (1.0f - f.y) * iv; o += q.y * S[4 * k4 + 1];
                S[4 * k4 + 2] = f.z * S[4 * k4 + 2] + (1.0f - f.z) * iv; o += q.z * S[4 * k4 + 2];
                S[4 * k4 + 3] = f.w * S[4 * k4 + 3] + (1.0f - f.w) * iv; o += q.w * S[4 * k4 + 3]; }
            os[(tt * 4 + kq) * 128 + v] = o; }
        __syncthreads();
#pragma unroll
        for (int j = 0; j < 4; ++j) { const int tt = kq + 4 * j, s = s0 + tt; const int t = dir ? (s < CTX ? CTX - 1 - s : CTX + TPB - 1 - s) : s;
            const float o = (os[(tt * 4 + 0) * 128 + v] + os[(tt * 4 + 1) * 128 + v]) + (os[(tt * 4 + 2) * 128 + v] + os[(tt * 4 + 3) * 128 + v]);
            O[(size_t)(b * TPB + t) * 512 + h * 128 + v] = (bf16_t)f2bf(o); }
        __syncthreads();
    }
}
namespace hg {
typedef short bf16x8 __attribute__((ext_vector_type(8)));
typedef short s16x4 __attribute__((ext_vector_type(4)));
constexpr int NSC = 16, NITEM = 32 * NSC, QP = 136  , TP = 40  ;
constexpr int L_QS = 0, L_KS = 8704, L_KT = 17408, L_VT = 27648, L_DL = 37888, L_PQ = 38400;
__device__ __forceinline__ int tok_row(int b, int dir, int s) { const int t = dir ? (s < CTX ? CTX - 1 - s : CTX + TPB - 1 - s) : s; return b * TPB + t; }
__device__ __forceinline__ bf16x8 cat8(s16x4 lo, s16x4 hi) { return (bf16x8){lo[0], lo[1], lo[2], lo[3], hi[0], hi[1], hi[2], hi[3]}; }
typedef float f32x2_t __attribute__((ext_vector_type(2))); typedef __bf16 bf16x2_t __attribute__((ext_vector_type(2)));
__device__ __forceinline__ unsigned cvtpk(float lo, float hi) { f32x2_t v = {lo, hi}; bf16x2_t b = __builtin_convertvector(v, bf16x2_t); return __builtin_bit_cast(unsigned, b); }
__device__ __forceinline__ bf16x8 pack88(f32x4 a, f32x4 b) { u32x4 w; w.x = cvtpk(a[0], a[1]); w.y = cvtpk(a[2], a[3]); w.z = cvtpk(b[0], b[1]); w.w = cvtpk(b[2], b[3]); return __builtin_bit_cast(bf16x8, w); }
#define HG_MFMA(a, b, c) __builtin_amdgcn_mfma_f32_16x16x32_bf16(a, b, c, 0, 0, 0)
__device__ __forceinline__ float fsig(float x) { return __builtin_amdgcn_rcpf(1.0f + __builtin_amdgcn_exp2f(-1.4426950408889634f * x)); }
__device__ __forceinline__ int sc_nch(int sc) { return sc == 0 ? 8 : ((sc <= 4 || sc >= 12) ? 9 : 8); }
__device__ __forceinline__ int sc_base(int sc) { return sc == 0 ? 0 : (sc <= 4 ? CTX + 288 * (sc - 1) : (sc <= 11 ? CTX + 1152 + 256 * (sc - 5) : CTX + 2944 + 288 * (sc - 12))); }
constexpr int L_SSB = 42496, L_OL = 43520, OLP = 132;
template <int MODE> __device__ __forceinline__ void scan_dir(const Fr& F, int l, int b, int h, int dir, int sc, int cvl, int cvit, int cvst, unsigned char* cvwb) {
    constexpr bool P3 = MODE != 0;
    const int item = ((b * 4 + h) * 2 + dir) * NSC + sc, NCH = sc_nch(sc), sbase = sc_base(sc);
    const bf16_t* P = (const bf16_t*)(F.ws + WS_P);
    float* St = (float*)(F.ws + WS_ST) + (size_t)item * 16384; float* Dg = (float*)(F.ws + WS_SD) + item * 128;
    LAS bf16_t* qs = (LAS bf16_t*)(F.lds + L_QS); LAS bf16_t* ks = (LAS bf16_t*)(F.lds + L_KS); LAS bf16_t* kT = (LAS bf16_t*)(F.lds + L_KT); LAS bf16_t* vT = (LAS bf16_t*)(F.lds + L_VT);
    LAS float* dl = (LAS float*)(F.lds + L_DL); LAS float* pq = (LAS float*)(F.lds + L_PQ);
    LAS float* ssb = (LAS float*)(F.lds + L_SSB); LAS bf16_t* OL = (LAS bf16_t*)(F.lds + L_OL);
    const int kp = F.tid & 63, tg = F.tid >> 6, k0 = 2 * kp, g = F.lane >> 4, c16 = F.lane & 15, vs = 16 * F.wave;
    const f32x2 lb = *(const f32x2*)((const float*)(F.ws + WS_LBT) + (l * 2 + dir) * 512 + h * 128 + k0);
    const int cfo = dir ? C_FB : C_FF;
    const int kperm = (k0 & ~31) | (((k0 & 15) >> 2) << 3) | (((k0 >> 4) & 1) << 2) | (k0 & 3);
    const int tslot = (tg & 3) * 8 + (tg >> 2) * 4;
    const long rstep = dir ? -(long)INP : (long)INP;
    f32x4 S[8];
#pragma unroll
    for (int kt = 0; kt < 8; ++kt) {
        if (P3) {
#pragma unroll
            for (int i = 0; i < 4; ++i) S[kt][i] = St[(16 * kt + 4 * g + i) * 128 + vs + c16]; }
        else S[kt] = (f32x4){0.f, 0.f, 0.f, 0.f}; }
    float D0 = 1.0f, D1 = 1.0f;
    unsigned rf[4], rq[4], rv[4], nf[4], nq[4], nv[4];
    const bf16_t* pld = P + (size_t)tok_row(b, dir, sbase + 4 * tg) * INP + h * 128 + k0;
#define HG_LOAD(F_, Q_, V_) do { const bf16_t* pr = pld; _Pragma("unroll") for (int j = 0; j < 4; ++j) { \
        F_[j] = *(const unsigned*)(pr + cfo); V_[j] = *(const unsigned*)(pr + C_I); if (P3) Q_[j] = *(const unsigned*)(pr + C_Q); pr += rstep; } pld += 32 * rstep; } while (0)
    HG_LOAD(rf, rq, rv); HG_LOAD(nf, nq, nv);
    const size_t row0 = (size_t)tok_row(b, dir, sbase + c16); const long tstep = dir ? -1L : 1L;
    const bf16_t* gp = P + row0 * INP + C_G + h * 128 + vs + 4 * g; bf16_t* ap = (bf16_t*)(F.ws + WS_A) + row0 * 512 + h * 128 + vs + 4 * g;
    int tau = MODE == 2 ? 32 * NCH - 1 - c16 : c16;
    const bool cvon = MODE == 0 && cvl >= 0; CvDesc cvd; f32x4 cvv[8]; bool cvload = false; int cvh = 0;
    f32x4 gn4 = {0.f, 0.f, 0.f, 0.f}; if (MODE == 2) gn4 = *(const f32x4*)(F.in[I_HGG] + l * 512 + h * 128 + vs + 4 * g);
#pragma unroll 1
    for (int ch = 0; ch < NCH; ++ch) {
        if (cvon && (ch & 1) == 0) { if (cvload) { cvt_finish(cvd, cvh, cvv, F.lane); cvload = false; }
            const int hi = cvit + (ch >> 1) * cvst; if (ch < 8 && hi < 2 * CV_T64) { cvd = cvt_decode(F, cvl, hi >> 1, cvwb); cvh = hi & 1; cvt_issue(cvd, cvh, cvv, F.lane); cvload = true; } }
        float c0 = 1.0f, c1 = 1.0f, cp0[4], cp1[4], kf0[4], kf1[4];
#pragma unroll
        for (int j = 0; j < 4; ++j) { const float f0 = lb.x + (1.0f - lb.x) * fsig(bflo(rf[j])), f1 = lb.y + (1.0f - lb.y) * fsig(bfhi(rf[j])); c0 *= f0; c1 *= f1; cp0[j] = c0; cp1[j] = c1; kf0[j] = 1.0f - f0; kf1[j] = 1.0f - f1; }
        *(LAS f32x2*)(pq + tg * 128 + k0) = (f32x2){c0, c1};
        __syncthreads();
        float pre0 = 1.0f, pre1 = 1.0f, tot0 = 1.0f, tot1 = 1.0f;
#pragma unroll
        for (int t = 0; t < 8; ++t) { const f32x2 p = *(const LAS f32x2*)(pq + t * 128 + k0); if (t < tg) { pre0 *= p.x; pre1 *= p.y; } tot0 *= p.x; tot1 *= p.y; }
        if (tg == 0) *(LAS f32x2*)(dl + k0) = (f32x2){tot0, tot1};
        D0 *= tot0; D1 *= tot1;
        float ka0[4], ka1[4];
#pragma unroll
        for (int j = 0; j < 4; ++j) { cp0[j] *= pre0; cp1[j] *= pre1; ka0[j] = kf0[j] * __builtin_amdgcn_rcpf(cp0[j]); ka1[j] = kf1[j] * __builtin_amdgcn_rcpf(cp1[j]); }
        if (P3) {
#pragma unroll
            for (int j = 0; j < 4; ++j) { *(LAS unsigned*)(qs + (4 * tg + j) * QP + kperm) = cvtpk(bflo(rq[j]) * cp0[j], bfhi(rq[j]) * cp1[j]); *(LAS unsigned*)(ks + (4 * tg + j) * QP + kperm) = cvtpk(ka0[j], ka1[j]); } }
        { u32x2 w; w.x = cvtpk(ka0[0], ka0[1]); w.y = cvtpk(ka0[2], ka0[3]); *(LAS u32x2*)(kT + k0 * TP + tslot) = w; w.x = cvtpk(ka1[0], ka1[1]); w.y = cvtpk(ka1[2], ka1[3]); *(LAS u32x2*)(kT + (k0 + 1) * TP + tslot) = w;
          w.x = (rv[0] & 0xffffu) | (rv[1] << 16); w.y = (rv[2] & 0xffffu) | (rv[3] << 16); *(LAS u32x2*)(vT + k0 * TP + tslot) = w;
          w.x = (rv[0] >> 16) | (rv[1] & 0xffff0000u); w.y = (rv[2] >> 16) | (rv[3] & 0xffff0000u); *(LAS u32x2*)(vT + (k0 + 1) * TP + tslot) = w; }
#pragma unroll
        for (int j = 0; j < 4; ++j) { rf[j] = nf[j]; rv[j] = nv[j]; if (P3) rq[j] = nq[j]; }
        if (ch + 2 < NCH) HG_LOAD(nf, nq, nv);
        __syncthreads();
        const bf16x8 vf = *(const LAS bf16x8*)(vT + (vs + c16) * TP + 8 * g);
        f32x4 o0 = {0.f, 0.f, 0.f, 0.f}, o1 = o0;
        if (P3) {
            bf16x8 qf[2][4], ka[2][4];
#pragma unroll
            for (int t2 = 0; t2 < 2; ++t2)
#pragma unroll
                for (int kb = 0; kb < 4; ++kb) { qf[t2][kb] = *(const LAS bf16x8*)(qs + (16 * t2 + c16) * QP + 32 * kb + 8 * g); ka[t2][kb] = *(const LAS bf16x8*)(ks + (16 * t2 + c16) * QP + 32 * kb + 8 * g); }
            f32x4 a00 = {0.f, 0.f, 0.f, 0.f}, a01 = a00, a11 = a00;
#pragma unroll
            for (int kb = 0; kb < 4; ++kb) { a00 = HG_MFMA(ka[0][kb], qf[0][kb], a00); a01 = HG_MFMA(ka[0][kb], qf[1][kb], a01); a11 = HG_MFMA(ka[1][kb], qf[1][kb], a11); }
#pragma unroll
            for (int i = 0; i < 4; ++i) { if (c16 < 4 * g + i) { a00[i] = 0.f; a11[i] = 0.f; } }
            const bf16x8 B0 = pack88(a00, (f32x4){0.f, 0.f, 0.f, 0.f}), B1 = pack88(a01, a11);
#pragma unroll
            for (int kb = 0; kb < 4; ++kb) { const bf16x8 Sf = pack88(S[2 * kb], S[2 * kb + 1]); o0 = HG_MFMA(Sf, qf[0][kb], o0); o1 = HG_MFMA(Sf, qf[1][kb], o1); }
            o0 = HG_MFMA(vf, B0, o0); o1 = HG_MFMA(vf, B1, o1);
            if (MODE == 1) { u32x2 w0, w1; w0.x = cvtpk(o0[0], o0[1]); w0.y = cvtpk(o0[2], o0[3]); w1.x = cvtpk(o1[0], o1[1]); w1.y = cvtpk(o1[2], o1[3]);
                *(LAS u32x2*)(OL + tau * OLP + vs + 4 * g) = w0; *(LAS u32x2*)(OL + (tau + 16) * OLP + vs + 4 * g) = w1; tau += 32; }
        }
#pragma unroll
        for (int kt = 0; kt < 8; ++kt) { const bf16x8 kTf = *(const LAS bf16x8*)(kT + (16 * kt + c16) * TP + 8 * g);
            S[kt] = HG_MFMA(kTf, vf, S[kt]); S[kt] = S[kt] * *(const LAS f32x4*)(dl + 16 * kt + 4 * g); }
        if (MODE == 2) {
            const u32x2 f0 = *(const LAS u32x2*)(OL + tau * OLP + vs + 4 * g), f1 = *(const LAS u32x2*)(OL + (tau - 16) * OLP + vs + 4 * g);
            o0 += (f32x4){bflo(f0.x), bfhi(f0.x), bflo(f0.y), bfhi(f0.y)}; o1 += (f32x4){bflo(f1.x), bfhi(f1.x), bflo(f1.y), bfhi(f1.y)};
            float s0 = (o0[0] * o0[0] + o0[1] * o0[1]) + (o0[2] * o0[2] + o0[3] * o0[3]), s1 = (o1[0] * o1[0] + o1[1] * o1[1]) + (o1[2] * o1[2] + o1[3] * o1[3]);
            s0 += lane_xor(s0, F.lane, 16); s0 += lane_xor(s0, F.lane, 32); s1 += lane_xor(s1, F.lane, 16); s1 += lane_xor(s1, F.lane, 32);
            if (g == 0) { ssb[F.wave * 32 + c16] = s0; ssb[F.wave * 32 + 16 + c16] = s1; }
            const u32x2 g0 = *(const u32x2*)gp, g1 = *(const u32x2*)(gp + 16 * tstep * INP);
            __syncthreads();
            float t0 = 0.f, t1 = 0.f;
#pragma unroll
            for (int w = 0; w < 8; ++w) { t0 += ssb[w * 32 + c16]; t1 += ssb[w * 32 + 16 + c16]; }
            const float r0 = 1.0f / sqrtf(t0 * (1.0f / 128.0f) + EPS), r1 = 1.0f / sqrtf(t1 * (1.0f / 128.0f) + EPS);
            const f32x4 gg0 = {bflo(g0.x), bfhi(g0.x), bflo(g0.y), bfhi(g0.y)}, gg1 = {bflo(g1.x), bfhi(g1.x), bflo(g1.y), bfhi(g1.y)};
            f32x4 y0, y1;
#pragma unroll
            for (int i = 0; i < 4; ++i) { y0[i] = o0[i] * r0 * gn4[i] * (gg0[i] * fsig(gg0[i])); y1[i] = o1[i] * r1 * gn4[i] * (gg1[i] * fsig(gg1[i])); }
            u32x2 w0, w1; w0.x = cvtpk(y0[0], y0[1]); w0.y = cvtpk(y0[2], y0[3]); w1.x = cvtpk(y1[0], y1[1]); w1.y = cvtpk(y1[2], y1[3]);
            *(u32x2*)ap = w0; *(u32x2*)(ap + 16 * tstep * 512) = w1;
            gp += 32 * tstep * INP; ap += 32 * tstep * 512; tau -= 32;
        }
    }
    if (cvon && cvload) cvt_finish(cvd, cvh, cvv, F.lane);
    __syncthreads();
#undef HG_LOAD
    if (MODE == 0) {
#pragma unroll
        for (int kt = 0; kt < 8; ++kt)
#pragma unroll
            for (int i = 0; i < 4; ++i) St[(16 * kt + 4 * g + i) * 128 + vs + c16] = S[kt][i];
        if (tg == 0) *(f32x2*)(Dg + k0) = (f32x2){D0, D1}; }
}
#undef HG_MFMA
__device__ __forceinline__ void scan_pass2(const Fr& F) {
    float* St = (float*)(F.ws + WS_ST); const float* Dg = (const float*)(F.ws + WS_SD);
    for (int idx = F.blk * 512 + F.tid; idx < 32 * 4096; idx += F.G * 512) { const int seq = idx >> 12, e4 = idx & 4095, kk = e4 >> 5;
        float z = 0.f; asm volatile("" : "+v"(z));
        f32x4 S = {z, z, z, z};
#pragma unroll
        for (int sc = 0; sc < NSC; ++sc) { f32x4* up = (f32x4*)(St + (size_t)(seq * NSC + sc) * 16384) + e4; const f32x4 u = *up; const float d = Dg[(seq * NSC + sc) * 128 + kk]; *up = S; S = S * d + u; } }
}
}
__device__ __forceinline__ void mla_prep(const Fr& F, int l, int gw, int ngw) {
    const bf16_t* P = (const bf16_t*)(F.ws + WS_P); const float* RP = (const float*)(F.ws + WS_ROPE);
    bf16_t* DQN = (bf16_t*)(F.ws + WS_DQN); bf16_t* DKVN = (bf16_t*)(F.ws + WS_DKVN); bf16_t* Kb = (bf16_t*)(F.ws + WS_K);
    const float* qg = F.in[I_QNG] + l * 384; const float* kg = F.in[I_KVNG] + l * 256;
    const f32x2 g0 = ((const f32x2*)qg)[F.lane], g1 = ((const f32x2*)qg)[F.lane + 64], g2 = ((const f32x2*)qg)[F.lane + 128]; const f32x4 gk = ((const f32x4*)kg)[F.lane];
    const int ax = (F.lane >> 3) & 1, i = F.lane & 7;
    for (int r0 = gw; r0 < M; r0 += 4 * ngw) {
        unsigned q0[4], q1[4], q2[4]; u32x2 kv[4]; bf16_t p1[4], p2[4];
#pragma unroll
        for (int u = 0; u < 4; ++u) { const int r = r0 + u * ngw; if (r < M) { const bf16_t* pr = P + (size_t)r * INP; const unsigned* src = (const unsigned*)(pr + C_DQ) + F.lane;
            q0[u] = src[0]; q1[u] = src[64]; q2[u] = src[128]; kv[u] = ((const u32x2*)(pr + C_DKV))[F.lane]; p1[u] = pr[C_KPE + ax * 16 + i]; p2[u] = pr[C_KPE + ax * 16 + 8 + i]; } }
#pragma unroll
        for (int u = 0; u < 4; ++u) { const int r = r0 + u * ngw; if (r < M) { const int b = r / TPB, t = r - b * TPB;
            { const float x0 = bflo(q0[u]), x1 = bfhi(q0[u]), x2 = bflo(q1[u]), x3 = bfhi(q1[u]), x4 = bflo(q2[u]), x5 = bfhi(q2[u]);
              const float rstd = 1.0f / sqrtf(wave_sum((x0 * x0 + x1 * x1) + (x2 * x2 + x3 * x3) + (x4 * x4 + x5 * x5), F.lane) * (1.0f / 384.0f) + EPS);
              unsigned* dst = (unsigned*)(DQN + (size_t)r * 384) + F.lane;
              dst[0] = pk2(x0 * rstd * g0.x, x1 * rstd * g0.y); dst[64] = pk2(x2 * rstd * g1.x, x3 * rstd * g1.y); dst[128] = pk2(x4 * rstd * g2.x, x5 * rstd * g2.y); }
            { const float x0 = bflo(kv[u].x), x1 = bfhi(kv[u].x), x2 = bflo(kv[u].y), x3 = bfhi(kv[u].y);
              const float rstd = 1.0f / sqrtf(wave_sum((x0 * x0 + x1 * x1) + (x2 * x2 + x3 * x3), F.lane) * (1.0f / 256.0f) + EPS);
              u32x2 w; w.x = pk2(x0 * rstd * gk.x, x1 * rstd * gk.y); w.y = pk2(x2 * rstd * gk.z, x3 * rstd * gk.w);
              ((u32x2*)(DKVN + (size_t)r * 256))[F.lane] = w; }
            if (F.lane < 16) { float x1 = bf1(p1[u]), x2 = bf1(p2[u]);
                if (t >= CTX) { const int p = t - CTX, pos = ax ? (p & 63) : (p >> 6); const float c = RP[(pos * 8 + i) * 2], sn = RP[(pos * 8 + i) * 2 + 1]; const float y1 = x1 * c - x2 * sn, y2 = x1 * sn + x2 * c; x1 = y1; x2 = y2; }
                const unsigned w = pk2(x1, x2);
#pragma unroll
                for (int hh = 0; hh < 8; ++hh) *(unsigned*)(Kb + ((size_t)(b * 8 + hh) * TPB + t) * 96 + 64 + ax * 16 + 2 * i) = w; } } }
    }
}
__device__ __forceinline__ void hg_readout(const Fr& F, int l) {
    const bf16_t* P = (const bf16_t*)(F.ws + WS_P); const bf16_t* OF = (const bf16_t*)(F.ws + WS_OF); const bf16_t* OB = (const bf16_t*)(F.ws + WS_OB); bf16_t* A = (bf16_t*)(F.ws + WS_A);
    const float* gain = F.in[I_HGG] + l * 512;
    const f32x4 ga = ((const f32x4*)gain)[2 * F.lane], gb = ((const f32x4*)gain)[2 * F.lane + 1]; const float gn[8] = {ga.x, ga.y, ga.z, ga.w, gb.x, gb.y, gb.z, gb.w};
    for (int r0 = F.gw; r0 < M; r0 += 4 * F.NGW) {
        u32x4 a4[4], c4[4], g4[4];
#pragma unroll
        for (int u = 0; u < 4; ++u) { const int r = r0 + u * F.NGW; if (r < M) { a4[u] = ((const u32x4*)(OF + (size_t)r * 512))[F.lane]; c4[u] = ((const u32x4*)(OB + (size_t)r * 512))[F.lane]; g4[u] = ((const u32x4*)(P + (size_t)r * INP + C_G))[F.lane]; } }
#pragma unroll
        for (int u = 0; u < 4; ++u) { const int r = r0 + u * F.NGW; if (r < M) { const u32x4 a = a4[u], c = c4[u], g = g4[u];
            float o[8] = {bflo(a.x) + bflo(c.x), bfhi(a.x) + bfhi(c.x), bflo(a.y) + bflo(c.y), bfhi(a.y) + bfhi(c.y), bflo(a.z) + bflo(c.z), bfhi(a.z) + bfhi(c.z), bflo(a.w) + bflo(c.w), bfhi(a.w) + bfhi(c.w)};
            const float gg[8] = {bflo(g.x), bfhi(g.x), bflo(g.y), bfhi(g.y), bflo(g.z), bfhi(g.z), bflo(g.w), bfhi(g.w)};
            float ss = 0.f;
#pragma unroll
            for (int i = 0; i < 8; ++i) ss += o[i] * o[i];
            ss += lane_xor(ss, F.lane, 1); ss += lane_xor(ss, F.lane, 2); ss += lane_xor(ss, F.lane, 4); ss += lane_xor(ss, F.lane, 8);
            const float rstd = 1.0f / sqrtf(ss * (1.0f / 128.0f) + EPS);
#pragma unroll
            for (int i = 0; i < 8; ++i) o[i] = o[i] * rstd * gn[i] * (gg[i] * sigm(gg[i]));
            u32x4 w; w.x = pk2(o[0], o[1]); w.y = pk2(o[2], o[3]); w.z = pk2(o[4], o[5]); w.w = pk2(o[6], o[7]);
            ((u32x4*)(A + (size_t)r * 512))[F.lane] = w; } }
    }
}
__device__ __forceinline__ void top2of4(float a, float b, float c, float d, int& i1, int& i2) {
    float bv = a; i1 = 0; if (b > bv) { bv = b; i1 = 1; } if (c > bv) { bv = c; i1 = 2; } if (d > bv) { bv = d; i1 = 3; }
    const float NI = -3.0e38f; const float a2 = i1 == 0 ? NI : a, b2 = i1 == 1 ? NI : b, c2 = i1 == 2 ? NI : c, d2 = i1 == 3 ? NI : d;
    bv = a2; i2 = 0; if (b2 > bv) { bv = b2; i2 = 1; } if (c2 > bv) { bv = c2; i2 = 2; } if (d2 > bv) { bv = d2; i2 = 3; }
}
__device__ __forceinline__ float sel4(int i, float a, float b, float c, float d) { return i == 0 ? a : (i == 1 ? b : (i == 2 ? c : d)); }
__device__ __forceinline__ void norm2_route(const Fr& F, int l, int skip_ctx) {
    LAS float* wrT = (LAS float*)F.lds; LAS int* hist = (LAS int*)(F.lds + 65536); LAS int* gbase = hist + 16;
    { f32x4 wv[8];
#pragma unroll
      for (int j = 0; j < 8; ++j) wv[j] = ((const f32x4*)F.in[I_WR])[512 * j + F.tid];
#pragma unroll
      for (int j = 0; j < 8; ++j) { const int i4 = 512 * j + F.tid, k = i4 >> 2, e0 = (i4 & 3) * 4;
          wrT[(e0 + 0) * 1024 + k] = wv[j].x; wrT[(e0 + 1) * 1024 + k] = wv[j].y; wrT[(e0 + 2) * 1024 + k] = wv[j].z; wrT[(e0 + 3) * 1024 + k] = wv[j].w; } }
    if (F.tid < 16) hist[F.tid] = 0;
    __syncthreads();
    const bf16_t* Z = (const bf16_t*)(F.ws + WS_Z); const float* MOD = (const float*)(F.ws + WS_MOD);
    LAS float* lg = (LAS float*)(hist + 64);
    f32x4 g2v[4];
#pragma unroll
    for (int j = 0; j < 4; ++j) g2v[j] = ((const f32x4*)(F.in[I_N2G] + l * 1024))[F.lane + 64 * j];
    int ri = 0; u32x2 vn[4];
    { const u32x2* zr = (const u32x2*)(Z + (size_t)F.gw * 1024) + F.lane;
#pragma unroll
      for (int j = 0; j < 4; ++j) vn[j] = zr[64 * j]; }
    for (int r = F.gw; r < M; r += F.NGW, ++ri) {
        const int b = r / TPB, t = r - b * TPB, ms = t < CTX ? 4 : b;
        f32x4 v[4]; float ss = 0.f;
#pragma unroll
        for (int j = 0; j < 4; ++j) v[j] = (f32x4){bflo(vn[j].x), bfhi(vn[j].x), bflo(vn[j].y), bfhi(vn[j].y)};
        if (r + F.NGW < M) { const u32x2* zr = (const u32x2*)(Z + (size_t)(r + F.NGW) * 1024) + F.lane;
#pragma unroll
            for (int j = 0; j < 4; ++j) vn[j] = zr[64 * j]; }
        if (skip_ctx && t < CTX) continue;
        const f32x4* sh = (const f32x4*)(MOD + (size_t)(l * 5 + ms) * 6144 + 3 * 1024) + F.lane; const f32x4* scl = sh + 256;
        f32x4 shv[4], scv[4];
#pragma unroll
        for (int j = 0; j < 4; ++j) { shv[j] = sh[64 * j]; scv[j] = scl[64 * j]; }
#pragma unroll
        for (int j = 0; j < 4; ++j) ss += (v[j].x * v[j].x + v[j].y * v[j].y) + (v[j].z * v[j].z + v[j].w * v[j].w);
        const float rstd = 1.0f / sqrtf(wave_sum(ss, F.lane) * (1.0f / 1024.0f) + EPS);
        u32x2* h = (u32x2*)((bf16_t*)(F.ws + WS_H) + (size_t)r * 1024) + F.lane;
#pragma unroll
        for (int j = 0; j < 4; ++j) { v[j] = v[j] * rstd * g2v[j] * (1.0f + scv[j]) + shv[j]; u32x2 w; w.x = pk2(v[j].x, v[j].y); w.y = pk2(v[j].z, v[j].w); h[64 * j] = w; }
        float p[16];
#pragma unroll
        for (int e = 0; e < 16; ++e) { float a = 0.f;
#pragma unroll
            for (int j = 0; j < 4; ++j) { const f32x4 w = *(const LAS f32x4*)(wrT + e * 1024 + 4 * F.lane + 256 * j); a += (v[j].x * w.x + v[j].y * w.y) + (v[j].z * w.z + v[j].w * w.w); }
            p[e] = a; }
        const bool h5 = (F.lane >> 5) & 1, h4 = (F.lane >> 4) & 1, h3 = (F.lane >> 3) & 1, h2 = (F.lane >> 2) & 1; float q[8], r4[4], s2[2];
#pragma unroll
        for (int j = 0; j < 8; ++j) q[j] = (h5 ? p[8 + j] : p[j]) + lane_xor(h5 ? p[j] : p[8 + j], F.lane, 32);
#pragma unroll
        for (int j = 0; j < 4; ++j) r4[j] = (h4 ? q[4 + j] : q[j]) + lane_xor(h4 ? q[j] : q[4 + j], F.lane, 16);
#pragma unroll
        for (int j = 0; j < 2; ++j) s2[j] = (h3 ? r4[2 + j] : r4[j]) + lane_xor(h3 ? r4[j] : r4[2 + j], F.lane, 8);
        float tt = (h2 ? s2[1] : s2[0]) + lane_xor(h2 ? s2[0] : s2[1], F.lane, 4);
        tt += lane_xor(tt, F.lane, 1); tt += lane_xor(tt, F.lane, 2);
        if ((F.lane & 3) == 0) lg[(F.wave * 9 + ri) * 16 + (((F.lane >> 5) & 1) << 3 | ((F.lane >> 4) & 1) << 2 | ((F.lane >> 3) & 1) << 1 | ((F.lane >> 2) & 1))] = tt;
    }
    const int rl = F.gw + F.lane * F.NGW; const bool valid = F.lane < 9 && rl < M && !(skip_ctx && (rl % TPB) < CTX);
    int e1 = 0, e2 = 0, k1 = 0, k2 = 0; float w1 = 0.f, w2 = 0.f;
    LDS_WAIT();
    if (valid) { float sc[16], rb[16];
#pragma unroll
        for (int e = 0; e < 16; ++e) { sc[e] = sigm(lg[(F.wave * 9 + F.lane) * 16 + e]); rb[e] = F.in[I_RB][e]; }
        float gs[4];
#pragma unroll
        for (int g = 0; g < 4; ++g) { const float a = sc[4 * g] + rb[4 * g], bq = sc[4 * g + 1] + rb[4 * g + 1], c = sc[4 * g + 2] + rb[4 * g + 2], d = sc[4 * g + 3] + rb[4 * g + 3];
            const float hi1 = fmaxf(a, bq), lo1 = fminf(a, bq), hi2 = fmaxf(c, d), lo2 = fminf(c, d); gs[g] = fmaxf(hi1, hi2) + fmaxf(fminf(hi1, hi2), fmaxf(lo1, lo2)); }
        int gi = 0; float gv = gs[0]; if (gs[1] > gv) { gv = gs[1]; gi = 1; } if (gs[2] > gv) { gv = gs[2]; gi = 2; } if (gs[3] > gv) { gv = gs[3]; gi = 3; }
        const float u0 = sel4(gi, sc[0], sc[4], sc[8], sc[12]), u1 = sel4(gi, sc[1], sc[5], sc[9], sc[13]), u2 = sel4(gi, sc[2], sc[6], sc[10], sc[14]), u3 = sel4(gi, sc[3], sc[7], sc[11], sc[15]);
        const float b0 = sel4(gi, rb[0], rb[4], rb[8], rb[12]), b1 = sel4(gi, rb[1], rb[5], rb[9], rb[13]), b2 = sel4(gi, rb[2], rb[6], rb[10], rb[14]), b3 = sel4(gi, rb[3], rb[7], rb[11], rb[15]);
        int i1, i2; top2of4(u0 + b0, u1 + b1, u2 + b2, u3 + b3, i1, i2);
        const float s1 = sel4(i1, u0, u1, u2, u3), s2v = sel4(i2, u0, u1, u2, u3), inv = 1.0f / (s1 + s2v);
        e1 = gi * 4 + i1; e2 = gi * 4 + i2; w1 = s1 * inv; w2 = s2v * inv;
        k1 = __hip_atomic_fetch_add(hist + e1, 1, __ATOMIC_RELAXED, __HIP_MEMORY_SCOPE_WORKGROUP); k2 = __hip_atomic_fetch_add(hist + e2, 1, __ATOMIC_RELAXED, __HIP_MEMORY_SCOPE_WORKGROUP); }
    __syncthreads();
    if (F.tid < 16) gbase[F.tid] = (int)__hip_atomic_fetch_add((gu32*)(F.ws + WS_CTL) + CW_GCNT + 64 * l + F.tid, (unsigned)hist[F.tid], RLX_AGENT);
    __syncthreads();
    if (valid) { const int g1 = gbase[e1] + k1, g2 = gbase[e2] + k2;
        int* rt = (int*)(F.ws + WS_ROUTE) + 8 * rl; rt[0] = e1; rt[1] = e2; rt[2] = g1; rt[3] = g2; rt[4] = __float_as_int(w1); rt[5] = __float_as_int(w2);
        int* RT = (int*)(F.ws + WS_XP); RT[(size_t)e1 * ROWCAP + g1] = rl; RT[(size_t)e2 * ROWCAP + g2] = rl; }
}
__device__ __forceinline__ unsigned char* opq_ptr(unsigned char* p) { GAS unsigned char* g = (GAS unsigned char*)p; asm volatile("" : "+s"(g)); return (unsigned char*)g; }
#define FRESH_FR(Fq) Fr Fq = F; Fq.ws = opq_ptr(F.ws); { int t_; asm volatile("v_mbcnt_lo_u32_b32 %0, -1, 0\n\tv_mbcnt_hi_u32_b32 %0, -1, %0" : "=v"(t_)); Fq.lane = t_; Fq.tid = t_ + F.wave * 64; }
constexpr int CVQ1 = 2592;
__device__ __forceinline__ void cvt_fill(const Fr& F, int l, unsigned char* wb, int i0, int i1, int first_idle) {
    int j = F.blk - first_idle, n = F.G - first_idle; if (n <= 0) { j = F.blk; n = F.G; }
    if (j >= 0) cvt_range(F, l, wb, i0 + j * NWAVES + F.wave, n * NWAVES, i1);
}
constexpr int NPH = 11;
constexpr int PH_END = 1 + DEPTH * NPH + 1;
struct Args { const float* in[25]; float* out; unsigned char* ws; int ph_lo, ph_hi; };
__global__ void __launch_bounds__(NWAVES * 64, 2) fwd(Args args) {
    extern __shared__ __attribute__((aligned(16))) unsigned char lds_raw[];
    Fr F;
    F.lds = (LAS unsigned char*)lds_raw;
    F.tid = threadIdx.x; F.lane = F.tid & 63; F.wave = __builtin_amdgcn_readfirstlane(F.tid >> 6);
    F.G = gridDim.x; F.blk = blockIdx.x; F.gw = F.blk * NWAVES + F.wave; F.NGW = F.G * NWAVES;
#pragma unroll
    for (int i = 0; i < 25; ++i) F.in[i] = args.in[i];
    F.out = args.out; F.ws = args.ws;
    volatile LAS unsigned* MISC = (volatile LAS unsigned*)(F.lds + MISC_OFF);
    if (F.tid < 32) MISC[F.tid] = 0u;
    __syncthreads();
#if MK_PER_PHASE
#define GRID_BAR() do { } while (0)
#else
    XcdBarrier bar = xcd_barrier_post((unsigned*)(F.ws + WS_CTL) + CW_BAR, MISC + 8);
#define GRID_BAR() xcd_barrier(bar)
#endif
    const int lo = args.ph_lo, hi = args.ph_hi;
#ifndef DBG_PH
#define DBG_PH -1
#endif
#define IN(k) (lo <= (k) && (k) < hi)
#define ON(k) (DBG_PH < 0 || DBG_PH == (k))
    const int opq = (int)(gridDim.x >> 20);
#define IN2(k) (lo <= (k) && (k) < hi + opq)
#define IN3(k) (lo <= (k) + opq && (k) < hi)
    LAS unsigned char* ring = F.lds;
#define PHASE_WS() Fr Fp = F; Fp.ws = opq_ptr(F.ws); { int t_; asm volatile("v_mbcnt_lo_u32_b32 %0, -1, 0\n\tv_mbcnt_hi_u32_b32 %0, -1, %0" : "=v"(t_)); t_ += F.wave * 64; int b_ = F.blk; asm volatile("" : "+s"(b_)); Fp.tid = t_; Fp.lane = t_ & 63; Fp.wave = __builtin_amdgcn_readfirstlane(t_ >> 6); Fp.blk = b_; Fp.gw = b_ * NWAVES + Fp.wave; } unsigned char* ws = Fp.ws; (void)ws

    if (ON(100) && IN(0)) { p0_setup(F); GRID_BAR(); }

    for (int l = 0; l < DEPTH; ++l) {
        const int pb = 1 + l * NPH; const int lastl = (l == DEPTH - 1) ? 1 : 0;
        const size_t wbo = (l & 1) ? WS_W2 : WS_W, wbn = (l & 1) ? WS_W : WS_W2;
        if (ON(0) && IN(pb + 0)) { PHASE_WS(); if (l == 0) { cvt_range(Fp, 0, Fp.ws + wbo, CVQ1 + Fp.gw, F.NGW, CV_GU); cvt_range(Fp, 0, Fp.ws + wbo, CV_GU + CV_DN + Fp.gw, F.NGW, CV_T64); } cvt_uq(Fp, l, Fp.ws + wbo); if (l == 0) row_phase_a<0>(Fp, l); else row_phase_a<1>(Fp, l); GRID_BAR(); }
        if (ON(1) && IN(pb + 1)) { PHASE_WS(); pg8::Gemm g{(const bf16_t*)(ws + WS_H), (const bf16_t*)(ws + wbo + W_IN), M, INP, 1024}; pg8::StaticOrder S; S.init(M, INP, F.G, Fp.blk);
            pg8::EpiStore E{(bf16_t*)(ws + WS_P), INP};
            pg8::gemm_phase<pg8::EpiStore, pg8::StaticOrder, true, true>(ring, g, S, E, Fp.tid);
            { FRESH_FR(Fq); const int nwg = (M / 256) * (INP / 256), R = (nwg + F.G - 1) / F.G, fi = nwg % F.G ? nwg - (R - 1) * F.G : F.G;
              if (l + 1 < DEPTH) { int j = Fq.blk - fi, n = F.G - fi; if (n <= 0) { j = Fq.blk; n = F.G; } if (j >= 0) mod_items(Fq, l + 1, j, n); }
              cvt_fill(Fq, l, Fq.ws + wbo, 0, CVQ1, fi); }
            GRID_BAR(); }
        if (ON(2) && IN(pb + 2)) { PHASE_WS(); { int slot = 0; for (int it = Fp.blk; it < hg::NITEM; it += F.G, ++slot) hg::scan_dir<0>(Fp, l, it >> 7, (it >> 5) & 3, (it >> 4) & 1, it & 15, -1, 0, 0, nullptr); (void)slot; } mla_prep(Fp, l, Fp.gw, F.NGW); GRID_BAR(); }
        if (ON(3) && IN(pb + 3)) { PHASE_WS(); hg::scan_pass2(Fp); }
        if (ON(3) && IN2(pb + 3)) { PHASE_WS();
            { pg8::Gemm g{(const bf16_t*)(ws + WS_DQN), (const bf16_t*)(ws + wbo + W_UQ), M, 768, 384}; pg8::StaticOrder S; S.init(M, 768, F.G, (Fp.blk + F.G - 52) % F.G, lastl);
              pg8::EpiQ E{(bf16_t*)(ws + WS_Q), (const float*)(ws + WS_ROPE)};
              pg8::gemm_phase<pg8::EpiQ, pg8::StaticOrder, true, true>(ring, g, S, E, Fp.tid); } }
        if (ON(3) && IN3(pb + 3)) { PHASE_WS();
            { pg8::Gemm g{(const bf16_t*)(ws + WS_DKVN), (const bf16_t*)(ws + wbo + W_UKV), M, 1024, 256}; pg8::StaticOrder S; S.init(M, 1024, F.G, Fp.blk);
              pg8::EpiKV E{(bf16_t*)(ws + WS_K), (bf16_t*)(ws + WS_V)};
              pg8::gemm_phase<pg8::EpiKV, pg8::StaticOrder, true, true>(ring, g, S, E, Fp.tid); }
            GRID_BAR(); }
        if (ON(4) && IN2(pb + 4)) { PHASE_WS(); for (int it = Fp.blk; it < 256; it += F.G) { const int b_ = it >> 6, h_ = (it >> 4) & 3, k_ = it & 15; hg::scan_dir<1>(Fp, l, b_, h_, 0, k_, -1, 0, 0, nullptr); hg::scan_dir<2>(Fp, l, b_, h_, 1, k_ ? 16 - k_ : 0, -1, 0, 0, nullptr); } }
        if (ON(4) && IN(pb + 4)) { PHASE_WS(); const int nu = 512 + (l < DEPTH - 1 ? 32 : 0);
            const bf16_t* Qg = (const bf16_t*)(ws + WS_Q); const bf16_t* Kg = (const bf16_t*)(ws + WS_K); const bf16_t* Vg = (const bf16_t*)(ws + WS_V); bf16_t* MO = (bf16_t*)(ws + WS_MO);
            for (int u = Fp.blk; u < nu; u += F.G) {
                const int bh = u < 512 ? (u >> 4) : (u - 512), t0 = u < 512 ? CTX + (u & 15) * 256 : 0, seq = u < 512 ? TPB : CTX, b = bh >> 3, h = bh & 7;
                int tq_; asm volatile("v_mbcnt_lo_u32_b32 %0, -1, 0\n\tv_mbcnt_hi_u32_b32 %0, -1, %0" : "=v"(tq_)); tq_ += Fp.wave * 64;
                if (false) { CvHook hk{Fp, l + 1, Fp.ws + wbn}; att::attn_unit(Qg + ((size_t)bh * TPB + t0) * 96, Kg + (size_t)bh * TPB * 96, Vg + (size_t)bh * TPB * 64, MO + ((size_t)b * TPB + t0) * 512 + h * 64, 512, seq, (LAS char*)ring, tq_, hk); }
                else { att::NoHook hk; att::attn_unit_pp(Qg + ((size_t)bh * TPB + t0) * 96, Kg + (size_t)bh * TPB * 96, Vg + (size_t)bh * TPB * 64, MO + ((size_t)b * TPB + t0) * 512 + h * 64, 512, seq, (LAS char*)ring, tq_, hk); } }
            GRID_BAR(); }
        if (ON(6) && IN(pb + 6)) { PHASE_WS();
            { pg8::Gemm g{(const bf16_t*)(ws + WS_A), (const bf16_t*)(ws + wbo + W_PA), M, 1024, 512}; pg8::StaticOrder S; S.init(M, 1024, F.G, Fp.blk, lastl);
              pg8::EpiMerge<false> E{(const bf16_t*)(ws + WS_P), C_GA, (bf16_t*)(ws + WS_MIX)};
              pg8::gemm_phase<pg8::EpiMerge<false>, pg8::StaticOrder, true, true>(ring, g, S, E, Fp.tid); } }
        if (ON(6) && IN2(pb + 6)) { PHASE_WS();
            { pg8::Gemm g{(const bf16_t*)(ws + WS_MO), (const bf16_t*)(ws + wbo + W_PB), M, 1024, 512}; pg8::StaticOrder S; S.init(M, 1024, F.G, Fp.blk, lastl);
              pg8::EpiMerge<true> E{(const bf16_t*)(ws + WS_P), C_GB, (bf16_t*)(ws + WS_MIX)};
              pg8::gemm_phase<pg8::EpiMerge<true>, pg8::StaticOrder, true, true>(ring, g, S, E, Fp.tid); }
            GRID_BAR(); }
        if (ON(7) && IN(pb + 7)) { PHASE_WS(); pg8::Gemm g{(const bf16_t*)(ws + WS_MIX), (const bf16_t*)(ws + wbo + W_O), M, 1024, 1024}; pg8::StaticOrder S; S.init(M, 1024, F.G, Fp.blk, lastl);
            pg8::EpiWo E{(bf16_t*)(ws + WS_Z), (const float*)(ws + WS_MOD) + (size_t)l * 5 * 6144};
            pg8::gemm_phase<pg8::EpiWo, pg8::StaticOrder, true, true>(ring, g, S, E, Fp.tid); GRID_BAR(); }
        if (ON(8) && IN(pb + 8)) { PHASE_WS(); norm2_route(Fp, l, lastl); GRID_BAR(); }
        if (ON(9) && IN(pb + 9)) { PHASE_WS(); moe_tab(Fp, l); const LAS int* tab = (const LAS int*)(Fp.lds + MOETAB_OFF); const int ntile = tab[48];
            pg8::Gemm g{(const bf16_t*)(ws + WS_H), (const bf16_t*)(ws + wbo + W_GU), XROWS, 1024, 1024}; pg8::MoeGatherOrder S{ntile * 4, F.G, Fp.blk, tab, (const int*)(ws + WS_XP), ROWCAP};
            pg8::EpiGU E{(bf16_t*)(ws + WS_HID)};
            pg8::gemm_phase<pg8::EpiGU, pg8::MoeGatherOrder, true, true>(ring, g, S, E, Fp.tid);
            { FRESH_FR(Fq); cvt_fill(Fq, l, Fq.ws + wbo, CV_GU, CV_GU + CV_DN, F.G / 2); if (l + 1 < DEPTH) cvt_fill(Fq, l + 1, Fq.ws + wbn, CVQ1, CV_GU, F.G / 2); }
            GRID_BAR(); }
        if (ON(10) && IN(pb + 10)) { PHASE_WS(); moe_tab(Fp, l); const LAS int* tab = (const LAS int*)(Fp.lds + MOETAB_OFF); const int ntile = tab[48];
            pg8::Gemm g{(const bf16_t*)(ws + WS_HID), (const bf16_t*)(ws + wbo + W_DN), XROWS, 1024, 512}; pg8::MoeOrder S{ntile * 4, F.G, Fp.blk, tab};
            pg8::EpiStore E{(bf16_t*)(ws + WS_Y), 1024};
            pg8::gemm_phase<pg8::EpiStore, pg8::MoeOrder, true, true>(ring, g, S, E, Fp.tid);
            if (l + 1 < DEPTH) { FRESH_FR(Fq); cvt_fill(Fq, l + 1, Fq.ws + wbn, CV_GU + CV_DN, CV_T64, F.G / 2); }
            GRID_BAR(); }
    }
    if (ON(101) && IN(PH_END - 1)) { PHASE_WS(); row_phase_a<2>(Fp, DEPTH); }
#undef IN
#undef IN2
#undef IN3
#undef ON
}

extern "C" void kernel_launch(void* const* d_in, const int* in_sizes, int n_in, void* d_out, int out_size, void* d_ws, size_t ws_size, hipStream_t stream) {
    static int grid = 0;
    if (grid == 0) {
        if (n_in != 25 || out_size != NB * SEQ * D || ws_size < WS_END) { fprintf(stderr, "kernel_launch: unexpected shapes: n_in %d out %d ws %zu (need %zu)\n", n_in, out_size, ws_size, (size_t)WS_END); grid = -1; return; }
        int dev = 0, cus = 0;
        if (hipGetDevice(&dev) != hipSuccess || hipDeviceGetAttribute(&cus, hipDeviceAttributeMultiprocessorCount, dev) != hipSuccess) { grid = -1; return; }
        if (hipFuncSetAttribute((const void*)fwd, hipFuncAttributeMaxDynamicSharedMemorySize, LDS_BYTES) != hipSuccess) { fprintf(stderr, "kernel_launch: hipFuncSetAttribute failed\n"); grid = -1; return; }
        int per_cu = 0;
        if (hipOccupancyMaxActiveBlocksPerMultiprocessor(&per_cu, (const void*)fwd, NWAVES * 64, LDS_BYTES) != hipSuccess || per_cu < 1) fprintf(stderr, "kernel_launch: occupancy query says %d\n", per_cu);
        (void)hipGetLastError();
        grid = cus > 256 ? 256 : cus;
    }
    if (grid < 0) return;
    if (hipMemsetAsync((char*)d_ws + WS_CTL, 0, CTL_ZERO_BYTES, stream) != hipSuccess) return;
    Args a{};
    for (int i = 0; i < 25; ++i) a.in[i] = (const float*)d_in[i];
    a.out = (float*)d_out; a.ws = (unsigned char*)d_ws;
#if MK_PER_PHASE
    for (int p = 0; p < PH_END; ++p) { a.ph_lo = p; a.ph_hi = p + 1; hipLaunchKernelGGL(fwd, dim3(grid), dim3(NWAVES * 64), LDS_BYTES, stream, a); }
#else
    a.ph_lo = 0; a.ph_hi = PH_END; hipLaunchKernelGGL(fwd, dim3(grid), dim3(NWAVES * 64), LDS_BYTES, stream, a);
#endif
    const hipError_t le = hipPeekAtLastError();
    if (le != hipSuccess) fprintf(stderr, "kernel_launch: launch failed: %s\n", hipGetErrorName(le));
}
```

```cpp
#include <hip/hip_runtime.h>
#include <cstdio>
#include <cstdint>
#ifndef MK_PER_PHASE
#define MK_PER_PHASE 0
#endif
#define GAS __attribute__((address_space(1)))
#define LAS __attribute__((address_space(3)))
constexpr int D = 1024, NB = 4, SEQ = 4096, CTX = 256, TPB = CTX + SEQ  , M = NB * TPB  , DEPTH = 4;
constexpr int IN_DIM = 5280, INP = 5376;
constexpr int C_Q = 0, C_I = 512, C_FF = 1024, C_FB = 1536, C_G = 2048, C_DQ = 2560, C_DKV = 2944, C_KPE = 3200, C_GA = 3232, C_GB = 4256;
constexpr int NE = 16, DE = 512, XROWS = 38912;
constexpr float EPS = 1e-6f;
constexpr size_t MiB = 1u << 20;
constexpr size_t WS_CTL = 0, CTL_ZERO_BYTES = 1 * MiB;
constexpr size_t WS_MOD = 1 * MiB;
constexpr size_t WS_LBT = WS_MOD + 512 * 1024;
constexpr size_t WS_ROPE = WS_LBT + 16 * 1024;
constexpr size_t WS_HIST = WS_ROPE + 4096;
constexpr size_t WS_TILE = WS_HIST + 16384;
constexpr size_t WS_ROUTE = 2 * MiB;
constexpr size_t WS_SLOT = 3 * MiB;
constexpr size_t WS_SD = 3 * MiB + 512 * 1024;
constexpr size_t WS_ST = 136 * MiB;
constexpr size_t WS_W = 4 * MiB, WS_W2 = 517 * MiB;
constexpr size_t W_IN = 0, W_UQ = W_IN + (size_t)INP * 1024 * 2, W_UKV = W_UQ + 768 * 384 * 2, W_PA = W_UKV + 1024 * 256 * 2, W_PB = W_PA + 1024 * 512 * 2,
                 W_O = W_PB + 1024 * 512 * 2, W_GU = W_O + 1024 * 1024 * 2, W_DN = W_GU + (size_t)16 * 1024 * 1024 * 2, W_END = W_DN + (size_t)16 * 1024 * 512 * 2;
static_assert(W_END <= 64 * MiB, "weights");
constexpr size_t WS_Z = 68 * MiB;
constexpr size_t WS_H = 136 * MiB;
constexpr size_t WS_P = 170 * MiB;
constexpr size_t WS_DQN = 349 * MiB, WS_DKVN = 362 * MiB;
constexpr size_t WS_XP = 170 * MiB, WS_HID = 246 * MiB, WS_Y = 284 * MiB;
constexpr int ROWCAP = 2 * M;
constexpr size_t WS_Q = 380 * MiB, WS_K = 406 * MiB, WS_V = 432 * MiB;
constexpr size_t WS_MIX = 380 * MiB;
constexpr size_t WS_OF = 449 * MiB, WS_OB = 466 * MiB;
constexpr size_t WS_A = 483 * MiB, WS_MO = 500 * MiB;
constexpr size_t WS_END = 581 * MiB;
static_assert(WS_P + (size_t)M * INP * 2 <= WS_DQN && WS_DQN + (size_t)M * 384 * 2 <= WS_DKVN && WS_DKVN + (size_t)M * 256 * 2 <= WS_Q, "R1 mixer view");
static_assert(WS_XP + (size_t)XROWS * 2048 <= WS_HID && WS_HID + (size_t)XROWS * 1024 <= WS_Y && WS_Y + (size_t)XROWS * 2048 <= WS_Q, "R1 moe view");
static_assert(WS_Q + (size_t)32 * TPB * 192 <= WS_K && WS_K + (size_t)32 * TPB * 192 <= WS_V && WS_V + (size_t)32 * TPB * 128 <= WS_OF && WS_MIX + (size_t)M * 2048 <= WS_V, "qkv");
static_assert(WS_OF + (size_t)M * 1024 <= WS_OB && WS_OB + (size_t)M * 1024 <= WS_A && WS_A + (size_t)M * 1024 <= WS_MO && WS_MO + (size_t)M * 1024 <= WS_W2 && WS_W2 + W_END <= WS_END, "tail");
namespace pg8 {
#define PG8_LAS __attribute__((address_space(3)))
typedef unsigned short bf16_t;
typedef short bf16x8 __attribute__((ext_vector_type(8)));
typedef float f32x4 __attribute__((ext_vector_type(4)));
typedef unsigned u32x4 __attribute__((ext_vector_type(4)));
constexpr int BM = 256, BK = 64, HALF = 128, HTB = HALF * BK * 2  , STAGE_BYTES = 8 * HTB, NXCD = 8, WGM = 8;

__host__ __device__ __forceinline__ int lds_byte(int r, int c) { const int st = (r >> 4) * 2 + (c >> 5), rr = r & 15, cc = c & 31, ob = rr * 64 + cc * 2; return st * 1024 + (ob ^ (((ob >> 9) & 1) << 5)); }
__host__ __device__ __forceinline__ void stage_rc(int b, int& R, int& C) { const int st = b / 1024, sb = b % 1024, swz = sb ^ (((sb >> 9) & 1) << 5); R = (st >> 1) * 16 + swz / 64; C = (st & 1) * 32 + (swz % 64) / 2; }
__host__ __device__ __forceinline__ int perm32(int rho) { const int n = rho >> 4, i = rho & 15; return 8 * (i >> 2) + 4 * n + (i & 3); }

struct Unit { int pm, pn, pb; };
struct Gemm { const bf16_t* A; const bf16_t* Bt; int M, N, K; };

struct StaticOrder {
    static constexpr bool GATHER = false;
    int nM, nN, nwg, G, c, lat;
    __host__ __device__ void init(int M, int N, int G_, int c_, int lat_ = 0) { lat = lat_; nM = lat_ ? 64 : M / BM; nN = N / BM; nwg = nM * nN; G = G_; c = c_; }
    __host__ __device__ bool next(int i, Unit& u) const {
        const long L = (long)i * G + c; if (L >= nwg) return false;
        int wgid = (int)L; { const int q = nwg / NXCD, r = nwg % NXCD, xcd = wgid % NXCD, off = wgid / NXCD; wgid = (xcd < r ? xcd * (q + 1) : r * (q + 1) + (xcd - r) * q) + off; }
        const int nig = WGM * nN, gid = wgid / nig, fm = gid * WGM, gsz = (nM - fm) < WGM ? (nM - fm) : WGM;
        u.pm = fm + ((wgid % nig) % gsz); u.pn = (wgid % nig) / gsz; u.pb = u.pn; if (lat) u.pm = (u.pm >> 4) * 17 + 1 + (u.pm & 15); return true;
    }
    __device__ __forceinline__ void a_ready(const Unit&) const {}
    __device__ __forceinline__ void done(const Unit&) const {}
};

typedef float f32x2 __attribute__((ext_vector_type(2)));
__device__ __forceinline__ unsigned cvt_pk_bf16(float lo, float hi) { unsigned r; asm volatile("v_cvt_pk_bf16_f32 %0, %1, %2" : "=v"(r) : "v"(lo), "v"(hi)); return r; }
__device__ __forceinline__ u32x4 pack8(f32x4 v0, f32x4 v1) { u32x4 w; w.x = cvt_pk_bf16(v0[0], v0[1]); w.y = cvt_pk_bf16(v0[2], v0[3]); w.z = cvt_pk_bf16(v1[0], v1[1]); w.w = cvt_pk_bf16(v1[2], v1[3]); return w; }
__device__ __forceinline__ float bf_lo(unsigned u) { return __uint_as_float(u << 16); }
__device__ __forceinline__ float bf_hi(unsigned u) { return __uint_as_float(u & 0xffff0000u); }
__device__ __forceinline__ void unpack8(u32x4 w, f32x4& v0, f32x4& v1) { v0 = (f32x4){bf_lo(w.x), bf_hi(w.x), bf_lo(w.y), bf_hi(w.y)}; v1 = (f32x4){bf_lo(w.z), bf_hi(w.z), bf_lo(w.w), bf_hi(w.w)}; }
__device__ __forceinline__ float sigmoidf_(float x) { return __builtin_amdgcn_rcpf(1.0f + __expf(-x)); }
__device__ __forceinline__ f32x4 sigmoid4(f32x4 x) { return (f32x4){sigmoidf_(x[0]), sigmoidf_(x[1]), sigmoidf_(x[2]), sigmoidf_(x[3])}; }

struct EpiStore { static constexpr bool PERM = true, AFTER_DRAIN = false; bf16_t* O; int ldc;
    __device__ __forceinline__ void operator()(const f32x4 (&acc)[2][2][4][2], const Unit& u, int wr, int wc, int fr, int fq) const {
        const int row0 = u.pm * BM + wr * 64 + fr, col0 = u.pn * BM + wc * 32 + 8 * fq;
#pragma unroll
        for (int ai = 0; ai < 2; ++ai)
#pragma unroll
            for (int m = 0; m < 4; ++m) { bf16_t* rowp = O + (size_t)(row0 + ai * HALF + m * 16) * ldc + col0;
#pragma unroll
                for (int bj = 0; bj < 2; ++bj) *(u32x4*)(rowp + bj * HALF) = pack8(acc[ai][bj][m][0], acc[ai][bj][m][1]); }
    }
};
constexpr float QSC = 0.10206207261596575f * 1.4426950408889634f;
struct EpiQ { static constexpr bool PERM = true, AFTER_DRAIN = false; bf16_t* Q; const float* rope;
    __device__ __forceinline__ void operator()(const f32x4 (&acc)[2][2][4][2], const Unit& u, int wr, int wc, int fr, int fq) const {
        const int b = u.pm / 17, tt = (u.pm % 17) * 256 + wr * 64 + fr; const bool lat = (u.pm % 17) != 0;
        const int n0 = u.pn * BM + wc * 32 + 8 * fq, n1 = n0 + HALF, h0 = n0 / 96, e0 = n0 - h0 * 96, h1 = n1 / 96, e1 = n1 - h1 * 96;
        bf16_t* base0 = Q + (size_t)(b * 8 + h0) * TPB * 96 + e0; bf16_t* base1 = Q + (size_t)(b * 8 + h1) * TPB * 96 + e1;
        const bool rp0 = lat && e0 >= 64, rp1 = lat && e1 >= 64; const int ax0 = (e0 - 64) >> 4, ax1 = (e1 - 64) >> 4;
        const float* r0 = rope + (((e0 - 64) & 15) >> 1) * 2; const float* r1 = rope + (((e1 - 64) & 15) >> 1) * 2;
#pragma unroll
        for (int ai = 0; ai < 2; ++ai)
#pragma unroll
            for (int m = 0; m < 4; ++m) { const int t = tt + ai * HALF + m * 16, p = t - 256;
                { f32x4 v0 = acc[ai][0][m][0], v1 = acc[ai][0][m][1];
                  if (rp0) { const int pos = ax0 ? (p & 63) : (p >> 6); const f32x4 c0 = *(const f32x4*)(r0 + pos * 16), c1 = *(const f32x4*)(r0 + pos * 16 + 4);
                      v0 = (f32x4){v0[0] * c0[0] - v0[1] * c0[1], v0[0] * c0[1] + v0[1] * c0[0], v0[2] * c0[2] - v0[3] * c0[3], v0[2] * c0[3] + v0[3] * c0[2]};
                      v1 = (f32x4){v1[0] * c1[0] - v1[1] * c1[1], v1[0] * c1[1] + v1[1] * c1[0], v1[2] * c1[2] - v1[3] * c1[3], v1[2] * c1[3] + v1[3] * c1[2]}; }
                  *(u32x4*)(base0 + (size_t)t * 96) = pack8(v0 * QSC, v1 * QSC); }
                { f32x4 v0 = acc[ai][1][m][0], v1 = acc[ai][1][m][1];
                  if (rp1) { const int pos = ax1 ? (p & 63) : (p >> 6); const f32x4 c0 = *(const f32x4*)(r1 + pos * 16), c1 = *(const f32x4*)(r1 + pos * 16 + 4);
                      v0 = (f32x4){v0[0] * c0[0] - v0[1] * c0[1], v0[0] * c0[1] + v0[1] * c0[0], v0[2] * c0[2] - v0[3] * c0[3], v0[2] * c0[3] + v0[3] * c0[2]};
                      v1 = (f32x4){v1[0] * c1[0] - v1[1] * c1[1], v1[0] * c1[1] + v1[1] * c1[0], v1[2] * c1[2] - v1[3] * c1[3], v1[2] * c1[3] + v1[3] * c1[2]}; }
                  *(u32x4*)(base1 + (size_t)t * 96) = pack8(v0 * QSC, v1 * QSC); }
                asm volatile("" ::: "memory"); }
    }
};
struct EpiKV { static constexpr bool PERM = true, AFTER_DRAIN = false; bf16_t* K; bf16_t* V;
    __device__ __forceinline__ void operator()(const f32x4 (&acc)[2][2][4][2], const Unit& u, int wr, int wc, int fr, int fq) const {
        const int b = u.pm / 17, tt = (u.pm % 17) * 256 + wr * 64 + fr, j0 = wc * 32 + 8 * fq;
#pragma unroll
        for (int bj = 0; bj < 2; ++bj) { const int h = 2 * u.pn + bj; const size_t hb = (size_t)(b * 8 + h) * TPB;
            bf16_t* base = (wc < 2) ? (K + hb * 96 + j0) : (V + hb * 64 + (j0 - 64)); const int pitch = (wc < 2) ? 96 : 64;
#pragma unroll
            for (int ai = 0; ai < 2; ++ai)
#pragma unroll
                for (int m = 0; m < 4; ++m) { const int t = tt + ai * HALF + m * 16; *(u32x4*)(base + (size_t)t * pitch) = pack8(acc[ai][bj][m][0], acc[ai][bj][m][1]); asm volatile("" ::: "memory"); } }
    }
};
template <bool ADD> struct EpiMerge { static constexpr bool PERM = true, AFTER_DRAIN = false, HAS_MID = false; const bf16_t* P; int gcol; bf16_t* MIX;
    __device__ __forceinline__ void operator()(const f32x4 (&acc)[2][2][4][2], const Unit& u, int wr, int wc, int fr, int fq) const {
        const int row0 = u.pm * BM + wr * 64 + fr, col0 = u.pn * BM + wc * 32 + 8 * fq;
#pragma unroll
        for (int ai = 0; ai < 2; ++ai) { u32x4 gt[4][2], mx[4][2];
#pragma unroll
            for (int m = 0; m < 4; ++m)
#pragma unroll
                for (int bj = 0; bj < 2; ++bj) { const int row = row0 + ai * HALF + m * 16, col = col0 + bj * HALF; gt[m][bj] = *(const u32x4*)(P + (size_t)row * INP + gcol + col); if (ADD) mx[m][bj] = *(const u32x4*)(MIX + (size_t)row * 1024 + col); }
#pragma unroll
            for (int m = 0; m < 4; ++m)
#pragma unroll
                for (int bj = 0; bj < 2; ++bj) { const int row = row0 + ai * HALF + m * 16, col = col0 + bj * HALF; f32x4 g0, g1; unpack8(gt[m][bj], g0, g1);
                    f32x4 v0 = sigmoid4(g0) * acc[ai][bj][m][0], v1 = sigmoid4(g1) * acc[ai][bj][m][1];
                    if (ADD) { f32x4 o0, o1; unpack8(mx[m][bj], o0, o1); v0 += o0; v1 += o1; }
                    *(u32x4*)(MIX + (size_t)row * 1024 + col) = pack8(v0, v1); }
            asm volatile("" ::: "memory"); }
    }
};
struct EpiWo { static constexpr bool PERM = false, AFTER_DRAIN = false; bf16_t* Z; const float* modl;
    __device__ __forceinline__ void operator()(const f32x4 (&acc)[2][2][4][2], const Unit& u, int wr, int wc, int fr, int fq) const {
        const int row0 = u.pm * BM + wr * 64 + fr, col0 = u.pn * BM + wc * 32 + 4 * fq; const int ms = (u.pm % 17 == 0) ? 4 : u.pm / 17; const float* gate = modl + ms * 6144 + 2 * 1024;
        f32x4 gv[2][2];
#pragma unroll
        for (int bj = 0; bj < 2; ++bj)
#pragma unroll
            for (int n = 0; n < 2; ++n) gv[bj][n] = *(const f32x4*)(gate + col0 + bj * HALF + n * 16);
#pragma unroll
        for (int ai = 0; ai < 2; ++ai) { unsigned long long zo[4][2][2];
#pragma unroll
            for (int m = 0; m < 4; ++m)
#pragma unroll
                for (int bj = 0; bj < 2; ++bj)
#pragma unroll
                    for (int n = 0; n < 2; ++n) zo[m][bj][n] = *(const unsigned long long*)(Z + (size_t)(row0 + ai * HALF + m * 16) * 1024 + col0 + bj * HALF + n * 16);
#pragma unroll
            for (int m = 0; m < 4; ++m)
#pragma unroll
                for (int bj = 0; bj < 2; ++bj)
#pragma unroll
                    for (int n = 0; n < 2; ++n) { const unsigned lo = (unsigned)zo[m][bj][n], hi = (unsigned)(zo[m][bj][n] >> 32);
                        const f32x4 zn = (f32x4){bf_lo(lo), bf_hi(lo), bf_lo(hi), bf_hi(hi)} + gv[bj][n] * acc[ai][bj][m][n];
                        *(unsigned long long*)(Z + (size_t)(row0 + ai * HALF + m * 16) * 1024 + col0 + bj * HALF + n * 16) = (unsigned long long)cvt_pk_bf16(zn[0], zn[1]) | ((unsigned long long)cvt_pk_bf16(zn[2], zn[3]) << 32); }
            asm volatile("" ::: "memory"); }
    }
};
struct EpiGU { static constexpr bool PERM = true, AFTER_DRAIN = false; bf16_t* HID;
    __device__ __forceinline__ void operator()(const f32x4 (&acc)[2][2][4][2], const Unit& u, int wr, int wc, int fr, int fq) const {
        const int row0 = u.pm * BM + wr * 64 + fr, col0 = u.pn * HALF + wc * 32 + 8 * fq;
#pragma unroll
        for (int ai = 0; ai < 2; ++ai)
#pragma unroll
            for (int m = 0; m < 4; ++m) { const f32x4 g0 = acc[ai][0][m][0], g1 = acc[ai][0][m][1], u0 = acc[ai][1][m][0], u1 = acc[ai][1][m][1];
                *(u32x4*)(HID + (size_t)(row0 + ai * HALF + m * 16) * 512 + col0) = pack8(g0 * sigmoid4(g0) * u0, g1 * sigmoid4(g1) * u1); }
    }
};
struct MoeOrder { static constexpr bool GATHER = false; int nunits, G, c; const PG8_LAS int* tab;
    __device__ __forceinline__ bool next(int i, Unit& u) const { const int L = i * G + c; if (L >= nunits) return false; const int j = L >> 2; u.pm = j; u.pn = L & 3; u.pb = tab[64 + j] * 4 + (L & 3); return true; }
    __device__ __forceinline__ void a_ready(const Unit&) const {}
    __device__ __forceinline__ void done(const Unit&) const {}
};
struct MoeGatherOrder { static constexpr bool GATHER = true; int nunits, G, c; const PG8_LAS int* tab; const int* rowtok; int cap;
    __device__ __forceinline__ bool next(int i, Unit& u) const { const int L = i * G + c; if (L >= nunits) return false; const int j = L >> 2; u.pm = j; u.pn = L & 3; u.pb = tab[64 + j] * 4 + (L & 3); return true; }
    __device__ __forceinline__ void rows(const Unit& u, const int (&RA)[2], const int (&CA)[2], int K, unsigned (&v0)[2], unsigned (&v1)[2]) const {
        const int e = tab[64 + u.pm], last = tab[e] - 1, r0 = u.pm * BM - tab[16 + e]; const int* rt = rowtok + (size_t)e * cap;
#pragma unroll
        for (int i = 0; i < 2; ++i) { const int k0 = r0 + RA[i], k1 = k0 + HALF;
            v0[i] = (unsigned)rt[k0 < last ? k0 : last] * (unsigned)(K * 2) + (unsigned)(CA[i] * 2); v1[i] = (unsigned)rt[k1 < last ? k1 : last] * (unsigned)(K * 2) + (unsigned)(CA[i] * 2); } }
    __device__ __forceinline__ void a_ready(const Unit&) const {}
    __device__ __forceinline__ void done(const Unit&) const {}
};
template <class Epi, class Sched, bool ALIGN_EPI = false, bool SP2 = false>
__device__ __forceinline__ void gemm_phase(PG8_LAS unsigned char* lds, const Gemm g, const Sched& S, const Epi& E, int tid_in) {
    int tid_ = tid_in; asm volatile("" : "+v"(tid_));
    const int tid = tid_, wid = __builtin_amdgcn_readfirstlane(tid >> 6), lane = tid & 63, wr = wid >> 2, wc = wid & 3, fr = lane & 15, fq = lane >> 4;
    const int K = g.K, nt = K / BK;
    constexpr bool GATHER = Sched::GATHER; static_assert(!GATHER || SP2, "gathered A rows: SP2 loop only");
    unsigned voffA[2], voffB[2]; int RA[2], CA[2];
#pragma unroll
    for (int i = 0; i < 2; ++i) { int R, C; stage_rc(tid * 16 + i * 8192, R, C); const int Rb = Epi::PERM ? ((R & ~31) + perm32(R & 31)) : R; RA[i] = R; CA[i] = C;
        voffA[i] = (unsigned)(R * K + C) * 2u; voffB[i] = (unsigned)(Rb * K + C) * 2u; }
    unsigned vC0[2] = {voffA[0], voffA[1]}, vC1[2] = {voffA[0], voffA[1]}, vN0[2] = {voffA[0], voffA[1]}, vN1[2] = {voffA[0], voffA[1]};
    const size_t kstep = (size_t)(BK * 2);
    const size_t hstep = (size_t)HALF * K * 2;
    const size_t tstep = 2 * hstep;
    const size_t hstepA = GATHER ? (size_t)0 : hstep;
    const unsigned ldsw = (unsigned)wid * 1024u;
    const int aoff = lds_byte(wr * 64 + fr, fq * 8), boff = lds_byte(wc * 32 + fr, fq * 8);
#define PG8_SA(b, h) (((b) * 2 + (h)) * HTB)
#define PG8_SB(b, h) ((4 + (b) * 2 + (h)) * HTB)
#define PG8_STAGE(bufoff, gbase, voff) do { _Pragma("unroll") for (int _i = 0; _i < 2; ++_i) \
        __builtin_amdgcn_global_load_lds((const unsigned*)((const char*)(gbase) + (voff)[_i]), (PG8_LAS unsigned*)(lds + (bufoff) + ldsw + _i * 8192), 16, 0, 0); } while (0)
#define PG8_LDA(dst, b, h) do { _Pragma("unroll") for (int m = 0; m < 4; ++m) _Pragma("unroll") for (int k = 0; k < 2; ++k) dst[m][k] = *(const PG8_LAS bf16x8*)(lds + PG8_SA(b, h) + aoff + m * 2048 + k * 1024); } while (0)
#define PG8_LDB(dst, b, h) do { _Pragma("unroll") for (int n = 0; n < 2; ++n) _Pragma("unroll") for (int k = 0; k < 2; ++k) dst[n][k] = *(const PG8_LAS bf16x8*)(lds + PG8_SB(b, h) + boff + n * 2048 + k * 1024); } while (0)
#define PG8_MMA(ai, bj, At, Bt) do { __builtin_amdgcn_s_setprio(1); _Pragma("unroll") for (int m = 0; m < 4; ++m) _Pragma("unroll") for (int n = 0; n < 2; ++n) _Pragma("unroll") for (int k = 0; k < 2; ++k) \
        acc[ai][bj][m][n] = __builtin_amdgcn_mfma_f32_16x16x32_bf16(Bt[n][k], At[m][k], acc[ai][bj][m][n], 0, 0, 0); __builtin_amdgcn_s_setprio(0); } while (0)
#define PG8_WAIT_V(n) asm volatile("s_waitcnt vmcnt(" #n ")" ::: "memory")
#define PG8_WAIT_L(n) asm volatile("s_waitcnt lgkmcnt(" #n ")" ::: "memory")
#define PG8_BAR __builtin_amdgcn_s_barrier()
#define PG8_SCHED __builtin_amdgcn_sched_barrier(0)
    Unit cur, nxt; int ui = 0;
    if (!S.next(0, cur)) return;
    f32x4 acc[2][2][4][2];
#pragma unroll
    for (int a = 0; a < 2; ++a)
#pragma unroll
        for (int b = 0; b < 2; ++b)
#pragma unroll
            for (int m = 0; m < 4; ++m)
#pragma unroll
                for (int n = 0; n < 2; ++n) acc[a][b][m][n] = (f32x4){0.f, 0.f, 0.f, 0.f};
    bf16x8 At[4][2], B0[2][2], B1[2][2];
    const char* cA = GATHER ? (const char*)g.A : (const char*)g.A + (size_t)cur.pm * tstep; const char* cB = (const char*)g.Bt + (size_t)cur.pb * tstep;
    if constexpr (GATHER) S.rows(cur, RA, CA, K, vC0, vC1);
    S.a_ready(cur);
    if constexpr (SP2) {
        PG8_STAGE(PG8_SB(0, 0), cB, voffB); PG8_STAGE(PG8_SB(0, 1), cB + hstep, voffB); PG8_STAGE(PG8_SA(0, 0), cA, vC0); PG8_STAGE(PG8_SA(0, 1), cA + hstepA, vC1);
        if (wr == 1) PG8_BAR;
        PG8_WAIT_V(2); PG8_BAR;
        PG8_STAGE(PG8_SB(1, 0), cB + kstep, voffB); PG8_STAGE(PG8_SA(1, 0), cA + kstep, vC0); PG8_STAGE(PG8_SB(1, 1), cB + hstep + kstep, voffB);
        PG8_WAIT_V(6); PG8_BAR;
    } else {
        PG8_STAGE(PG8_SB(0, 0), cB, voffB); PG8_STAGE(PG8_SA(0, 0), cA, voffA); PG8_STAGE(PG8_SB(0, 1), cB + hstep, voffB); PG8_STAGE(PG8_SA(0, 1), cA + hstep, voffA);
        if (wr == 1) PG8_BAR;
        PG8_WAIT_V(4); PG8_BAR;
        PG8_STAGE(PG8_SB(1, 0), cB + kstep, voffB); PG8_STAGE(PG8_SA(1, 0), cA + kstep, voffA); PG8_STAGE(PG8_SB(1, 1), cB + hstep + kstep, voffB);
        PG8_WAIT_V(6); PG8_BAR;
    }
    for (;;) {
        const bool has_next = S.next(ui + 1, nxt);
        const char* nA = (has_next && !GATHER) ? (const char*)g.A + (size_t)nxt.pm * tstep : cA;
        if constexpr (GATHER) { if (has_next) S.rows(nxt, RA, CA, K, vN0, vN1); else { vN0[0] = vC0[0]; vN0[1] = vC0[1]; vN1[0] = vC1[0]; vN1[1] = vC1[1]; } }
        const char* nB = has_next ? (const char*)g.Bt + (size_t)nxt.pb * tstep : cB;
        for (int t = 0; t < nt; t += 2) {
            const bool last = (t == nt - 2);
            const char* a1 = cA + (size_t)(t + 1) * kstep;
            const char* a2 = last ? nA : cA + (size_t)(t + 2) * kstep; const char* b2 = last ? nB : cB + (size_t)(t + 2) * kstep;
            const char* a3 = a2 + kstep; const char* b3 = b2 + kstep;
            if (last && has_next) S.a_ready(nxt);
            unsigned w0[2], w1[2];
            if constexpr (GATHER) { w0[0] = last ? vN0[0] : vC0[0]; w0[1] = last ? vN0[1] : vC0[1]; w1[0] = last ? vN1[0] : vC1[0]; w1[1] = last ? vN1[1] : vC1[1]; } else { w0[0] = w1[0] = voffA[0]; w0[1] = w1[1] = voffA[1]; }
            if constexpr (SP2) {
            PG8_LDB(B0, 0, 0); PG8_LDB(B1, 0, 1); PG8_SCHED; PG8_LDA(At, 0, 0); PG8_STAGE(PG8_SA(1, 1), a1 + hstepA, vC1);
            PG8_WAIT_V(8); PG8_WAIT_L(0); PG8_BAR; PG8_MMA(0, 0, At, B0); PG8_MMA(0, 1, At, B1); PG8_BAR; PG8_SCHED;
            PG8_LDA(At, 0, 1); PG8_STAGE(PG8_SB(0, 0), b2, voffB); PG8_STAGE(PG8_SB(0, 1), b2 + hstep, voffB); PG8_STAGE(PG8_SA(0, 0), a2, w0);
            PG8_WAIT_V(8); PG8_WAIT_L(0); PG8_BAR; PG8_MMA(1, 0, At, B0); PG8_MMA(1, 1, At, B1); PG8_BAR; PG8_SCHED;
            PG8_LDB(B0, 1, 0); PG8_LDB(B1, 1, 1); PG8_SCHED; PG8_LDA(At, 1, 0); PG8_STAGE(PG8_SA(0, 1), a2 + hstepA, w1);
            PG8_WAIT_V(8); PG8_WAIT_L(0); PG8_BAR; PG8_MMA(0, 0, At, B0); PG8_MMA(0, 1, At, B1); PG8_BAR; PG8_SCHED;
            PG8_LDA(At, 1, 1); PG8_STAGE(PG8_SB(1, 0), b3, voffB); PG8_STAGE(PG8_SB(1, 1), b3 + hstep, voffB); PG8_STAGE(PG8_SA(1, 0), a3, w0);
            PG8_WAIT_V(8); PG8_WAIT_L(0); PG8_BAR; PG8_MMA(1, 0, At, B0); PG8_MMA(1, 1, At, B1); PG8_BAR; PG8_SCHED;
            } else {
            PG8_LDB(B0, 0, 0); PG8_SCHED; PG8_LDA(At, 0, 0); PG8_STAGE(PG8_SA(1, 1), a1 + hstep, voffA);
            PG8_WAIT_L(8); PG8_BAR; PG8_WAIT_L(0); PG8_MMA(0, 0, At, B0); PG8_BAR; PG8_SCHED;
            PG8_LDB(B1, 0, 1); PG8_STAGE(PG8_SB(0, 0), b2, voffB);
            PG8_BAR; PG8_WAIT_L(0); PG8_MMA(0, 1, At, B1); PG8_BAR;
            PG8_LDA(At, 0, 1); PG8_STAGE(PG8_SA(0, 0), a2, voffA);
            PG8_BAR; PG8_WAIT_L(0); PG8_MMA(1, 0, At, B0); PG8_BAR; PG8_SCHED;
            PG8_STAGE(PG8_SB(0, 1), b2 + hstep, voffB);
            PG8_WAIT_V(6); PG8_BAR; PG8_MMA(1, 1, At, B1); PG8_BAR;
            PG8_LDB(B0, 1, 0); PG8_SCHED; PG8_LDA(At, 1, 0); PG8_STAGE(PG8_SA(0, 1), a2 + hstep, voffA);
            PG8_WAIT_L(8); PG8_BAR; PG8_WAIT_L(0); PG8_MMA(0, 0, At, B0); PG8_BAR; PG8_SCHED;
            PG8_LDB(B1, 1, 1); PG8_STAGE(PG8_SB(1, 0), b3, voffB);
            PG8_BAR; PG8_WAIT_L(0); PG8_MMA(0, 1, At, B1); PG8_BAR;
            PG8_LDA(At, 1, 1); PG8_STAGE(PG8_SA(1, 0), a3, voffA);
            PG8_BAR; PG8_WAIT_L(0); PG8_MMA(1, 0, At, B0); PG8_BAR; PG8_SCHED;
            PG8_STAGE(PG8_SB(1, 1), b3 + hstep, voffB);
            PG8_WAIT_V(6); PG8_BAR; PG8_MMA(1, 1, At, B1); PG8_BAR;
            }
        }
        if constexpr (ALIGN_EPI) { if (wr == 0) PG8_BAR; }
        if constexpr (!Epi::AFTER_DRAIN) { int ln2; asm volatile("v_mbcnt_lo_u32_b32 %0, -1, 0\n\tv_mbcnt_hi_u32_b32 %0, -1, %0" : "=v"(ln2)); const int fr2 = ln2 & 15, fq2 = ln2 >> 4; E(acc, cur, wr, wc, fr2, fq2); S.done(cur); }
        if (!has_next) break;
#pragma unroll
        for (int a = 0; a < 2; ++a)
#pragma unroll
            for (int b = 0; b < 2; ++b)
#pragma unroll
                for (int m = 0; m < 4; ++m)
#pragma unroll
                    for (int n = 0; n < 2; ++n) acc[a][b][m][n] = (f32x4){0.f, 0.f, 0.f, 0.f};
        cur = nxt; cA = nA; cB = nB; ++ui;
        if constexpr (GATHER) { vC0[0] = vN0[0]; vC0[1] = vN0[1]; vC1[0] = vN1[0]; vC1[1] = vN1[1]; }
        if constexpr (ALIGN_EPI) { if (wr == 1) PG8_BAR; }
    }
    PG8_WAIT_V(0);
    if constexpr (!ALIGN_EPI) { if (wr == 0) PG8_BAR; }
    PG8_BAR;
    if constexpr (Epi::AFTER_DRAIN) { E.fused(acc, cur, wr, wc, fr, fq, lds, wid, lane); S.done(cur); }
#undef PG8_SA
#undef PG8_SB
#undef PG8_STAGE
#undef PG8_LDA
#undef PG8_LDB
#undef PG8_MMA
#undef PG8_WAIT_V
#undef PG8_WAIT_L
#undef PG8_BAR
#undef PG8_SCHED
}
}

namespace att {
typedef unsigned short bf16_t;
typedef short bf16x8 __attribute__((ext_vector_type(8)));
typedef short s16x4 __attribute__((ext_vector_type(4)));
typedef float f32x16 __attribute__((ext_vector_type(16)));
typedef unsigned u32x4 __attribute__((ext_vector_type(4)));
constexpr int NW = 8, QBLK = 32, KVBLK = 64, DQK = 96, DV = 64;
constexpr float SCALE = 0.10206207261596575f;
constexpr float THR = 8.f;
constexpr int SHM_V = KVBLK * DV * 2  , SHM_K = KVBLK * 256  ;
constexpr int NBUF = 4;
constexpr int LDS_V = 0, LDS_K = NBUF * SHM_V, LDS_WS = LDS_K + NBUF * SHM_K, LDS_BYTES = LDS_WS + NW * 64 * 4;
#define KSWZ(row, colB) ((row) * 256 + ((colB) ^ (((row) & 7) << 4)))
#define SBAR() __builtin_amdgcn_sched_barrier(0)
__device__ __forceinline__ int crow(int r, int hi) { return (r & 3) + 8 * (r >> 2) + 4 * hi; }
__device__ __forceinline__ unsigned cvtpk(float lo, float hi) { unsigned r; asm volatile("v_cvt_pk_bf16_f32 %0, %1, %2" : "=v"(r) : "v"(lo), "v"(hi)); return r; }
template <bool FIRST> __device__ __forceinline__ void partialSM(f32x16& p0, f32x16& p1, float& m_reg, f32x16& negm, float& alpha) {
  constexpr float THRL = THR * 1.4426950408889634f;
  float pmax = p0[0];
#pragma unroll
  for (int r = 1; r < 16; ++r) pmax = fmaxf(pmax, p0[r]);
#pragma unroll
  for (int r = 0; r < 16; ++r) pmax = fmaxf(pmax, p1[r]);
  { auto rr = __builtin_amdgcn_permlane32_swap(__float_as_uint(pmax), __float_as_uint(pmax), false, false);
    pmax = fmaxf(__uint_as_float(rr[0]), __uint_as_float(rr[1])); }
  if (!FIRST && __builtin_expect(__all(pmax <= THRL), 1)) { alpha = 1.f; }
  else { const float delta = FIRST ? pmax : fmaxf(pmax, 0.f); alpha = FIRST ? 1.f : __builtin_amdgcn_exp2f(-delta); m_reg += delta;
#pragma unroll
    for (int r = 0; r < 16; ++r) { negm[r] -= delta; p0[r] -= delta; p1[r] -= delta; } }
#pragma unroll
  for (int r = 0; r < 16; ++r) p0[r] = __builtin_amdgcn_exp2f(p0[r]);
}
__device__ __forceinline__ void finishSM(f32x16& p0, f32x16& p1, bf16x8& pa0, bf16x8& pa1, bf16x8& pa2, bf16x8& pa3) {
#pragma unroll
  for (int r = 0; r < 16; ++r) p1[r] = __builtin_amdgcn_exp2f(p1[r]);
#define PK4(P, BASE, OUT) do { unsigned a0 = cvtpk(P[BASE + 0], P[BASE + 1]), a1 = cvtpk(P[BASE + 2], P[BASE + 3]);   \
    unsigned b0 = cvtpk(P[BASE + 4], P[BASE + 5]), b1 = cvtpk(P[BASE + 6], P[BASE + 7]);                              \
    auto r0 = __builtin_amdgcn_permlane32_swap(a0, b0, false, false); auto r1 = __builtin_amdgcn_permlane32_swap(a1, b1, false, false); \
    u32x4 w = {r0[0], r1[0], r0[1], r1[1]}; OUT = *reinterpret_cast<bf16x8*>(&w); } while (0)
  PK4(p0, 0, pa0); PK4(p0, 8, pa1); PK4(p1, 0, pa2); PK4(p1, 8, pa3);
#undef PK4
}
template <int OFF> __device__ __forceinline__ bf16x8 krd(int addr) { bf16x8 r; asm volatile("ds_read_b128 %0, %1 offset:%2" : "=&v"(r) : "v"(addr), "i"(OFF) : "memory"); return r; }
template <int KOFF> __device__ __forceinline__ void qkt(f32x16& p0, f32x16& p1, const int (&ka)[6], const bf16x8* qr, const f32x16& negm) {
#define KA(d0) krd<KOFF>(ka[d0])
#define KB(d0) krd<KOFF + 8192>(ka[d0])
  const bf16x8 a0 = KA(0), b0 = KB(0), a1 = KA(1), b1 = KB(1), a2 = KA(2), b2 = KB(2);
  asm volatile("s_waitcnt lgkmcnt(4)" ::: "memory"); SBAR();
  p0 = __builtin_amdgcn_mfma_f32_32x32x16_bf16(a0, qr[0], negm, 0, 0, 0); p1 = __builtin_amdgcn_mfma_f32_32x32x16_bf16(b0, qr[0], negm, 0, 0, 0);
  const bf16x8 a3 = KA(3), b3 = KB(3);
  asm volatile("s_waitcnt lgkmcnt(4)" ::: "memory"); SBAR();
  p0 = __builtin_amdgcn_mfma_f32_32x32x16_bf16(a1, qr[1], p0, 0, 0, 0); p1 = __builtin_amdgcn_mfma_f32_32x32x16_bf16(b1, qr[1], p1, 0, 0, 0);
  const bf16x8 a4 = KA(4), b4 = KB(4);
  asm volatile("s_waitcnt lgkmcnt(4)" ::: "memory"); SBAR();
  p0 = __builtin_amdgcn_mfma_f32_32x32x16_bf16(a2, qr[2], p0, 0, 0, 0); p1 = __builtin_amdgcn_mfma_f32_32x32x16_bf16(b2, qr[2], p1, 0, 0, 0);
  const bf16x8 a5 = KA(5), b5 = KB(5);
  asm volatile("s_waitcnt lgkmcnt(4)" ::: "memory"); SBAR();
  p0 = __builtin_amdgcn_mfma_f32_32x32x16_bf16(a3, qr[3], p0, 0, 0, 0); p1 = __builtin_amdgcn_mfma_f32_32x32x16_bf16(b3, qr[3], p1, 0, 0, 0);
  asm volatile("s_waitcnt lgkmcnt(2)" ::: "memory"); SBAR();
  p0 = __builtin_amdgcn_mfma_f32_32x32x16_bf16(a4, qr[4], p0, 0, 0, 0); p1 = __builtin_amdgcn_mfma_f32_32x32x16_bf16(b4, qr[4], p1, 0, 0, 0);
  asm volatile("s_waitcnt lgkmcnt(0)" ::: "memory"); SBAR();
  p0 = __builtin_amdgcn_mfma_f32_32x32x16_bf16(a5, qr[5], p0, 0, 0, 0); p1 = __builtin_amdgcn_mfma_f32_32x32x16_bf16(b5, qr[5], p1, 0, 0, 0);
#undef KA
#undef KB
}
template <int KOFF> __device__ __forceinline__ void kpre(const int (&ka)[6], bf16x8 (&kf)[6]) {
  kf[0] = krd<KOFF>(ka[0]); kf[1] = krd<KOFF + 8192>(ka[0]); kf[2] = krd<KOFF>(ka[1]); kf[3] = krd<KOFF + 8192>(ka[1]); kf[4] = krd<KOFF>(ka[2]); kf[5] = krd<KOFF + 8192>(ka[2]); }
template <int KOFF> __device__ __forceinline__ void qkt_pre(f32x16& p0, f32x16& p1, const int (&ka)[6], const bf16x8* qr, const f32x16& negm, const bf16x8 (&kf)[6]) {
#define KA(d0) krd<KOFF>(ka[d0])
#define KB(d0) krd<KOFF + 8192>(ka[d0])
  const bf16x8 a3 = KA(3), b3 = KB(3), a4 = KA(4), b4 = KB(4);
  p0 = __builtin_amdgcn_mfma_f32_32x32x16_bf16(kf[0], qr[0], negm, 0, 0, 0); p1 = __builtin_amdgcn_mfma_f32_32x32x16_bf16(kf[1], qr[0], negm, 0, 0, 0);
  const bf16x8 a5 = KA(5), b5 = KB(5); SBAR();
  p0 = __builtin_amdgcn_mfma_f32_32x32x16_bf16(kf[2], qr[1], p0, 0, 0, 0); p1 = __builtin_amdgcn_mfma_f32_32x32x16_bf16(kf[3], qr[1], p1, 0, 0, 0);
  p0 = __builtin_amdgcn_mfma_f32_32x32x16_bf16(kf[4], qr[2], p0, 0, 0, 0); p1 = __builtin_amdgcn_mfma_f32_32x32x16_bf16(kf[5], qr[2], p1, 0, 0, 0);
  asm volatile("s_waitcnt lgkmcnt(4)" ::: "memory"); SBAR();
  p0 = __builtin_amdgcn_mfma_f32_32x32x16_bf16(a3, qr[3], p0, 0, 0, 0); p1 = __builtin_amdgcn_mfma_f32_32x32x16_bf16(b3, qr[3], p1, 0, 0, 0);
  asm volatile("s_waitcnt lgkmcnt(2)" ::: "memory"); SBAR();
  p0 = __builtin_amdgcn_mfma_f32_32x32x16_bf16(a4, qr[4], p0, 0, 0, 0); p1 = __builtin_amdgcn_mfma_f32_32x32x16_bf16(b4, qr[4], p1, 0, 0, 0);
  asm volatile("s_waitcnt lgkmcnt(0)" ::: "memory"); SBAR();
  p0 = __builtin_amdgcn_mfma_f32_32x32x16_bf16(a5, qr[5], p0, 0, 0, 0); p1 = __builtin_amdgcn_mfma_f32_32x32x16_bf16(b5, qr[5], p1, 0, 0, 0);
#undef KA
#undef KB
}
template <int KOFF> __device__ __forceinline__ void qkt_fin(f32x16& p0, f32x16& p1, const int (&ka)[6], const bf16x8* qr, const f32x16& negm, f32x16& q0, f32x16& q1, bf16x8& pa0, bf16x8& pa1, bf16x8& pa2, bf16x8& pa3) {
#define KA(d0) krd<KOFF>(ka[d0])
#define KB(d0) krd<KOFF + 8192>(ka[d0])
#define PK4(P, BASE, OUT) do { unsigned a0_ = cvtpk(P[BASE + 0], P[BASE + 1]), a1_ = cvtpk(P[BASE + 2], P[BASE + 3]);   \
    unsigned b0_ = cvtpk(P[BASE + 4], P[BASE + 5]), b1_ = cvtpk(P[BASE + 6], P[BASE + 7]);                              \
    auto r0_ = __builtin_amdgcn_permlane32_swap(a0_, b0_, false, false); auto r1_ = __builtin_amdgcn_permlane32_swap(a1_, b1_, false, false); \
    u32x4 w_ = {r0_[0], r1_[0], r0_[1], r1_[1]}; OUT = *reinterpret_cast<bf16x8*>(&w_); } while (0)
#define EX(i) q1[i] = __builtin_amdgcn_exp2f(q1[i])
  const bf16x8 a0 = KA(0), b0 = KB(0), a1 = KA(1), b1 = KB(1), a2 = KA(2), b2 = KB(2);
  asm volatile("s_waitcnt lgkmcnt(4)" ::: "memory"); SBAR();
  p0 = __builtin_amdgcn_mfma_f32_32x32x16_bf16(a0, qr[0], negm, 0, 0, 0); p1 = __builtin_amdgcn_mfma_f32_32x32x16_bf16(b0, qr[0], negm, 0, 0, 0);
  PK4(q0, 0, pa0); EX(0); EX(1);
  const bf16x8 a3 = KA(3), b3 = KB(3);
  asm volatile("s_waitcnt lgkmcnt(4)" ::: "memory"); SBAR();
  p0 = __builtin_amdgcn_mfma_f32_32x32x16_bf16(a1, qr[1], p0, 0, 0, 0); p1 = __builtin_amdgcn_mfma_f32_32x32x16_bf16(b1, qr[1], p1, 0, 0, 0);
  PK4(q0, 8, pa1); EX(2); EX(3);
  const bf16x8 a4 = KA(4), b4 = KB(4);
  asm volatile("s_waitcnt lgkmcnt(4)" ::: "memory"); SBAR();
  p0 = __builtin_amdgcn_mfma_f32_32x32x16_bf16(a2, qr[2], p0, 0, 0, 0); p1 = __builtin_amdgcn_mfma_f32_32x32x16_bf16(b2, qr[2], p1, 0, 0, 0);
  EX(4); EX(5); EX(6); EX(7);
  const bf16x8 a5 = KA(5), b5 = KB(5);
  asm volatile("s_waitcnt lgkmcnt(4)" ::: "memory"); SBAR();
  p0 = __builtin_amdgcn_mfma_f32_32x32x16_bf16(a3, qr[3], p0, 0, 0, 0); p1 = __builtin_amdgcn_mfma_f32_32x32x16_bf16(b3, qr[3], p1, 0, 0, 0);
  EX(8); EX(9); EX(10); EX(11);
  asm volatile("s_waitcnt lgkmcnt(2)" ::: "memory"); SBAR();
  p0 = __builtin_amdgcn_mfma_f32_32x32x16_bf16(a4, qr[4], p0, 0, 0, 0); p1 = __builtin_amdgcn_mfma_f32_32x32x16_bf16(b4, qr[4], p1, 0, 0, 0);
  EX(12); EX(13); EX(14); EX(15);
  asm volatile("s_waitcnt lgkmcnt(0)" ::: "memory"); SBAR();
  p0 = __builtin_amdgcn_mfma_f32_32x32x16_bf16(a5, qr[5], p0, 0, 0, 0); p1 = __builtin_amdgcn_mfma_f32_32x32x16_bf16(b5, qr[5], p1, 0, 0, 0);
  PK4(q1, 0, pa2); PK4(q1, 8, pa3);
#undef EX
#undef PK4
#undef KA
#undef KB
}
__device__ __forceinline__ int v_st(int k, int c) { const int kk = (k & ~0xC) | ((k & 4) << 1) | ((k & 8) >> 1); return ((kk >> 3) * 2 + (c >> 5)) * 512 + ((kk & 7) * 32 + (c & 31)) * 2; }
__device__ __forceinline__ int v_rd_base(int lane) { return ((lane & 3) << 3) | (((lane >> 2) & 3) << 6) | (((lane >> 4) & 1) << 5) | (((lane >> 5) & 1) << 8); }
constexpr int v_rd_off(int d0, int ks, int half) { return d0 * 512 + ks * 2048 + half * 1024; }
template <int OFF> __device__ __forceinline__ s16x4 tr_read(int vb) {
  s16x4 r; asm volatile("ds_read_b64_tr_b16 %0, %1 offset:%2" : "=&v"(r) : "v"(vb), "i"(OFF) : "memory"); return r; }
template <int VOFF, bool SPLIT> __device__ __forceinline__ void pv_d0(f32x16* o, int vb, bf16x8 pa0, bf16x8 pa1, bf16x8 pa2, bf16x8 pa3) {
#define PK(L, H) (bf16x8){L[0], L[1], L[2], L[3], H[0], H[1], H[2], H[3]}
  if constexpr (SPLIT) {
    const bf16x8 ones = {0x3F80, 0x3F80, 0x3F80, 0x3F80, 0x3F80, 0x3F80, 0x3F80, 0x3F80};
    { const s16x4 l0 = tr_read<VOFF + v_rd_off(0, 0, 0)>(vb), h0 = tr_read<VOFF + v_rd_off(0, 0, 1)>(vb), m0 = tr_read<VOFF + v_rd_off(1, 0, 0)>(vb), g0 = tr_read<VOFF + v_rd_off(1, 0, 1)>(vb);
      const s16x4 l1 = tr_read<VOFF + v_rd_off(0, 1, 0)>(vb), h1 = tr_read<VOFF + v_rd_off(0, 1, 1)>(vb), m1 = tr_read<VOFF + v_rd_off(1, 1, 0)>(vb), g1 = tr_read<VOFF + v_rd_off(1, 1, 1)>(vb);
      asm volatile("s_waitcnt lgkmcnt(4)" ::: "memory"); SBAR();
      o[0] = __builtin_amdgcn_mfma_f32_32x32x16_bf16(pa0, PK(l0, h0), o[0], 0, 0, 0); o[1] = __builtin_amdgcn_mfma_f32_32x32x16_bf16(pa0, PK(m0, g0), o[1], 0, 0, 0);
      asm volatile("s_waitcnt lgkmcnt(0)" ::: "memory"); SBAR();
      o[0] = __builtin_amdgcn_mfma_f32_32x32x16_bf16(pa1, PK(l1, h1), o[0], 0, 0, 0); o[1] = __builtin_amdgcn_mfma_f32_32x32x16_bf16(pa1, PK(m1, g1), o[1], 0, 0, 0); SBAR(); }
    { const s16x4 l2 = tr_read<VOFF + v_rd_off(0, 2, 0)>(vb), h2 = tr_read<VOFF + v_rd_off(0, 2, 1)>(vb), m2 = tr_read<VOFF + v_rd_off(1, 2, 0)>(vb), g2 = tr_read<VOFF + v_rd_off(1, 2, 1)>(vb);
      const s16x4 l3 = tr_read<VOFF + v_rd_off(0, 3, 0)>(vb), h3 = tr_read<VOFF + v_rd_off(0, 3, 1)>(vb), m3 = tr_read<VOFF + v_rd_off(1, 3, 0)>(vb), g3 = tr_read<VOFF + v_rd_off(1, 3, 1)>(vb);
      o[2] = __builtin_amdgcn_mfma_f32_32x32x16_bf16(pa0, ones, o[2], 0, 0, 0); o[2] = __builtin_amdgcn_mfma_f32_32x32x16_bf16(pa1, ones, o[2], 0, 0, 0);
      o[2] = __builtin_amdgcn_mfma_f32_32x32x16_bf16(pa2, ones, o[2], 0, 0, 0); o[2] = __builtin_amdgcn_mfma_f32_32x32x16_bf16(pa3, ones, o[2], 0, 0, 0);
      asm volatile("s_waitcnt lgkmcnt(4)" ::: "memory"); SBAR();
      o[0] = __builtin_amdgcn_mfma_f32_32x32x16_bf16(pa2, PK(l2, h2), o[0], 0, 0, 0); o[1] = __builtin_amdgcn_mfma_f32_32x32x16_bf16(pa2, PK(m2, g2), o[1], 0, 0, 0);
      asm volatile("s_waitcnt lgkmcnt(0)" ::: "memory"); SBAR();
      o[0] = __builtin_amdgcn_mfma_f32_32x32x16_bf16(pa3, PK(l3, h3), o[0], 0, 0, 0); o[1] = __builtin_amdgcn_mfma_f32_32x32x16_bf16(pa3, PK(m3, g3), o[1], 0, 0, 0); }
  } else {

  const s16x4 l0 = tr_read<VOFF + v_rd_off(0, 0, 0)>(vb), h0 = tr_read<VOFF + v_rd_off(0, 0, 1)>(vb), m0 = tr_read<VOFF + v_rd_off(1, 0, 0)>(vb), g0 = tr_read<VOFF + v_rd_off(1, 0, 1)>(vb);
  const s16x4 l1 = tr_read<VOFF + v_rd_off(0, 1, 0)>(vb), h1 = tr_read<VOFF + v_rd_off(0, 1, 1)>(vb), m1 = tr_read<VOFF + v_rd_off(1, 1, 0)>(vb), g1 = tr_read<VOFF + v_rd_off(1, 1, 1)>(vb);
  const s16x4 l2 = tr_read<VOFF + v_rd_off(0, 2, 0)>(vb), h2 = tr_read<VOFF + v_rd_off(0, 2, 1)>(vb), m2 = tr_read<VOFF + v_rd_off(1, 2, 0)>(vb), g2 = tr_read<VOFF + v_rd_off(1, 2, 1)>(vb);
  const s16x4 l3 = tr_read<VOFF + v_rd_off(0, 3, 0)>(vb), h3 = tr_read<VOFF + v_rd_off(0, 3, 1)>(vb), m3 = tr_read<VOFF + v_rd_off(1, 3, 0)>(vb), g3 = tr_read<VOFF + v_rd_off(1, 3, 1)>(vb);
  asm volatile("s_waitcnt lgkmcnt(12)" ::: "memory"); SBAR();
  o[0] = __builtin_amdgcn_mfma_f32_32x32x16_bf16(pa0, PK(l0, h0), o[0], 0, 0, 0); o[1] = __builtin_amdgcn_mfma_f32_32x32x16_bf16(pa0, PK(m0, g0), o[1], 0, 0, 0);
  asm volatile("s_waitcnt lgkmcnt(8)" ::: "memory"); SBAR();
  o[0] = __builtin_amdgcn_mfma_f32_32x32x16_bf16(pa1, PK(l1, h1), o[0], 0, 0, 0); o[1] = __builtin_amdgcn_mfma_f32_32x32x16_bf16(pa1, PK(m1, g1), o[1], 0, 0, 0);
  asm volatile("s_waitcnt lgkmcnt(4)" ::: "memory"); SBAR();
  o[0] = __builtin_amdgcn_mfma_f32_32x32x16_bf16(pa2, PK(l2, h2), o[0], 0, 0, 0); o[1] = __builtin_amdgcn_mfma_f32_32x32x16_bf16(pa2, PK(m2, g2), o[1], 0, 0, 0);
  asm volatile("s_waitcnt lgkmcnt(0)" ::: "memory"); SBAR();
  o[0] = __builtin_amdgcn_mfma_f32_32x32x16_bf16(pa3, PK(l3, h3), o[0], 0, 0, 0); o[1] = __builtin_amdgcn_mfma_f32_32x32x16_bf16(pa3, PK(m3, g3), o[1], 0, 0, 0);
  { const bf16x8 ones = {0x3F80, 0x3F80, 0x3F80, 0x3F80, 0x3F80, 0x3F80, 0x3F80, 0x3F80};
    o[2] = __builtin_amdgcn_mfma_f32_32x32x16_bf16(pa0, ones, o[2], 0, 0, 0); o[2] = __builtin_amdgcn_mfma_f32_32x32x16_bf16(pa1, ones, o[2], 0, 0, 0);
    o[2] = __builtin_amdgcn_mfma_f32_32x32x16_bf16(pa2, ones, o[2], 0, 0, 0); o[2] = __builtin_amdgcn_mfma_f32_32x32x16_bf16(pa3, ones, o[2], 0, 0, 0); }
  }
#undef PK
}
template <int KOFF, int VOFF> __device__ __forceinline__ void m_phase(f32x16& p0, f32x16& p1, const int (&ka)[6], const bf16x8* qr, const f32x16& negm, const bf16x8 (&kf)[6], f32x16* o, int vb, bf16x8 pa0, bf16x8 pa1, bf16x8 pa2, bf16x8 pa3) {
#define KA(d0) krd<KOFF>(ka[d0])
#define KB(d0) krd<KOFF + 8192>(ka[d0])
#define PK(L, H) (bf16x8){L[0], L[1], L[2], L[3], H[0], H[1], H[2], H[3]}
  const bf16x8 a3 = KA(3), b3 = KB(3), a4 = KA(4), b4 = KB(4);
  p0 = __builtin_amdgcn_mfma_f32_32x32x16_bf16(kf[0], qr[0], negm, 0, 0, 0); p1 = __builtin_amdgcn_mfma_f32_32x32x16_bf16(kf[1], qr[0], negm, 0, 0, 0);
  const bf16x8 a5 = KA(5), b5 = KB(5); SBAR();
  p0 = __builtin_amdgcn_mfma_f32_32x32x16_bf16(kf[2], qr[1], p0, 0, 0, 0); p1 = __builtin_amdgcn_mfma_f32_32x32x16_bf16(kf[3], qr[1], p1, 0, 0, 0);
  p0 = __builtin_amdgcn_mfma_f32_32x32x16_bf16(kf[4], qr[2], p0, 0, 0, 0); p1 = __builtin_amdgcn_mfma_f32_32x32x16_bf16(kf[5], qr[2], p1, 0, 0, 0);
  asm volatile("s_waitcnt lgkmcnt(4)" ::: "memory"); SBAR();
  p0 = __builtin_amdgcn_mfma_f32_32x32x16_bf16(a3, qr[3], p0, 0, 0, 0); p1 = __builtin_amdgcn_mfma_f32_32x32x16_bf16(b3, qr[3], p1, 0, 0, 0);
  const s16x4 l0 = tr_read<VOFF + v_rd_off(0, 0, 0)>(vb), h0 = tr_read<VOFF + v_rd_off(0, 0, 1)>(vb), m0 = tr_read<VOFF + v_rd_off(1, 0, 0)>(vb), g0 = tr_read<VOFF + v_rd_off(1, 0, 1)>(vb);
  const s16x4 l1 = tr_read<VOFF + v_rd_off(0, 1, 0)>(vb), h1 = tr_read<VOFF + v_rd_off(0, 1, 1)>(vb);
  asm volatile("s_waitcnt lgkmcnt(8)" ::: "memory"); SBAR();
  p0 = __builtin_amdgcn_mfma_f32_32x32x16_bf16(a4, qr[4], p0, 0, 0, 0); p1 = __builtin_amdgcn_mfma_f32_32x32x16_bf16(b4, qr[4], p1, 0, 0, 0);
  const s16x4 m1 = tr_read<VOFF + v_rd_off(1, 1, 0)>(vb), g1 = tr_read<VOFF + v_rd_off(1, 1, 1)>(vb);
  const s16x4 l2 = tr_read<VOFF + v_rd_off(0, 2, 0)>(vb), h2 = tr_read<VOFF + v_rd_off(0, 2, 1)>(vb), m2 = tr_read<VOFF + v_rd_off(1, 2, 0)>(vb), g2 = tr_read<VOFF + v_rd_off(1, 2, 1)>(vb);
  asm volatile("s_waitcnt lgkmcnt(12)" ::: "memory"); SBAR();
  p0 = __builtin_amdgcn_mfma_f32_32x32x16_bf16(a5, qr[5], p0, 0, 0, 0); p1 = __builtin_amdgcn_mfma_f32_32x32x16_bf16(b5, qr[5], p1, 0, 0, 0);
  asm volatile("s_waitcnt lgkmcnt(8)" ::: "memory"); SBAR();
  o[0] = __builtin_amdgcn_mfma_f32_32x32x16_bf16(pa0, PK(l0, h0), o[0], 0, 0, 0); o[1] = __builtin_amdgcn_mfma_f32_32x32x16_bf16(pa0, PK(m0, g0), o[1], 0, 0, 0);
  const s16x4 l3 = tr_read<VOFF + v_rd_off(0, 3, 0)>(vb), h3 = tr_read<VOFF + v_rd_off(0, 3, 1)>(vb), m3 = tr_read<VOFF + v_rd_off(1, 3, 0)>(vb), g3 = tr_read<VOFF + v_rd_off(1, 3, 1)>(vb);
  asm volatile("s_waitcnt lgkmcnt(8)" ::: "memory"); SBAR();
  o[0] = __builtin_amdgcn_mfma_f32_32x32x16_bf16(pa1, PK(l1, h1), o[0], 0, 0, 0); o[1] = __builtin_amdgcn_mfma_f32_32x32x16_bf16(pa1, PK(m1, g1), o[1], 0, 0, 0);
  asm volatile("s_waitcnt lgkmcnt(4)" ::: "memory"); SBAR();
  o[0] = __builtin_amdgcn_mfma_f32_32x32x16_bf16(pa2, PK(l2, h2), o[0], 0, 0, 0); o[1] = __builtin_amdgcn_mfma_f32_32x32x16_bf16(pa2, PK(m2, g2), o[1], 0, 0, 0);
  asm volatile("s_waitcnt lgkmcnt(0)" ::: "memory"); SBAR();
  o[0] = __builtin_amdgcn_mfma_f32_32x32x16_bf16(pa3, PK(l3, h3), o[0], 0, 0, 0); o[1] = __builtin_amdgcn_mfma_f32_32x32x16_bf16(pa3, PK(m3, g3), o[1], 0, 0, 0);
  { const bf16x8 ones = {0x3F80, 0x3F80, 0x3F80, 0x3F80, 0x3F80, 0x3F80, 0x3F80, 0x3F80};
    o[2] = __builtin_amdgcn_mfma_f32_32x32x16_bf16(pa0, ones, o[2], 0, 0, 0); o[2] = __builtin_amdgcn_mfma_f32_32x32x16_bf16(pa1, ones, o[2], 0, 0, 0);
    o[2] = __builtin_amdgcn_mfma_f32_32x32x16_bf16(pa2, ones, o[2], 0, 0, 0); o[2] = __builtin_amdgcn_mfma_f32_32x32x16_bf16(pa3, ones, o[2], 0, 0, 0); }
#undef PK
#undef KA
#undef KB
}
__device__ __forceinline__ unsigned short f2bf(float f) { unsigned u = __float_as_uint(f); return (unsigned short)((u + 0x7fffu + ((u >> 16) & 1u)) >> 16); }

struct NoHook { static constexpr bool ACTIVE = false; __device__ __forceinline__ void issue(int) {} __device__ __forceinline__ void finish() {} };
template <class HK> __device__ __forceinline__ void attn_unit(const bf16_t* __restrict__ Qb, const bf16_t* __restrict__ Kh, const bf16_t* __restrict__ Vh, bf16_t* __restrict__ Ob, int opitch, int seq, LAS char* lds, int tid_in, HK& hk) {
  int tid_ = tid_in; asm volatile("" : "+v"(tid_));
  const int tid = tid_, wid = tid >> 6, lane = tid & 63, r32 = lane & 31, hi = lane >> 5;
  LAS char* V_lds = lds + LDS_V; LAS char* K_lds = lds + LDS_K;
  LAS float* ws = (LAS float*)(lds + LDS_WS) + wid * 64; LAS float* li_l = ws; LAS float* al_l = ws + 32;
  float m_reg = 0.f; f32x16 o[3] = {}; f32x16 negm = {}; bf16x8 qr[6];
  const bf16_t* Qw = Qb + (size_t)(wid * QBLK + r32) * DQK + hi * 8;
#pragma unroll
  for (int d0 = 0; d0 < 6; ++d0) qr[d0] = *(const bf16x8*)(Qw + d0 * 16);
  const int vr = tid >> 3, vc = (tid & 7) * 8, vst = v_st(vr, vc);
  const int c1 = (tid + 512) % 768, kr0 = tid / 12, kc0 = (tid % 12) * 8, kr1 = c1 / 12, kc1 = (c1 % 12) * 8;
  const int kst0 = KSWZ(kr0, kc0 * 2), kst1 = KSWZ(kr1, kc1 * 2);
  const int vb0 = (int)(uintptr_t)V_lds + v_rd_base(lane);
  int ka[6];
#pragma unroll
  for (int d0 = 0; d0 < 6; ++d0) ka[d0] = (int)(uintptr_t)K_lds + r32 * 256 + ((d0 * 32 + hi * 16) ^ ((r32 & 7) << 4));
  bf16x8 sv0, sk00, sk01, sv1, sk10, sk11;
#define SLOAD0(k0) do { sv0 = *(const bf16x8*)(Vh + (size_t)((k0) + vr) * DV + vc); sk00 = *(const bf16x8*)(Kh + (size_t)((k0) + kr0) * DQK + kc0); sk01 = *(const bf16x8*)(Kh + (size_t)((k0) + kr1) * DQK + kc1); } while (0)
#define SLOAD1(k0) do { sv1 = *(const bf16x8*)(Vh + (size_t)((k0) + vr) * DV + vc); sk10 = *(const bf16x8*)(Kh + (size_t)((k0) + kr0) * DQK + kc0); sk11 = *(const bf16x8*)(Kh + (size_t)((k0) + kr1) * DQK + kc1); } while (0)
#define SWRITE0(b) do { *(LAS bf16x8*)(V_lds + (b) * SHM_V + vst) = sv0; *(LAS bf16x8*)(K_lds + (b) * SHM_K + kst0) = sk00; *(LAS bf16x8*)(K_lds + (b) * SHM_K + kst1) = sk01; } while (0)
#define SWRITE1(b) do { *(LAS bf16x8*)(V_lds + (b) * SHM_V + vst) = sv1; *(LAS bf16x8*)(K_lds + (b) * SHM_K + kst0) = sk10; *(LAS bf16x8*)(K_lds + (b) * SHM_K + kst1) = sk11; } while (0)
#define SWAIT() asm volatile("s_waitcnt vmcnt(3)" ::: "memory")
#define SWAITH(n) do { if constexpr (HK::ACTIVE) asm volatile("s_waitcnt vmcnt(" #n ")" ::: "memory"); else asm volatile("s_waitcnt vmcnt(3)" ::: "memory"); } while (0)
#define RESC(a) do { if (__any((a) < 1.f)) { if (hi == 0) al_l[r32] = (a); asm volatile("s_waitcnt lgkmcnt(0)" ::: "memory"); \
    _Pragma("unroll") for (int d = 0; d < 3; ++d) _Pragma("unroll") for (int r = 0; r < 16; ++r) o[d][r] *= al_l[crow(r, hi)]; } } while (0)
  f32x16 pA0, pA1, pB0, pB1; float alA, alB; bf16x8 pa0, pa1, pa2, pa3; const int NT = seq / KVBLK;
  SLOAD0(0); asm volatile("s_waitcnt vmcnt(0)" ::: "memory"); SWRITE0(0); __syncthreads();
  qkt<0>(pA0, pA1, ka, qr, negm); partialSM<true>(pA0, pA1, m_reg, negm, alA);
  if constexpr (HK::ACTIVE) hk.issue(0);
  SLOAD1(KVBLK); if (2 < NT) SLOAD0(2 * KVBLK);
  SWAIT(); SWRITE1(1); __syncthreads();
#define ATT_STEP(j_, PC0, PC1, ALC, PP0, PP1, ALP, KB, VB, WB, LD, WR, DO_LD, DO_WR, HOOK, WN) do { \
    SBAR(); { f32x16 nm_; if constexpr (HK::ACTIVE) { _Pragma("unroll") for (int r_ = 0; r_ < 16; ++r_) nm_[r_] = -m_reg; } else nm_ = negm; qkt_fin<(KB) * SHM_K>(PC0, PC1, ka, qr, nm_, PP0, PP1, pa0, pa1, pa2, pa3); } SBAR(); \
    if constexpr (HK::ACTIVE && HOOK) hk.finish(); if (DO_LD) SLOAD##LD(((j_) + 2) * KVBLK); if constexpr (HK::ACTIVE && HOOK) hk.issue(((j_) >> 2) + 1); SBAR(); \
    pv_d0<(VB) * SHM_V, HK::ACTIVE>(o, vb0, pa0, pa1, pa2, pa3); if constexpr (HK::ACTIVE) { f32x16 dm_ = {}; partialSM<false>(PC0, PC1, m_reg, dm_, ALC); } else partialSM<false>(PC0, PC1, m_reg, negm, ALC); \
    if (DO_WR) { SWAITH(WN); SWRITE##WR(WB); } \
    RESC(ALC); __syncthreads(); } while (0)
  int j = 1;
  for (; j < NT - 3; j += 4) {
    ATT_STEP(j,     pB0, pB1, alB, pA0, pA1, alA, 1, 0, 2, 1, 0, true, true, true, 11);
    ATT_STEP(j + 1, pA0, pA1, alA, pB0, pB1, alB, 2, 1, 3, 0, 1, true, true, false, 7);
    ATT_STEP(j + 2, pB0, pB1, alB, pA0, pA1, alA, 3, 2, 0, 1, 0, true, true, false, 3);
    ATT_STEP(j + 3, pA0, pA1, alA, pB0, pB1, alB, 0, 3, 1, 0, 1, true, true, false, 3);
  }
  if constexpr (HK::ACTIVE) hk.finish();
  ATT_STEP(j,     pB0, pB1, alB, pA0, pA1, alA, 1, 0, 2, 1, 0, true, true, false, 3);
  ATT_STEP(j + 1, pA0, pA1, alA, pB0, pB1, alB, 2, 1, 3, 0, 1, false, true, false, 3);
  ATT_STEP(j + 2, pB0, pB1, alB, pA0, pA1, alA, 3, 2, 0, 1, 0, false, false, false, 3);
#undef ATT_STEP
  finishSM(pB0, pB1, pa0, pa1, pa2, pa3); SBAR();
  pv_d0<3 * SHM_V, HK::ACTIVE>(o, vb0, pa0, pa1, pa2, pa3);
  float rli[16];
#pragma unroll
  for (int r = 0; r < 16; ++r) rli[r] = __builtin_amdgcn_rcpf(o[2][r]);
  bf16_t* Ow = Ob + (size_t)(wid * QBLK) * opitch;
#pragma unroll
  for (int r = 0; r < 16; ++r) { const int orow = crow(r, hi);
#pragma unroll
    for (int d0 = 0; d0 < 2; ++d0) Ow[(size_t)orow * opitch + d0 * 32 + r32] = f2bf(o[d0][r] * rli[r]); }
  __syncthreads();
#undef SLOAD0
#undef SLOAD1
#undef SWRITE0
#undef SWRITE1
#undef SWAIT
#undef SWAITH
#undef RESC
}

constexpr int PP_CNT_OFF = 131072 + 320 + 20 * 4;
template <class HK> __device__ __forceinline__ void attn_unit_pp(const bf16_t* __restrict__ Qb, const bf16_t* __restrict__ Kh, const bf16_t* __restrict__ Vh, bf16_t* __restrict__ Ob, int opitch, int seq, LAS char* lds, int tid_in, HK&) {
  int tid_ = tid_in; asm volatile("" : "+v"(tid_));
  const int tid = tid_, wid = tid >> 6, lane = tid & 63, r32 = lane & 31, hi = lane >> 5;
  int grp; { const unsigned simd = ((unsigned)__builtin_amdgcn_s_getreg(63492) >> 4) & 3u; unsigned old_ = 0u; if (lane == 0) old_ = __hip_atomic_fetch_add((LAS unsigned*)(lds + PP_CNT_OFF) + simd, 1u, __ATOMIC_RELAXED, __HIP_MEMORY_SCOPE_WORKGROUP); grp = __builtin_amdgcn_readfirstlane(old_) & 1; }
  LAS char* V_lds = lds + LDS_V; LAS char* K_lds = lds + LDS_K;
  LAS float* ws = (LAS float*)(lds + LDS_WS) + wid * 64; LAS float* al_l = ws + 32;
  float m_reg = 0.f; f32x16 o[3] = {}; f32x16 negm = {}; bf16x8 qr[6];
  const bf16_t* Qw = Qb + (size_t)(wid * QBLK + r32) * DQK + hi * 8;
#pragma unroll
  for (int d0 = 0; d0 < 6; ++d0) qr[d0] = *(const bf16x8*)(Qw + d0 * 16);
  const int vr = tid >> 3, vc = (tid & 7) * 8, vst = v_st(vr, vc);
  const int c1 = (tid + 512) % 768, kr0 = tid / 12, kc0 = (tid % 12) * 8, kr1 = c1 / 12, kc1 = (c1 % 12) * 8;
  const int kst0 = KSWZ(kr0, kc0 * 2), kst1 = KSWZ(kr1, kc1 * 2);
  const int vb0 = (int)(uintptr_t)V_lds + v_rd_base(lane);
  int ka[6];
#pragma unroll
  for (int d0 = 0; d0 < 6; ++d0) ka[d0] = (int)(uintptr_t)K_lds + r32 * 256 + ((d0 * 32 + hi * 16) ^ ((r32 & 7) << 4));
  bf16x8 sv0, sk00, sk01, sv1, sk10, sk11;
#define SLOAD0(k0) do { sv0 = *(const bf16x8*)(Vh + (size_t)((k0) + vr) * DV + vc); sk00 = *(const bf16x8*)(Kh + (size_t)((k0) + kr0) * DQK + kc0); sk01 = *(const bf16x8*)(Kh + (size_t)((k0) + kr1) * DQK + kc1); } while (0)
#define SLOAD1(k0) do { sv1 = *(const bf16x8*)(Vh + (size_t)((k0) + vr) * DV + vc); sk10 = *(const bf16x8*)(Kh + (size_t)((k0) + kr0) * DQK + kc0); sk11 = *(const bf16x8*)(Kh + (size_t)((k0) + kr1) * DQK + kc1); } while (0)
#define SWRITE0(b) do { *(LAS bf16x8*)(V_lds + (b) * SHM_V + vst) = sv0; *(LAS bf16x8*)(K_lds + (b) * SHM_K + kst0) = sk00; *(LAS bf16x8*)(K_lds + (b) * SHM_K + kst1) = sk01; } while (0)
#define SWRITE1(b) do { *(LAS bf16x8*)(V_lds + (b) * SHM_V + vst) = sv1; *(LAS bf16x8*)(K_lds + (b) * SHM_K + kst0) = sk10; *(LAS bf16x8*)(K_lds + (b) * SHM_K + kst1) = sk11; } while (0)
#define SWAIT() asm volatile("s_waitcnt vmcnt(3)" ::: "memory")
#define RESC(a) do { if (__any((a) < 1.f)) { if (hi == 0) al_l[r32] = (a); asm volatile("s_waitcnt lgkmcnt(0)" ::: "memory"); \
    _Pragma("unroll") for (int d = 0; d < 3; ++d) _Pragma("unroll") for (int r = 0; r < 16; ++r) o[d][r] *= al_l[crow(r, hi)]; } } while (0)
#define PBAR() do { asm volatile("s_waitcnt lgkmcnt(0)" ::: "memory"); __builtin_amdgcn_s_barrier(); asm volatile("" ::: "memory"); } while (0)
  f32x16 p0, p1; float al; bf16x8 pa0, pa1, pa2, pa3; const int NT = seq / KVBLK;
  SLOAD0(0); SLOAD1(KVBLK); asm volatile("s_waitcnt vmcnt(0)" ::: "memory"); SWRITE0(0); SWRITE1(1);
  SLOAD0(2 * KVBLK); SLOAD1(3 * KVBLK);
  __syncthreads();
  bf16x8 kf[6]; kpre<0>(ka, kf);
  if (grp == 1) PBAR();
#define PP_STEP(t_, KB, VBP, WB, SL, FIRST_) do { \
    SBAR(); if (FIRST_) qkt_pre<(KB) * SHM_K>(p0, p1, ka, qr, negm, kf); else m_phase<(KB) * SHM_K, (VBP) * SHM_V>(p0, p1, ka, qr, negm, kf, o, vb0, pa0, pa1, pa2, pa3); SBAR(); \
    PBAR(); \
    partialSM<FIRST_>(p0, p1, m_reg, negm, al); if (!(FIRST_)) RESC(al); finishSM(p0, p1, pa0, pa1, pa2, pa3); SBAR(); \
    if ((t_) + 2 < NT) { SWAIT(); SWRITE##SL(WB); } SLOAD##SL(((t_) + 4 < NT ? (t_) + 4 : NT - 1) * KVBLK); \
    SBAR(); kpre<(((KB) + 1) & 3) * SHM_K>(ka, kf); \
    PBAR(); } while (0)
  PP_STEP(0, 0, 3, 2, 0, true); PP_STEP(1, 1, 0, 3, 1, false); PP_STEP(2, 2, 1, 0, 0, false); PP_STEP(3, 3, 2, 1, 1, false);
#pragma unroll 1
  for (int t = 4; t < NT; t += 4) { PP_STEP(t, 0, 3, 2, 0, false); PP_STEP(t + 1, 1, 0, 3, 1, false); PP_STEP(t + 2, 2, 1, 0, 0, false); PP_STEP(t + 3, 3, 2, 1, 1, false); }
#undef PP_STEP
  SBAR(); pv_d0<3 * SHM_V, false>(o, vb0, pa0, pa1, pa2, pa3);
  if (grp == 0) PBAR();
  float rli[16];
#pragma unroll
  for (int r = 0; r < 16; ++r) rli[r] = __builtin_amdgcn_rcpf(o[2][r]);
  bf16_t* Ow = Ob + (size_t)(wid * QBLK) * opitch;
#pragma unroll
  for (int r = 0; r < 16; ++r) { const int orow = crow(r, hi);
#pragma unroll
    for (int d0 = 0; d0 < 2; ++d0) Ow[(size_t)orow * opitch + d0 * 32 + r32] = f2bf(o[d0][r] * rli[r]); }
  __syncthreads();
#undef PBAR
#undef SLOAD0
#undef SLOAD1
#undef SWRITE0
#undef SWRITE1
#undef SWAIT
#undef RESC
}
#undef KSWZ
#undef SBAR
}

typedef unsigned short bf16_t;
typedef unsigned u32x4 __attribute__((ext_vector_type(4)));
typedef unsigned u32x2 __attribute__((ext_vector_type(2)));
typedef float f32x4 __attribute__((ext_vector_type(4)));
typedef float f32x2 __attribute__((ext_vector_type(2)));
typedef GAS unsigned gu32;
#define RLX_AGENT __ATOMIC_RELAXED, __HIP_MEMORY_SCOPE_AGENT
#define LDS_WAIT() asm volatile("s_waitcnt lgkmcnt(0)" ::: "memory")
#define VM_WAIT() asm volatile("s_waitcnt vmcnt(0)" ::: "memory")
__device__ __forceinline__ unsigned f2bf(float f) { unsigned u = __builtin_bit_cast(unsigned, f); return (u + 0x7fffu + ((u >> 16) & 1u)) >> 16; }
__device__ __forceinline__ unsigned pk2(float lo, float hi) { return f2bf(lo) | (f2bf(hi) << 16); }
__device__ __forceinline__ float bflo(unsigned u) { return __uint_as_float(u << 16); }
__device__ __forceinline__ float bfhi(unsigned u) { return __uint_as_float(u & 0xffff0000u); }
__device__ __forceinline__ float bf1(bf16_t h) { return __uint_as_float(((unsigned)h) << 16); }
__device__ __forceinline__ float sigm(float x) { return 1.0f / (1.0f + __expf(-x)); }
__device__ __forceinline__ float lane_xor(float v, int lane, int o) { return __int_as_float(__builtin_amdgcn_ds_bpermute((lane ^ o) << 2, __float_as_int(v))); }
__device__ __forceinline__ float wave_sum(float v, int lane) {
#pragma unroll
    for (int o = 1; o < 64; o <<= 1) v += lane_xor(v, lane, o);
    return v;
}
#define XB_TMO      128
#define XB_XCNT(j)  (256  + 64 * (j))
#define XB_XSUB(j)  (1280 + 64 * (j))
#define XB_XGEN(j)  (2304 + 64 * (j))
#define XB_TOP      3328
#define XB_TOPGEN   3392
#define XCD_BAR_WORDS 3456
#define XB_SPIN_CAP (1u << 18)

__device__ __forceinline__ unsigned xb_ld(unsigned* p)              { return __hip_atomic_load(p, __ATOMIC_RELAXED, __HIP_MEMORY_SCOPE_AGENT); }
__device__ __forceinline__ unsigned xb_add(unsigned* p, unsigned v) { return __hip_atomic_fetch_add(p, v, __ATOMIC_RELAXED, __HIP_MEMORY_SCOPE_AGENT); }
__device__ __forceinline__ unsigned xb_xcc_id() { return (unsigned)__builtin_amdgcn_s_getreg((3 << 11) | 20) & 0xFu; }
#define XB_SPIN(cond, bar) do { unsigned _sp = 0; while (cond) { __builtin_amdgcn_s_sleep(1); \
    if ((++_sp & 255u) == 0u) { if (xb_ld(&(bar)[XB_TMO])) break; if (_sp > XB_SPIN_CAP) { atomicAdd(&(bar)[XB_TMO], 1u); break; } } } } while (0)

struct XcdBarrier {
    unsigned* bar; unsigned x;
    volatile LAS unsigned* st;
};

__device__ __forceinline__ XcdBarrier xcd_barrier_post(unsigned* bar, volatile LAS unsigned* st) {
    XcdBarrier b; b.bar = bar; b.x = xb_xcc_id(); b.st = st;
    if (threadIdx.x == 0) (void)xb_add(&bar[XB_XCNT(b.x)], 1u);
    return b;
}
__device__ __forceinline__ void xcd_barrier_complete(unsigned* bar, unsigned x, unsigned& nloc, unsigned& nx) {
    const unsigned G = gridDim.x * gridDim.y * gridDim.z;
    unsigned sum, cnt, mine, sp = 0u;
    for (;;) {
        sum = 0u; cnt = 0u; mine = 0u;
#pragma unroll
        for (unsigned j = 0; j < 16; ++j) { const unsigned c = xb_ld(&bar[XB_XCNT(j)]); sum += c; cnt += (c > 0u) ? 1u : 0u; mine = (j == x) ? c : mine; }
        if (sum == G) break;
        __builtin_amdgcn_s_sleep(1);
        if ((++sp & 255u) == 0u) { if (xb_ld(&bar[XB_TMO])) break; if (sp > XB_SPIN_CAP) { atomicAdd(&bar[XB_TMO], 1u); break; } }
    }
    nloc = mine > 0u ? mine : 1u; nx = cnt > 0u ? cnt : 1u;
}

__device__ __forceinline__ void xcd_barrier(const XcdBarrier& b) {
    asm volatile("s_waitcnt vmcnt(0)" ::: "memory");
    __syncthreads();
    if (threadIdx.x == 0) {
        unsigned* bar = b.bar;
        __builtin_amdgcn_s_waitcnt(0);
        unsigned nloc = b.st[0], nx = b.st[1];
        if (nloc == 0u) { xcd_barrier_complete(bar, b.x, nloc, nx); b.st[0] = nloc; b.st[1] = nx; }
        const unsigned old = xb_add(&bar[XB_XSUB(b.x)], 1u);
        const unsigned gen = old / nloc;
        if (old + 1u == (gen + 1u) * nloc) {
            __builtin_amdgcn_fence(__ATOMIC_RELEASE, "agent");
            asm volatile("s_waitcnt vmcnt(0)" ::: "memory");
            const unsigned og = xb_add(&bar[XB_TOP], 1u);
            const unsigned tg = og / nx;
            if (og + 1u == (tg + 1u) * nx) xb_add(&bar[XB_TOPGEN], 1u);
            else XB_SPIN(xb_ld(&bar[XB_TOPGEN]) == tg, bar);
            __builtin_amdgcn_fence(__ATOMIC_ACQUIRE, "agent");
            xb_add(&bar[XB_XGEN(b.x)], 1u);
            asm volatile("s_waitcnt vmcnt(0)" ::: "memory");
        } else {
            XB_SPIN(xb_ld(&bar[XB_XGEN(b.x)]) == gen, bar);
            __builtin_amdgcn_fence(__ATOMIC_ACQUIRE, "agent");
            asm volatile("s_waitcnt vmcnt(0)" ::: "memory");
        }
    }
    __syncthreads();
}

constexpr int NWAVES = 8;
constexpr int RING_BYTES = 131072, MISC_OFF = RING_BYTES + 320, MOETAB_OFF = RING_BYTES + 1024, LDS_BYTES = 147456;
constexpr int CW_BAR = 4096;
struct Fr {
    LAS unsigned char* lds; int tid, lane, wave, gw, NGW, G, blk;
    const float* in[25]; float* out; unsigned char* ws;
};
enum { I_X = 0, I_C, I_CTX, I_CCTX, I_WMOD, I_BMOD, I_N1G, I_N2G, I_WIN, I_GF, I_GB, I_HGG, I_QNG, I_KVNG, I_WUQ, I_WUKV, I_WPA, I_WPB, I_WO, I_WR, I_RB, I_WG, I_WU, I_WD, I_FG };

__device__ __forceinline__ void mod_items(const Fr& F, int lm, int j, int n) {
    LAS float* sc = (LAS float*)F.lds; LAS float* red = sc + 5120;
    for (int i = F.tid; i < 5120; i += 512) { const int s = i >> 10, k = i & 1023; const float x = (s < 4) ? F.in[I_C][s * 1024 + k] : F.in[I_CCTX][k]; sc[i] = x * sigm(x); }
    __syncthreads();
    float* MOD = (float*)(F.ws + WS_MOD);
    for (int cg = j; cg < 192; cg += n) {
        const int cl = F.tid & 31, ks = F.tid >> 5;
        const float* wp = F.in[I_WMOD] + ((size_t)lm * 1024 + ks * 64) * 6144 + cg * 32 + cl;
        float a0 = 0.f, a1 = 0.f, a2 = 0.f, a3 = 0.f, a4 = 0.f; float w[64];
#pragma unroll
        for (int k = 0; k < 64; ++k) w[k] = wp[(size_t)k * 6144];
#pragma unroll
        for (int k = 0; k < 64; ++k) { const int kk = ks * 64 + k; a0 += sc[kk] * w[k]; a1 += sc[1024 + kk] * w[k]; a2 += sc[2048 + kk] * w[k]; a3 += sc[3072 + kk] * w[k]; a4 += sc[4096 + kk] * w[k]; }
        red[(ks * 5 + 0) * 32 + cl] = a0; red[(ks * 5 + 1) * 32 + cl] = a1; red[(ks * 5 + 2) * 32 + cl] = a2; red[(ks * 5 + 3) * 32 + cl] = a3; red[(ks * 5 + 4) * 32 + cl] = a4;
        __syncthreads();
        if (F.tid < 160) { const int s = F.tid >> 5, c = F.tid & 31; float v = F.in[I_BMOD][lm * 6144 + cg * 32 + c];
#pragma unroll
            for (int q = 0; q < 16; ++q) v += red[(q * 5 + s) * 32 + c];
            MOD[(size_t)(lm * 5 + s) * 6144 + cg * 32 + c] = v; }
        __syncthreads();
    }
}
__device__ __forceinline__ void p0_setup(const Fr& F) {
    mod_items(F, 0, F.blk, F.G);
    const int gi = F.blk * 512 + F.tid;
    if (gi < 1024) { const int dir = gi >> 9, j = gi & 511; const float* gm = F.in[dir ? I_GB : I_GF];
        const float g0 = gm[j], g1 = gm[512 + j], g2 = gm[1024 + j], g3 = gm[1536 + j], mx = fmaxf(fmaxf(g0, g1), fmaxf(g2, g3));
        const float e0 = __expf(g0 - mx), e1 = __expf(g1 - mx), e2 = __expf(g2 - mx), e3 = __expf(g3 - mx), inv = 1.0f / (e0 + e1 + e2 + e3);
        float* LBT = (float*)(F.ws + WS_LBT);
        LBT[(0 * 2 + dir) * 512 + j] = 0.f; LBT[(1 * 2 + dir) * 512 + j] = e1 * inv; LBT[(2 * 2 + dir) * 512 + j] = (e1 + e2) * inv; LBT[(3 * 2 + dir) * 512 + j] = (e1 + e2 + e3) * inv; }
    if (gi >= 1024 && gi < 1536) { const int idx = gi - 1024, pos = idx >> 3, i = idx & 7; const float ang = (float)pos * exp2f(-(float)i * 1.6609640474436813f);
        float* RP = (float*)(F.ws + WS_ROPE); RP[idx * 2] = __cosf(ang); RP[idx * 2 + 1] = __sinf(ang); }
}

__device__ __forceinline__ void tr_item(const float* wsrc  , int ldw, int K, bf16_t* WT  , int k0, LAS float* scr, int lane) {
#pragma unroll 8
    for (int i = 0; i < 32; ++i) { const int kk = 2 * i + (lane >> 5); scr[kk * 33 + (lane & 31)] = wsrc ? wsrc[(size_t)(k0 + kk) * ldw] : 0.f; }
    LDS_WAIT(); asm volatile("" ::: "memory");
    const int c = lane & 7;
#pragma unroll
    for (int j = 0; j < 4; ++j) { const int n = (lane >> 3) + 8 * j; const LAS float* s = scr + (8 * c) * 33 + n;
        u32x4 o; o.x = pk2(s[0 * 33], s[1 * 33]); o.y = pk2(s[2 * 33], s[3 * 33]); o.z = pk2(s[4 * 33], s[5 * 33]); o.w = pk2(s[6 * 33], s[7 * 33]);
        *(u32x4*)(WT + (size_t)n * K + k0 + 8 * c) = o; }
    LDS_WAIT(); asm volatile("" ::: "memory");
}
__device__ __forceinline__ void tr64_item(const float* src  , int ldw, bool valid, bf16_t* dst  , int K, LAS bf16_t* scr, int lane) {
    const int g = lane >> 4, n4 = (lane & 15) * 4; f32x4 v[16];
#pragma unroll
    for (int i = 0; i < 16; ++i) v[i] = valid ? *(const f32x4*)(src + (size_t)(16 * g + i) * ldw + n4) : (f32x4){0.f, 0.f, 0.f, 0.f};
#pragma unroll
    for (int c = 0; c < 4; ++c)
#pragma unroll
        for (int ip = 0; ip < 8; ++ip) *(LAS unsigned*)(scr + (n4 + c) * 72 + 16 * g + 2 * ip) = pk2(v[2 * ip][c], v[2 * ip + 1][c]);
    LDS_WAIT(); asm volatile("" ::: "memory");
#pragma unroll
    for (int j = 0; j < 8; ++j) { const int n = (lane >> 3) + 8 * j; *(u32x4*)(dst + (size_t)n * K + 8 * (lane & 7)) = *(const LAS u32x4*)(scr + n * 72 + 8 * (lane & 7)); }
    LDS_WAIT(); asm volatile("" ::: "memory");
}
constexpr int CV_IN = 16 * 84, CV_UQ = 6 * 24, CV_UKV = 4 * 16, CV_PA = 8 * 16, CV_PB = 8 * 16, CV_O = 16 * 16, CV_GU = 16 * 256, CV_DN = 16 * 128;
constexpr int CV_NITEMS = CV_IN + CV_UQ + CV_UKV + CV_PA + CV_PB + CV_O + CV_GU + CV_DN;
constexpr int CW_QHEAD = 8192, CW_ARR = 8192 + 64 * 8, CW_GCNT = 16384;
struct CvDesc { const float* src; const float* srcz; bf16_t* dst; int ldw, K; bool valid; bool edge; bool none; };
constexpr int CV_T64 = CV_GU + CV_DN + CV_IN + CV_O + CV_PA + CV_PB + CV_UKV;
__device__ __forceinline__ CvDesc cvt_decode(const Fr& F, int l, int it, unsigned char* wb) {
    CvDesc d; d.valid = true; d.edge = false; d.none = false; d.srcz = nullptr; int r = it; const int c4 = 4 * (F.lane & 15);
    if (r < CV_GU) { const int e = r >> 8, q = r & 255, kb = q >> 4, nb = q & 15, n0 = nb * 64, pn = n0 >> 8, w = n0 & 255;
        d.src = (w < 128 ? F.in[I_WG] : F.in[I_WU]) + ((size_t)(l * 16 + e) * 1024 + kb * 64) * 512 + 128 * pn + (w & 127); d.ldw = 512; d.K = 1024;
        d.dst = (bf16_t*)(wb + W_GU) + ((size_t)e * 1024 + n0) * 1024 + kb * 64; return d; } r -= CV_GU;
    if (r < CV_DN) { const int e = r >> 7, q = r & 127, kb = q >> 4, nb = q & 15;
        d.src = F.in[I_WD] + ((size_t)(l * 16 + e) * 512 + kb * 64) * 1024 + nb * 64; d.ldw = 1024; d.K = 512; d.dst = (bf16_t*)(wb + W_DN) + ((size_t)e * 1024 + nb * 64) * 512 + kb * 64; return d; } r -= CV_DN;
    if (r < CV_IN) { const int kb = r / 84, nb = r % 84;
        d.src = F.in[I_WIN] + ((size_t)l * 1024 + kb * 64) * IN_DIM + nb * 64; d.srcz = F.in[I_WIN] + ((size_t)l * 1024 + kb * 64) * IN_DIM; d.ldw = IN_DIM; d.K = 1024; d.valid = nb * 64 + c4 < IN_DIM; d.edge = nb * 64 + 32 == IN_DIM; d.none = nb * 64 >= IN_DIM; d.dst = (bf16_t*)(wb + W_IN) + (size_t)nb * 64 * 1024 + kb * 64; return d; } r -= CV_IN;
    if (r < CV_O) { const int kb = r >> 4, nb = r & 15;
        d.src = F.in[I_WO] + ((size_t)l * 1024 + kb * 64) * 1024 + nb * 64; d.ldw = 1024; d.K = 1024; d.dst = (bf16_t*)(wb + W_O) + (size_t)nb * 64 * 1024 + kb * 64; return d; } r -= CV_O;
    if (r < CV_PA) { const int kb = r >> 4, nb = r & 15;
        d.src = F.in[I_WPA] + ((size_t)l * 512 + kb * 64) * 1024 + nb * 64; d.ldw = 1024; d.K = 512; d.dst = (bf16_t*)(wb + W_PA) + (size_t)nb * 64 * 512 + kb * 64; return d; } r -= CV_PA;
    if (r < CV_PB) { const int kb = r >> 4, nb = r & 15;
        d.src = F.in[I_WPB] + ((size_t)l * 512 + kb * 64) * 1024 + nb * 64; d.ldw = 1024; d.K = 512; d.dst = (bf16_t*)(wb + W_PB) + (size_t)nb * 64 * 512 + kb * 64; return d; } r -= CV_PB;
    { const int kb = r >> 4, nb = r & 15;
        d.src = F.in[I_WUKV] + ((size_t)l * 256 + kb * 64) * 1024 + nb * 64; d.ldw = 1024; d.K = 256; d.dst = (bf16_t*)(wb + W_UKV) + (size_t)nb * 64 * 256 + kb * 64; return d; }
}
__device__ __forceinline__ void cvt_range(const Fr& F, int l, unsigned char* wb, int first, int stride, int end) {
    LAS float* scr = (LAS float*)(F.lds + F.wave * 16384); LAS bf16_t* scb = (LAS bf16_t*)scr;
    const int g = F.lane >> 4, n4 = (F.lane & 15) * 4;
    int it = first; CvDesc d; f32x4 v[16];
    if (it < end) { d = cvt_decode(F, l, it, wb);
#pragma unroll
        for (int i = 0; i < 16; ++i) v[i] = d.valid ? __builtin_nontemporal_load((const f32x4*)(d.src + (size_t)(16 * g + i) * d.ldw + n4)) : (f32x4){0.f, 0.f, 0.f, 0.f}; }
    while (it < end) {
        const int itn = it + stride; CvDesc dn = d; f32x4 vn[16];
        if (itn < end) { dn = cvt_decode(F, l, itn, wb);
#pragma unroll
            for (int i = 0; i < 16; ++i) vn[i] = dn.valid ? __builtin_nontemporal_load((const f32x4*)(dn.src + (size_t)(16 * g + i) * dn.ldw + n4)) : (f32x4){0.f, 0.f, 0.f, 0.f}; }
#pragma unroll
        for (int c = 0; c < 4; ++c)
#pragma unroll
            for (int ip = 0; ip < 8; ++ip) *(LAS unsigned*)(scb + (n4 + c) * 72 + 16 * g + 2 * ip) = pk2(v[2 * ip][c], v[2 * ip + 1][c]);
        LDS_WAIT(); asm volatile("" ::: "memory");
#pragma unroll
        for (int j = 0; j < 8; ++j) { const int n = (F.lane >> 3) + 8 * j; *(u32x4*)(d.dst + (size_t)n * d.K + 8 * (F.lane & 7)) = *(const LAS u32x4*)(scb + n * 72 + 8 * (F.lane & 7)); }
        LDS_WAIT(); asm volatile("" ::: "memory");
        it = itn; d = dn;
#pragma unroll
        for (int i = 0; i < 16; ++i) v[i] = vn[i];
    }
}
__device__ __forceinline__ void cvt_pull(const Fr& F, int l, unsigned char* wb, gu32*  ) {
    cvt_range(F, l, wb, F.gw, F.NGW, CV_T64);
    LAS float* scr = (LAS float*)(F.lds + F.wave * 16384); const int ln = F.lane & 31;
    for (int r = F.gw; r < CV_UQ; r += F.NGW) { const int kb = r / 24, nb = r % 24, n = nb * 32 + ln, h = n / 96, e = n - h * 96; const int sc = e < 64 ? n : h * 96 + 64 + ((e - 64) >> 4) * 16 + ((e - 64) & 1) * 8 + (((e - 64) & 15) >> 1);
        tr_item(F.in[I_WUQ] + (size_t)l * 384 * 768 + sc, 768, 384, (bf16_t*)(wb + W_UQ) + (size_t)nb * 32 * 384, kb * 64, scr, F.lane); }
}
__device__ __forceinline__ void cvt_issue(const CvDesc& d, int hf, f32x4 (&v)[8], int lane) { const int g = lane >> 3, n4 = 32 * hf + (lane & 7) * 4;
#pragma unroll
    for (int i = 0; i < 8; ++i) v[i] = (!d.none && !(d.edge && hf == 1)) ? *(const f32x4*)(d.src + (size_t)(8 * g + i) * d.ldw + n4) : (f32x4){0.f, 0.f, 0.f, 0.f}; }
__device__ __forceinline__ void cvt_finish(const CvDesc& d, int hf, const f32x4 (&v)[8], int lane) { const int g = lane >> 3, n4 = 32 * hf + (lane & 7) * 4;
#pragma unroll
    for (int cc = 0; cc < 4; ++cc) { u32x4 w; w.x = pk2(v[0][cc], v[1][cc]); w.y = pk2(v[2][cc], v[3][cc]); w.z = pk2(v[4][cc], v[5][cc]); w.w = pk2(v[6][cc], v[7][cc]);
        *(u32x4*)(d.dst + (size_t)(n4 + cc) * d.K + 8 * g) = w; } }
__device__ __forceinline__ void cvt_issue_q(const CvDesc& d, int qt, f32x4 (&v)[4], int lane) { const int g = lane >> 2, n4 = 16 * qt + (lane & 3) * 4; const bool ok = !d.none && !(d.edge && qt >= 2); const float* sp = ok ? d.src + n4 : d.srcz + (lane & 3) * 4;
#pragma unroll
    for (int i = 0; i < 4; ++i) v[i] = __builtin_nontemporal_load((const f32x4*)(sp + (size_t)(4 * g + i) * d.ldw)); }
__device__ __forceinline__ void cvt_finish_q(const CvDesc& d, int qt, const f32x4 (&v)[4], int lane) { const int g = lane >> 2, n4 = 16 * qt + (lane & 3) * 4; const unsigned keep = (!d.none && !(d.edge && qt >= 2)) ? 0xffffffffu : 0u;
#pragma unroll
    for (int cc = 0; cc < 4; ++cc) { u32x2 w; w.x = att::cvtpk(v[0][cc], v[1][cc]) & keep; w.y = att::cvtpk(v[2][cc], v[3][cc]) & keep; __builtin_nontemporal_store(w, (u32x2*)(d.dst + (size_t)(n4 + cc) * d.K + 4 * g)); } }
struct CvHook { static constexpr bool ACTIVE = true; const Fr& F; int l; unsigned char* wb; f32x4 v[4]; int q;
    static __device__ __forceinline__ int lane_now() { int t_; asm volatile("v_mbcnt_lo_u32_b32 %0, -1, 0\n\tv_mbcnt_hi_u32_b32 %0, -1, %0" : "=v"(t_)); return t_; }
    __device__ __forceinline__ void issue(int slot) { int qq = slot * F.NGW + F.gw; if (qq >= 4 * CV_T64) qq -= 4 * CV_T64; q = qq; const CvDesc d = cvt_decode(F, l, qq >> 2, wb); cvt_issue_q(d, qq & 3, v, lane_now()); }
    __device__ __forceinline__ void finish() { const CvDesc d = cvt_decode(F, l, q >> 2, wb); cvt_finish_q(d, q & 3, v, lane_now()); }
};
__device__ __forceinline__ void cvt_uq(const Fr& F, int l, unsigned char* wb) {
    LAS float* scr = (LAS float*)(F.lds + F.wave * 16384); const int ln = F.lane & 31;
    for (int r = F.gw; r < CV_UQ; r += F.NGW) { const int kb = r / 24, nb = r % 24, n = nb * 32 + ln, h = n / 96, e = n - h * 96; const int sc = e < 64 ? n : h * 96 + 64 + ((e - 64) >> 4) * 16 + ((e - 64) & 1) * 8 + (((e - 64) & 15) >> 1);
        tr_item(F.in[I_WUQ] + (size_t)l * 384 * 768 + sc, 768, 384, (bf16_t*)(wb + W_UQ) + (size_t)nb * 32 * 384, kb * 64, scr, F.lane); }
}
__device__ __forceinline__ void moe_tab(const Fr& F, int l) {
    LAS int* tab = (LAS int*)(F.lds + MOETAB_OFF); gu32* gc = (gu32*)(F.ws + WS_CTL) + CW_GCNT + 64 * l;
    if (F.tid < 16) tab[F.tid] = (int)__hip_atomic_load(gc + F.tid, RLX_AGENT);
    __syncthreads();
    if (F.tid == 0) { int run = 0;
#pragma unroll 1
        for (int e = 0; e < 16; ++e) { const int nt = (tab[e] + 255) >> 8; tab[16 + e] = run * 256;
#pragma clang loop vectorize(disable) unroll(disable)
            for (int j = 0; j < nt; ++j) tab[64 + run + j] = e;
            run += nt; }
        tab[48] = run; }
    __syncthreads();
}
template <int MODE> __device__ __forceinline__ void row_phase_a(const Fr& F, int l) {
    bf16_t* Z = (bf16_t*)(F.ws + WS_Z); const float* MOD = (const float*)(F.ws + WS_MOD);
    const LAS int* tab = (const LAS int*)(F.lds + MOETAB_OFF); if (MODE != 0) moe_tab(F, l - 1);
    for (int r0 = F.gw; r0 < M; r0 += 2 * F.NGW) {
        int rr[2], bb[2], tt[2], ms[2]; bool ok[2]; f32x4 v[2][4]; u32x2 ya[2][4], yc[2][4]; float w1[2], w2[2]; int s1[2], s2[2];
#pragma unroll
        for (int u = 0; u < 2; ++u) { rr[u] = r0 + u * F.NGW; ok[u] = rr[u] < M; const int rc = ok[u] ? rr[u] : 0; bb[u] = rc / TPB; tt[u] = rc - bb[u] * TPB; ms[u] = tt[u] < CTX ? 4 : bb[u];
            if (MODE == 2 && tt[u] < CTX) ok[u] = false;
            if (MODE != 0 && ok[u]) { const int* rt = (const int*)(F.ws + WS_ROUTE) + 8 * rr[u]; s1[u] = tab[16 + rt[0]] + rt[2]; s2[u] = tab[16 + rt[1]] + rt[3]; w1[u] = __int_as_float(rt[4]); w2[u] = __int_as_float(rt[5]); } }
#pragma unroll
        for (int u = 0; u < 2; ++u) if (ok[u]) {
            if (MODE == 0) { const f32x4* src = (const f32x4*)(tt[u] < CTX ? F.in[I_CTX] + (size_t)(bb[u] * CTX + tt[u]) * 1024 : F.in[I_X] + (size_t)(bb[u] * SEQ + tt[u] - CTX) * 1024) + F.lane;
#pragma unroll
                for (int j = 0; j < 4; ++j) v[u][j] = src[64 * j]; }
            else { const u32x2* zr = (const u32x2*)(Z + (size_t)rr[u] * 1024) + F.lane;
                const u32x2* y1 = (const u32x2*)((const bf16_t*)(F.ws + WS_Y) + (size_t)s1[u] * 1024) + F.lane; const u32x2* y2 = (const u32x2*)((const bf16_t*)(F.ws + WS_Y) + (size_t)s2[u] * 1024) + F.lane;
#pragma unroll
                for (int j = 0; j < 4; ++j) { const u32x2 zz = zr[64 * j]; v[u][j] = (f32x4){bflo(zz.x), bfhi(zz.x), bflo(zz.y), bfhi(zz.y)}; ya[u][j] = y1[64 * j]; yc[u][j] = y2[64 * j]; } } }
#pragma unroll
        for (int u = 0; u < 2; ++u) if (ok[u]) {
            if (MODE != 0) { const f32x4* g5 = (const f32x4*)(MOD + (size_t)((l - 1) * 5 + ms[u]) * 6144 + 5 * 1024) + F.lane;
#pragma unroll
                for (int j = 0; j < 4; ++j) { const u32x2 a = ya[u][j], c = yc[u][j]; const float p = w1[u], q = w2[u];
                    const f32x4 f = (f32x4){p * bflo(a.x) + q * bflo(c.x), p * bfhi(a.x) + q * bfhi(c.x), p * bflo(a.y) + q * bflo(c.y), p * bfhi(a.y) + q * bfhi(c.y)};
                    v[u][j] = v[u][j] + g5[64 * j] * f; } }
            if (MODE != 2) { u32x2* zw = (u32x2*)(Z + (size_t)rr[u] * 1024) + F.lane;
#pragma unroll
                for (int j = 0; j < 4; ++j) { u32x2 w; w.x = pk2(v[u][j].x, v[u][j].y); w.y = pk2(v[u][j].z, v[u][j].w); zw[64 * j] = w; } }
            float ss = 0.f;
#pragma unroll
            for (int j = 0; j < 4; ++j) ss += (v[u][j].x * v[u][j].x + v[u][j].y * v[u][j].y) + (v[u][j].z * v[u][j].z + v[u][j].w * v[u][j].w);
            const float rstd = 1.0f / sqrtf(wave_sum(ss, F.lane) * (1.0f / 1024.0f) + EPS);
            if (MODE == 2) { const f32x4* fg = (const f32x4*)F.in[I_FG] + F.lane; f32x4* o = (f32x4*)(F.out + (size_t)(bb[u] * SEQ + tt[u] - CTX) * 1024) + F.lane;
#pragma unroll
                for (int j = 0; j < 4; ++j) o[64 * j] = v[u][j] * rstd * fg[64 * j]; }
            else { const f32x4* g1 = (const f32x4*)(F.in[I_N1G] + l * 1024) + F.lane; const f32x4* sh = (const f32x4*)(MOD + (size_t)(l * 5 + ms[u]) * 6144) + F.lane; const f32x4* scl = sh + 256;
                u32x2* h = (u32x2*)((bf16_t*)(F.ws + WS_H) + (size_t)rr[u] * 1024) + F.lane;
#pragma unroll
                for (int j = 0; j < 4; ++j) { const f32x4 y = v[u][j] * rstd * g1[64 * j] * (1.0f + scl[64 * j]) + sh[64 * j]; u32x2 w; w.x = pk2(y.x, y.y); w.y = pk2(y.z, y.w); h[64 * j] = w; } } }
    }
}

__device__ __forceinline__ void scan_naive(const Fr& F, int l, int item) {
    const int dir = item & 1, h = (item >> 1) & 3, b = item >> 3;
    const bf16_t* P = (const bf16_t*)(F.ws + WS_P); bf16_t* O = (bf16_t*)(F.ws + (dir ? WS_OB : WS_OF));
    LAS float* qs = (LAS float*)F.lds; LAS float* fs = qs + 2048; LAS float* vs = fs + 2048; LAS float* os = vs + 2048;
    const int v = F.tid & 127, kq = F.tid >> 7;
    const float lb = ((const float*)(F.ws + WS_LBT))[(l * 2 + dir) * 512 + h * 128 + v];
    const int cf = dir ? C_FB : C_FF;
    float S[32];
#pragma unroll
    for (int i = 0; i < 32; ++i) S[i] = 0.f;
    for (int s0 = 0; s0 < TPB; s0 += 16) {
#pragma unroll
        for (int j = 0; j < 4; ++j) { const int tt = kq + 4 * j, s = s0 + tt; const int t = dir ? (s < CTX ? CTX - 1 - s : CTX + TPB - 1 - s) : s;
            const bf16_t* pr = P + (size_t)(b * TPB + t) * INP + h * 128 + v;
            qs[tt * 128 + v] = bf1(pr[C_Q]); vs[tt * 128 + v] = bf1(pr[C_I]); fs[tt * 128 + v] = lb + (1.0f - lb) * sigm(bf1(pr[cf])); }
        __syncthreads();
#pragma unroll 1
        for (int tt = 0; tt < 16; ++tt) { const float iv = vs[tt * 128 + v]; float o = 0.f;
#pragma unroll
            for (int k4 = 0; k4 < 8; ++k4) { const f32x4 f = *(const LAS f32x4*)(fs + tt * 128 + kq * 32 + 4 * k4), q = *(const LAS f32x4*)(qs + tt * 128 + kq * 32 + 4 * k4);
                S[4 * k4 + 0] = f.x * S[4 * k4 + 0] + (1.0f - f.x) * iv; o += q.x * S[4 * k4 + 0];
                S[4 * k4 + 1] = f.y * S[4 * k4 + 1] + (1.0f - f.y) * iv; o += q.y * S[4 * k4 + 1];
                S[4 * k4 + 2] = f.z * S[4 * k4 + 2] + (1.0f - f.z) * iv; o += q.z * S[4 * k4 + 2];
                S[4 * k4 + 3] = f.w * S[4 * k4 + 3] + (1.0f - f.w) * iv; o += q.w * S[4 * k4 + 3]; }
            os[(tt * 4 + kq) * 128 + v] = o; }
        __syncthreads();
#pragma unroll
        for (int j = 0; j < 4; ++j) { const int tt = kq + 4 * j, s = s0 + tt; const int t = dir ? (s < CTX ? CTX - 1 - s : CTX + TPB - 1 - s) : s;
            const float o = (os[(tt * 4 + 0) * 128 + v] + os[(tt * 4 + 1) * 128 + v]) + (os[(tt * 4 + 2) * 128 + v] + os[(tt * 4 + 3) * 128 + v]);
            O[(size_t)(b * TPB + t) * 512 + h * 128 + v] = (bf16_t)f2bf(o); }
        __syncthreads();
    }
}
namespace hg {
typedef short bf16x8 __attribute__((ext_vector_type(8)));
typedef short s16x4 __attribute__((ext_vector_type(4)));
constexpr int NSC = 16, NITEM = 32 * NSC, QP = 136  , TP = 40  ;
constexpr int L_QS = 0, L_KS = 8704, L_KT = 17408, L_VT = 27648, L_DL = 37888, L_PQ = 38400;
__device__ __forceinline__ int tok_row(int b, int dir, int s) { const int t = dir ? (s < CTX ? CTX - 1 - s : CTX + TPB - 1 - s) : s; return b * TPB + t; }
__device__ __forceinline__ bf16x8 cat8(s16x4 lo, s16x4 hi) { return (bf16x8){lo[0], lo[1], lo[2], lo[3], hi[0], hi[1], hi[2], hi[3]}; }
typedef float f32x2_t __attribute__((ext_vector_type(2))); typedef __bf16 bf16x2_t __attribute__((ext_vector_type(2)));
__device__ __forceinline__ unsigned cvtpk(float lo, float hi) { f32x2_t v = {lo, hi}; bf16x2_t b = __builtin_convertvector(v, bf16x2_t); return __builtin_bit_cast(unsigned, b); }
__device__ __forceinline__ bf16x8 pack88(f32x4 a, f32x4 b) { u32x4 w; w.x = cvtpk(a[0], a[1]); w.y = cvtpk(a[2], a[3]); w.z = cvtpk(b[0], b[1]); w.w = cvtpk(b[2], b[3]); return __builtin_bit_cast(bf16x8, w); }
#define HG_MFMA(a, b, c) __builtin_amdgcn_mfma_f32_16x16x32_bf16(a, b, c, 0, 0, 0)
__device__ __forceinline__ float fsig(float x) { return __builtin_amdgcn_rcpf(1.0f + __builtin_amdgcn_exp2f(-1.4426950408889634f * x)); }
__device__ __forceinline__ int sc_nch(int sc) { return sc == 0 ? 8 : ((sc <= 4 || sc >= 12) ? 9 : 8); }
__device__ __forceinline__ int sc_base(int sc) { return sc == 0 ? 0 : (sc <= 4 ? CTX + 288 * (sc - 1) : (sc <= 11 ? CTX + 1152 + 256 * (sc - 5) : CTX + 2944 + 288 * (sc - 12))); }
constexpr int L_SSB = 42496, L_OL = 43520, OLP = 132;
template <int MODE> __device__ __forceinline__ void scan_dir(const Fr& F, int l, int b, int h, int dir, int sc, int cvl, int cvit, int cvst, unsigned char* cvwb) {
    constexpr bool P3 = MODE != 0;
    const int item = ((b * 4 + h) * 2 + dir) * NSC + sc, NCH = sc_nch(sc), sbase = sc_base(sc);
    const bf16_t* P = (const bf16_t*)(F.ws + WS_P);
    float* St = (float*)(F.ws + WS_ST) + (size_t)item * 16384; float* Dg = (float*)(F.ws + WS_SD) + item * 128;
    LAS bf16_t* qs = (LAS bf16_t*)(F.lds + L_QS); LAS bf16_t* ks = (LAS bf16_t*)(F.lds + L_KS); LAS bf16_t* kT = (LAS bf16_t*)(F.lds + L_KT); LAS bf16_t* vT = (LAS bf16_t*)(F.lds + L_VT);
    LAS float* dl = (LAS float*)(F.lds + L_DL); LAS float* pq = (LAS float*)(F.lds + L_PQ);
    LAS float* ssb = (LAS float*)(F.lds + L_SSB); LAS bf16_t* OL = (LAS bf16_t*)(F.lds + L_OL);
    const int kp = F.tid & 63, tg = F.tid >> 6, k0 = 2 * kp, g = F.lane >> 4, c16 = F.lane & 15, vs = 16 * F.wave;
    const f32x2 lb = *(const f32x2*)((const float*)(F.ws + WS_LBT) + (l * 2 + dir) * 512 + h * 128 + k0);
    const int cfo = dir ? C_FB : C_FF;
    const int kperm = (k0 & ~31) | (((k0 & 15) >> 2) << 3) | (((k0 >> 4) & 1) << 2) | (k0 & 3);
    const int tslot = (tg & 3) * 8 + (tg >> 2) * 4;
    const long rstep = dir ? -(long)INP : (long)INP;
    f32x4 S[8];
#pragma unroll
    for (int kt = 0; kt < 8; ++kt) {
        if (P3) {
#pragma unroll
            for (int i = 0; i < 4; ++i) S[kt][i] = St[(16 * kt + 4 * g + i) * 128 + vs + c16]; }
        else S[kt] = (f32x4){0.f, 0.f, 0.f, 0.f}; }
    float D0 = 1.0f, D1 = 1.0f;
    unsigned rf[4], rq[4], rv[4], nf[4], nq[4], nv[4];
    const bf16_t* pld = P + (size_t)tok_row(b, dir, sbase + 4 * tg) * INP + h * 128 + k0;
#define HG_LOAD(F_, Q_, V_) do { const bf16_t* pr = pld; _Pragma("unroll") for (int j = 0; j < 4; ++j) { \
        F_[j] = *(const unsigned*)(pr + cfo); V_[j] = *(const unsigned*)(pr + C_I); if (P3) Q_[j] = *(const unsigned*)(pr + C_Q); pr += rstep; } pld += 32 * rstep; } while (0)
    HG_LOAD(rf, rq, rv); HG_LOAD(nf, nq, nv);
    const size_t row0 = (size_t)tok_row(b, dir, sbase + c16); const long tstep = dir ? -1L : 1L;
    const bf16_t* gp = P + row0 * INP + C_G + h * 128 + vs + 4 * g; bf16_t* ap = (bf16_t*)(F.ws + WS_A) + row0 * 512 + h * 128 + vs + 4 * g;
    int tau = MODE == 2 ? 32 * NCH - 1 - c16 : c16;
    const bool cvon = MODE == 0 && cvl >= 0; CvDesc cvd; f32x4 cvv[8]; bool cvload = false; int cvh = 0;
    f32x4 gn4 = {0.f, 0.f, 0.f, 0.f}; if (MODE == 2) gn4 = *(const f32x4*)(F.in[I_HGG] + l * 512 + h * 128 + vs + 4 * g);
#pragma unroll 1
    for (int ch = 0; ch < NCH; ++ch) {
        if (cvon && (ch & 1) == 0) { if (cvload) { cvt_finish(cvd, cvh, cvv, F.lane); cvload = false; }
            const int hi = cvit + (ch >> 1) * cvst; if (ch < 8 && hi < 2 * CV_T64) { cvd = cvt_decode(F, cvl, hi >> 1, cvwb); cvh = hi & 1; cvt_issue(cvd, cvh, cvv, F.lane); cvload = true; } }
        float c0 = 1.0f, c1 = 1.0f, cp0[4], cp1[4], kf0[4], kf1[4];
#pragma unroll
        for (int j = 0; j < 4; ++j) { const float f0 = lb.x + (1.0f - lb.x) * fsig(bflo(rf[j])), f1 = lb.y + (1.0f - lb.y) * fsig(bfhi(rf[j])); c0 *= f0; c1 *= f1; cp0[j] = c0; cp1[j] = c1; kf0[j] = 1.0f - f0; kf1[j] = 1.0f - f1; }
        *(LAS f32x2*)(pq + tg * 128 + k0) = (f32x2){c0, c1};
        __syncthreads();
        float pre0 = 1.0f, pre1 = 1.0f, tot0 = 1.0f, tot1 = 1.0f;
#pragma unroll
        for (int t = 0; t < 8; ++t) { const f32x2 p = *(const LAS f32x2*)(pq + t * 128 + k0); if (t < tg) { pre0 *= p.x; pre1 *= p.y; } tot0 *= p.x; tot1 *= p.y; }
        if (tg == 0) *(LAS f32x2*)(dl + k0) = (f32x2){tot0, tot1};
        D0 *= tot0; D1 *= tot1;
        float ka0[4], ka1[4];
#pragma unroll
        for (int j = 0; j < 4; ++j) { cp0[j] *= pre0; cp1[j] *= pre1; ka0[j] = kf0[j] * __builtin_amdgcn_rcpf(cp0[j]); ka1[j] = kf1[j] * __builtin_amdgcn_rcpf(cp1[j]); }
        if (P3) {
#pragma unroll
            for (int j = 0; j < 4; ++j) { *(LAS unsigned*)(qs + (4 * tg + j) * QP + kperm) = cvtpk(bflo(rq[j]) * cp0[j], bfhi(rq[j]) * cp1[j]); *(LAS unsigned*)(ks + (4 * tg + j) * QP + kperm) = cvtpk(ka0[j], ka1[j]); } }
        { u32x2 w; w.x = cvtpk(ka0[0], ka0[1]); w.y = cvtpk(ka0[2], ka0[3]); *(LAS u32x2*)(kT + k0 * TP + tslot) = w; w.x = cvtpk(ka1[0], ka1[1]); w.y = cvtpk(ka1[2], ka1[3]); *(LAS u32x2*)(kT + (k0 + 1) * TP + tslot) = w;
          w.x = (rv[0] & 0xffffu) | (rv[1] << 16); w.y = (rv[2] & 0xffffu) | (rv[3] << 16); *(LAS u32x2*)(vT + k0 * TP + tslot) = w;
          w.x = (rv[0] >> 16) | (rv[1] & 0xffff0000u); w.y = (rv[2] >> 16) | (rv[3] & 0xffff0000u); *(LAS u32x2*)(vT + (k0 + 1) * TP + tslot) = w; }
#pragma unroll
        for (int j = 0; j < 4; ++j) { rf[j] = nf[j]; rv[j] = nv[j]; if (P3) rq[j] = nq[j]; }
        if (ch + 2 < NCH) HG_LOAD(nf, nq, nv);
        __syncthreads();
        const bf16x8 vf = *(const LAS bf16x8*)(vT + (vs + c16) * TP + 8 * g);
        f32x4 o0 = {0.f, 0.f, 0.f, 0.f}, o1 = o0;
        if (P3) {
            bf16x8 qf[2][4], ka[2][4];
#pragma unroll
            for (int t2 = 0; t2 < 2; ++t2)
#pragma unroll
                for (int kb = 0; kb < 4; ++kb) { qf[t2][kb] = *(const LAS bf16x8*)(qs + (16 * t2 + c16) * QP + 32 * kb + 8 * g); ka[t2][kb] = *(const LAS bf16x8*)(ks + (16 * t2 + c16) * QP + 32 * kb + 8 * g); }
            f32x4 a00 = {0.f, 0.f, 0.f, 0.f}, a01 = a00, a11 = a00;
#pragma unroll
            for (int kb = 0; kb < 4; ++kb) { a00 = HG_MFMA(ka[0][kb], qf[0][kb], a00); a01 = HG_MFMA(ka[0][kb], qf[1][kb], a01); a11 = HG_MFMA(ka[1][kb], qf[1][kb], a11); }
#pragma unroll
            for (int i = 0; i < 4; ++i) { if (c16 < 4 * g + i) { a00[i] = 0.f; a11[i] = 0.f; } }
            const bf16x8 B0 = pack88(a00, (f32x4){0.f, 0.f, 0.f, 0.f}), B1 = pack88(a01, a11);
#pragma unroll
            for (int kb = 0; kb < 4; ++kb) { const bf16x8 Sf = pack88(S[2 * kb], S[2 * kb + 1]); o0 = HG_MFMA(Sf, qf[0][kb], o0); o1 = HG_MFMA(Sf, qf[1][kb], o1); }
            o0 = HG_MFMA(vf, B0, o0); o1 = HG_MFMA(vf, B1, o1);
            if (MODE == 1) { u32x2 w0, w1; w0.x = cvtpk(o0[0], o0[1]); w0.y = cvtpk(o0[2], o0[3]); w1.x = cvtpk(o1[0], o1[1]); w1.y = cvtpk(o1[2], o1[3]);
                *(LAS u32x2*)(OL + tau * OLP + vs + 4 * g) = w0; *(LAS u32x2*)(OL + (tau + 16) * OLP + vs + 4 * g) = w1; tau += 32; }
        }
#pragma unroll
        for (int kt = 0; kt < 8; ++kt) { const bf16x8 kTf = *(const LAS bf16x8*)(kT + (16 * kt + c16) * TP + 8 * g);
            S[kt] = HG_MFMA(kTf, vf, S[kt]); S[kt] = S[kt] * *(const LAS f32x4*)(dl + 16 * kt + 4 * g); }
        if (MODE == 2) {
            const u32x2 f0 = *(const LAS u32x2*)(OL + tau * OLP + vs + 4 * g), f1 = *(const LAS u32x2*)(OL + (tau - 16) * OLP + vs + 4 * g);
            o0 += (f32x4){bflo(f0.x), bfhi(f0.x), bflo(f0.y), bfhi(f0.y)}; o1 += (f32x4){bflo(f1.x), bfhi(f1.x), bflo(f1.y), bfhi(f1.y)};
            float s0 = (o0[0] * o0[0] + o0[1] * o0[1]) + (o0[2] * o0[2] + o0[3] * o0[3]), s1 = (o1[0] * o1[0] + o1[1] * o1[1]) + (o1[2] * o1[2] + o1[3] * o1[3]);
            s0 += lane_xor(s0, F.lane, 16); s0 += lane_xor(s0, F.lane, 32); s1 += lane_xor(s1, F.lane, 16); s1 += lane_xor(s1, F.lane, 32);
            if (g == 0) { ssb[F.wave * 32 + c16] = s0; ssb[F.wave * 32 + 16 + c16] = s1; }
            const u32x2 g0 = *(const u32x2*)gp, g1 = *(const u32x2*)(gp + 16 * tstep * INP);
            __syncthreads();
            float t0 = 0.f, t1 = 0.f;
#pragma unroll
            for (int w = 0; w < 8; ++w) { t0 += ssb[w * 32 + c16]; t1 += ssb[w * 32 + 16 + c16]; }
            const float r0 = 1.0f / sqrtf(t0 * (1.0f / 128.0f) + EPS), r1 = 1.0f / sqrtf(t1 * (1.0f / 128.0f) + EPS);
            const f32x4 gg0 = {bflo(g0.x), bfhi(g0.x), bflo(g0.y), bfhi(g0.y)}, gg1 = {bflo(g1.x), bfhi(g1.x), bflo(g1.y), bfhi(g1.y)};
            f32x4 y0, y1;
#pragma unroll
            for (int i = 0; i < 4; ++i) { y0[i] = o0[i] * r0 * gn4[i] * (gg0[i] * fsig(gg0[i])); y1[i] = o1[i] * r1 * gn4[i] * (gg1[i] * fsig(gg1[i])); }
            u32x2 w0, w1; w0.x = cvtpk(y0[0], y0[1]); w0.y = cvtpk(y0[2], y0[3]); w1.x = cvtpk(y1[0], y1[1]); w1.y = cvtpk(y1[2], y1[3]);
            *(u32x2*)ap = w0; *(u32x2*)(ap + 16 * tstep * 512) = w1;
            gp += 32 * tstep * INP; ap += 32 * tstep * 512; tau -= 32;
        }
    }
    if (cvon && cvload) cvt_finish(cvd, cvh, cvv, F.lane);
    __syncthreads();
#undef HG_LOAD
    if (MODE == 0) {
#pragma unroll
        for (int kt = 0; kt < 8; ++kt)
#pragma unroll
            for (int i = 0; i < 4; ++i) St[(16 * kt + 4 * g + i) * 128 + vs + c16] = S[kt][i];
        if (tg == 0) *(f32x2*)(Dg + k0) = (f32x2){D0, D1}; }
}
#undef HG_MFMA
__device__ __forceinline__ void scan_pass2(const Fr& F) {
    float* St = (float*)(F.ws + WS_ST); const float* Dg = (const float*)(F.ws + WS_SD);
    for (int idx = F.blk * 512 + F.tid; idx < 32 * 4096; idx += F.G * 512) { const int seq = idx >> 12, e4 = idx & 4095, kk = e4 >> 5;
        float z = 0.f; asm volatile("" : "+v"(z));
        f32x4 S = {z, z, z, z};
#pragma unroll
        for (int sc = 0; sc < NSC; ++sc) { f32x4* up = (f32x4*)(St + (size_t)(seq * NSC + sc) * 16384) + e4; const f32x4 u = *up; const float d = Dg[(seq * NSC + sc) * 128 + kk]; *up = S; S = S * d + u; } }
}
}
__device__ __forceinline__ void mla_prep(const Fr& F, int l, int gw, int ngw) {
    const bf16_t* P = (const bf16_t*)(F.ws + WS_P); const float* RP = (const float*)(F.ws + WS_ROPE);
    bf16_t* DQN = (bf16_t*)(F.ws + WS_DQN); bf16_t* DKVN = (bf16_t*)(F.ws + WS_DKVN); bf16_t* Kb = (bf16_t*)(F.ws + WS_K);
    const float* qg = F.in[I_QNG] + l * 384; const float* kg = F.in[I_KVNG] + l * 256;
    const f32x2 g0 = ((const f32x2*)qg)[F.lane], g1 = ((const f32x2*)qg)[F.lane + 64], g2 = ((const f32x2*)qg)[F.lane + 128]; const f32x4 gk = ((const f32x4*)kg)[F.lane];
    const int ax = (F.lane >> 3) & 1, i = F.lane & 7;
    for (int r0 = gw; r0 < M; r0 += 4 * ngw) {
        unsigned q0[4], q1[4], q2[4]; u32x2 kv[4]; bf16_t p1[4], p2[4];
#pragma unroll
        for (int u = 0; u < 4; ++u) { const int r = r0 + u * ngw; if (r < M) { const bf16_t* pr = P + (size_t)r * INP; const unsigned* src = (const unsigned*)(pr + C_DQ) + F.lane;
            q0[u] = src[0]; q1[u] = src[64]; q2[u] = src[128]; kv[u] = ((const u32x2*)(pr + C_DKV))[F.lane]; p1[u] = pr[C_KPE + ax * 16 + i]; p2[u] = pr[C_KPE + ax * 16 + 8 + i]; } }
#pragma unroll
        for (int u = 0; u < 4; ++u) { const int r = r0 + u * ngw; if (r < M) { const int b = r / TPB, t = r - b * TPB;
            { const float x0 = bflo(q0[u]), x1 = bfhi(q0[u]), x2 = bflo(q1[u]), x3 = bfhi(q1[u]), x4 = bflo(q2[u]), x5 = bfhi(q2[u]);
              const float rstd = 1.0f / sqrtf(wave_sum((x0 * x0 + x1 * x1) + (x2 * x2 + x3 * x3) + (x4 * x4 + x5 * x5), F.lane) * (1.0f / 384.0f) + EPS);
              unsigned* dst = (unsigned*)(DQN + (size_t)r * 384) + F.lane;
              dst[0] = pk2(x0 * rstd * g0.x, x1 * rstd * g0.y); dst[64] = pk2(x2 * rstd * g1.x, x3 * rstd * g1.y); dst[128] = pk2(x4 * rstd * g2.x, x5 * rstd * g2.y); }
            { const float x0 = bflo(kv[u].x), x1 = bfhi(kv[u].x), x2 = bflo(kv[u].y), x3 = bfhi(kv[u].y);
              const float rstd = 1.0f / sqrtf(wave_sum((x0 * x0 + x1 * x1) + (x2 * x2 + x3 * x3), F.lane) * (1.0f / 256.0f) + EPS);
              u32x2 w; w.x = pk2(x0 * rstd * gk.x, x1 * rstd * gk.y); w.y = pk2(x2 * rstd * gk.z, x3 * rstd * gk.w);
              ((u32x2*)(DKVN + (size_t)r * 256))[F.lane] = w; }
            if (F.lane < 16) { float x1 = bf1(p1[u]), x2 = bf1(p2[u]);
                if (t >= CTX) { const int p = t - CTX, pos = ax ? (p & 63) : (p >> 6); const float c = RP[(pos * 8 + i) * 2], sn = RP[(pos * 8 + i) * 2 + 1]; const float y1 = x1 * c - x2 * sn, y2 = x1 * sn + x2 * c; x1 = y1; x2 = y2; }
                const unsigned w = pk2(x1, x2);
#pragma unroll
                for (int hh = 0; hh < 8; ++hh) *(unsigned*)(Kb + ((size_t)(b * 8 + hh) * TPB + t) * 96 + 64 + ax * 16 + 2 * i) = w; } } }
    }
}
__device__ __forceinline__ void hg_readout(const Fr& F, int l) {
    const bf16_t* P = (const bf16_t*)(F.ws + WS_P); const bf16_t* OF = (const bf16_t*)(F.ws + WS_OF); const bf16_t* OB = (const bf16_t*)(F.ws + WS_OB); bf16_t* A = (bf16_t*)(F.ws + WS_A);
    const float* gain = F.in[I_HGG] + l * 512;
    const f32x4 ga = ((const f32x4*)gain)[2 * F.lane], gb = ((const f32x4*)gain)[2 * F.lane + 1]; const float gn[8] = {ga.x, ga.y, ga.z, ga.w, gb.x, gb.y, gb.z, gb.w};
    for (int r0 = F.gw; r0 < M; r0 += 4 * F.NGW) {
        u32x4 a4[4], c4[4], g4[4];
#pragma unroll
        for (int u = 0; u < 4; ++u) { const int r = r0 + u * F.NGW; if (r < M) { a4[u] = ((const u32x4*)(OF + (size_t)r * 512))[F.lane]; c4[u] = ((const u32x4*)(OB + (size_t)r * 512))[F.lane]; g4[u] = ((const u32x4*)(P + (size_t)r * INP + C_G))[F.lane]; } }
#pragma unroll
        for (int u = 0; u < 4; ++u) { const int r = r0 + u * F.NGW; if (r < M) { const u32x4 a = a4[u], c = c4[u], g = g4[u];
            float o[8] = {bflo(a.x) + bflo(c.x), bfhi(a.x) + bfhi(c.x), bflo(a.y) + bflo(c.y), bfhi(a.y) + bfhi(c.y), bflo(a.z) + bflo(c.z), bfhi(a.z) + bfhi(c.z), bflo(a.w) + bflo(c.w), bfhi(a.w) + bfhi(c.w)};
            const float gg[8] = {bflo(g.x), bfhi(g.x), bflo(g.y), bfhi(g.y), bflo(g.z), bfhi(g.z), bflo(g.w), bfhi(g.w)};
            float ss = 0.f;
#pragma unroll
            for (int i = 0; i < 8; ++i) ss += o[i] * o[i];
            ss += lane_xor(ss, F.lane, 1); ss += lane_xor(ss, F.lane, 2); ss += lane_xor(ss, F.lane, 4); ss += lane_xor(ss, F.lane, 8);
            const float rstd = 1.0f / sqrtf(ss * (1.0f / 128.0f) + EPS);
#pragma unroll
            for (int i = 0; i < 8; ++i) o[i] = o[i] * rstd * gn[i] * (gg[i] * sigm(gg[i]));
            u32x4 w; w.x = pk2(o[0], o[1]); w.y = pk2(o[2], o[3]); w.z = pk2(o[4], o[5]); w.w = pk2(o[6], o[7]);
            ((u32x4*)(A + (size_t)r * 512))[F.lane] = w; } }
    }
}
__device__ __forceinline__ void top2of4(float a, float b, float c, float d, int& i1, int& i2) {
    float bv = a; i1 = 0; if (b > bv) { bv = b; i1 = 1; } if (c > bv) { bv = c; i1 = 2; } if (d > bv) { bv = d; i1 = 3; }
    const float NI = -3.0e38f; const float a2 = i1 == 0 ? NI : a, b2 = i1 == 1 ? NI : b, c2 = i1 == 2 ? NI : c, d2 = i1 == 3 ? NI : d;
    bv = a2; i2 = 0; if (b2 > bv) { bv = b2; i2 = 1; } if (c2 > bv) { bv = c2; i2 = 2; } if (d2 > bv) { bv = d2; i2 = 3; }
}
__device__ __forceinline__ float sel4(int i, float a, float b, float c, float d) { return i == 0 ? a : (i == 1 ? b : (i == 2 ? c : d)); }
__device__ __forceinline__ void norm2_route(const Fr& F, int l, int skip_ctx) {
    LAS float* wrT = (LAS float*)F.lds; LAS int* hist = (LAS int*)(F.lds + 65536); LAS int* gbase = hist + 16;
    { f32x4 wv[8];
#pragma unroll
      for (int j = 0; j < 8; ++j) wv[j] = ((const f32x4*)F.in[I_WR])[512 * j + F.tid];
#pragma unroll
      for (int j = 0; j < 8; ++j) { const int i4 = 512 * j + F.tid, k = i4 >> 2, e0 = (i4 & 3) * 4;
          wrT[(e0 + 0) * 1024 + k] = wv[j].x; wrT[(e0 + 1) * 1024 + k] = wv[j].y; wrT[(e0 + 2) * 1024 + k] = wv[j].z; wrT[(e0 + 3) * 1024 + k] = wv[j].w; } }
    if (F.tid < 16) hist[F.tid] = 0;
    __syncthreads();
    const bf16_t* Z = (const bf16_t*)(F.ws + WS_Z); const float* MOD = (const float*)(F.ws + WS_MOD);
    LAS float* lg = (LAS float*)(hist + 64);
    f32x4 g2v[4];
#pragma unroll
    for (int j = 0; j < 4; ++j) g2v[j] = ((const f32x4*)(F.in[I_N2G] + l * 1024))[F.lane + 64 * j];
    int ri = 0; u32x2 vn[4];
    { const u32x2* zr = (const u32x2*)(Z + (size_t)F.gw * 1024) + F.lane;
#pragma unroll
      for (int j = 0; j < 4; ++j) vn[j] = zr[64 * j]; }
    for (int r = F.gw; r < M; r += F.NGW, ++ri) {
        const int b = r / TPB, t = r - b * TPB, ms = t < CTX ? 4 : b;
        f32x4 v[4]; float ss = 0.f;
#pragma unroll
        for (int j = 0; j < 4; ++j) v[j] = (f32x4){bflo(vn[j].x), bfhi(vn[j].x), bflo(vn[j].y), bfhi(vn[j].y)};
        if (r + F.NGW < M) { const u32x2* zr = (const u32x2*)(Z + (size_t)(r + F.NGW) * 1024) + F.lane;
#pragma unroll
            for (int j = 0; j < 4; ++j) vn[j] = zr[64 * j]; }
        if (skip_ctx && t < CTX) continue;
        const f32x4* sh = (const f32x4*)(MOD + (size_t)(l * 5 + ms) * 6144 + 3 * 1024) + F.lane; const f32x4* scl = sh + 256;
        f32x4 shv[4], scv[4];
#pragma unroll
        for (int j = 0; j < 4; ++j) { shv[j] = sh[64 * j]; scv[j] = scl[64 * j]; }
#pragma unroll
        for (int j = 0; j < 4; ++j) ss += (v[j].x * v[j].x + v[j].y * v[j].y) + (v[j].z * v[j].z + v[j].w * v[j].w);
        const float rstd = 1.0f / sqrtf(wave_sum(ss, F.lane) * (1.0f / 1024.0f) + EPS);
        u32x2* h = (u32x2*)((bf16_t*)(F.ws + WS_H) + (size_t)r * 1024) + F.lane;
#pragma unroll
        for (int j = 0; j < 4; ++j) { v[j] = v[j] * rstd * g2v[j] * (1.0f + scv[j]) + shv[j]; u32x2 w; w.x = pk2(v[j].x, v[j].y); w.y = pk2(v[j].z, v[j].w); h[64 * j] = w; }
        float p[16];
#pragma unroll
        for (int e = 0; e < 16; ++e) { float a = 0.f;
#pragma unroll
            for (int j = 0; j < 4; ++j) { const f32x4 w = *(const LAS f32x4*)(wrT + e * 1024 + 4 * F.lane + 256 * j); a += (v[j].x * w.x + v[j].y * w.y) + (v[j].z * w.z + v[j].w * w.w); }
            p[e] = a; }
        const bool h5 = (F.lane >> 5) & 1, h4 = (F.lane >> 4) & 1, h3 = (F.lane >> 3) & 1, h2 = (F.lane >> 2) & 1; float q[8], r4[4], s2[2];
#pragma unroll
        for (int j = 0; j < 8; ++j) q[j] = (h5 ? p[8 + j] : p[j]) + lane_xor(h5 ? p[j] : p[8 + j], F.lane, 32);
#pragma unroll
        for (int j = 0; j < 4; ++j) r4[j] = (h4 ? q[4 + j] : q[j]) + lane_xor(h4 ? q[j] : q[4 + j], F.lane, 16);
#pragma unroll
        for (int j = 0; j < 2; ++j) s2[j] = (h3 ? r4[2 + j] : r4[j]) + lane_xor(h3 ? r4[j] : r4[2 + j], F.lane, 8);
        float tt = (h2 ? s2[1] : s2[0]) + lane_xor(h2 ? s2[0] : s2[1], F.lane, 4);
        tt += lane_xor(tt, F.lane, 1); tt += lane_xor(tt, F.lane, 2);
        if ((F.lane & 3) == 0) lg[(F.wave * 9 + ri) * 16 + (((F.lane >> 5) & 1) << 3 | ((F.lane >> 4) & 1) << 2 | ((F.lane >> 3) & 1) << 1 | ((F.lane >> 2) & 1))] = tt;
    }
    const int rl = F.gw + F.lane * F.NGW; const bool valid = F.lane < 9 && rl < M && !(skip_ctx && (rl % TPB) < CTX);
    int e1 = 0, e2 = 0, k1 = 0, k2 = 0; float w1 = 0.f, w2 = 0.f;
    LDS_WAIT();
    if (valid) { float sc[16], rb[16];
#pragma unroll
        for (int e = 0; e < 16; ++e) { sc[e] = sigm(lg[(F.wave * 9 + F.lane) * 16 + e]); rb[e] = F.in[I_RB][e]; }
        float gs[4];
#pragma unroll
        for (int g = 0; g < 4; ++g) { const float a = sc[4 * g] + rb[4 * g], bq = sc[4 * g + 1] + rb[4 * g + 1], c = sc[4 * g + 2] + rb[4 * g + 2], d = sc[4 * g + 3] + rb[4 * g + 3];
            const float hi1 = fmaxf(a, bq), lo1 = fminf(a, bq), hi2 = fmaxf(c, d), lo2 = fminf(c, d); gs[g] = fmaxf(hi1, hi2) + fmaxf(fminf(hi1, hi2), fmaxf(lo1, lo2)); }
        int gi = 0; float gv = gs[0]; if (gs[1] > gv) { gv = gs[1]; gi = 1; } if (gs[2] > gv) { gv = gs[2]; gi = 2; } if (gs[3] > gv) { gv = gs[3]; gi = 3; }
        const float u0 = sel4(gi, sc[0], sc[4], sc[8], sc[12]), u1 = sel4(gi, sc[1], sc[5], sc[9], sc[13]), u2 = sel4(gi, sc[2], sc[6], sc[10], sc[14]), u3 = sel4(gi, sc[3], sc[7], sc[11], sc[15]);
        const float b0 = sel4(gi, rb[0], rb[4], rb[8], rb[12]), b1 = sel4(gi, rb[1], rb[5], rb[9], rb[13]), b2 = sel4(gi, rb[2], rb[6], rb[10], rb[14]), b3 = sel4(gi, rb[3], rb[7], rb[11], rb[15]);
        int i1, i2; top2of4(u0 + b0, u1 + b1, u2 + b2, u3 + b3, i1, i2);
        const float s1 = sel4(i1, u0, u1, u2, u3), s2v = sel4(i2, u0, u1, u2, u3), inv = 1.0f / (s1 + s2v);
        e1 = gi * 4 + i1; e2 = gi * 4 + i2; w1 = s1 * inv; w2 = s2v * inv;
        k1 = __hip_atomic_fetch_add(hist + e1, 1, __ATOMIC_RELAXED, __HIP_MEMORY_SCOPE_WORKGROUP); k2 = __hip_atomic_fetch_add(hist + e2, 1, __ATOMIC_RELAXED, __HIP_MEMORY_SCOPE_WORKGROUP); }
    __syncthreads();
    if (F.tid < 16) gbase[F.tid] = (int)__hip_atomic_fetch_add((gu32*)(F.ws + WS_CTL) + CW_GCNT + 64 * l + F.tid, (unsigned)hist[F.tid], RLX_AGENT);
    __syncthreads();
    if (valid) { const int g1 = gbase[e1] + k1, g2 = gbase[e2] + k2;
        int* rt = (int*)(F.ws + WS_ROUTE) + 8 * rl; rt[0] = e1; rt[1] = e2; rt[2] = g1; rt[3] = g2; rt[4] = __float_as_int(w1); rt[5] = __float_as_int(w2);
        int* RT = (int*)(F.ws + WS_XP); RT[(size_t)e1 * ROWCAP + g1] = rl; RT[(size_t)e2 * ROWCAP + g2] = rl; }
}
__device__ __forceinline__ unsigned char* opq_ptr(unsigned char* p) { GAS unsigned char* g = (GAS unsigned char*)p; asm volatile("" : "+s"(g)); return (unsigned char*)g; }
#define FRESH_FR(Fq) Fr Fq = F; Fq.ws = opq_ptr(F.ws); { int t_; asm volatile("v_mbcnt_lo_u32_b32 %0, -1, 0\n\tv_mbcnt_hi_u32_b32 %0, -1, %0" : "=v"(t_)); Fq.lane = t_; Fq.tid = t_ + F.wave * 64; }
constexpr int CVQ1 = 2592;
__device__ __forceinline__ void cvt_fill(const Fr& F, int l, unsigned char* wb, int i0, int i1, int first_idle) {
    int j = F.blk - first_idle, n = F.G - first_idle; if (n <= 0) { j = F.blk; n = F.G; }
    if (j >= 0) cvt_range(F, l, wb, i0 + j * NWAVES + F.wave, n * NWAVES, i1);
}
constexpr int NPH = 11;
constexpr int PH_END = 1 + DEPTH * NPH + 1;
struct Args { const float* in[25]; float* out; unsigned char* ws; int ph_lo, ph_hi; };
__global__ void __launch_bounds__(NWAVES * 64, 2) fwd(Args args) {
    extern __shared__ __attribute__((aligned(16))) unsigned char lds_raw[];
    Fr F;
    F.lds = (LAS unsigned char*)lds_raw;
    F.tid = threadIdx.x; F.lane = F.tid & 63; F.wave = __builtin_amdgcn_readfirstlane(F.tid >> 6);
    F.G = gridDim.x; F.blk = blockIdx.x; F.gw = F.blk * NWAVES + F.wave; F.NGW = F.G * NWAVES;
#pragma unroll
    for (int i = 0; i < 25; ++i) F.in[i] = args.in[i];
    F.out = args.out; F.ws = args.ws;
    volatile LAS unsigned* MISC = (volatile LAS unsigned*)(F.lds + MISC_OFF);
    if (F.tid < 32) MISC[F.tid] = 0u;
    __syncthreads();
#if MK_PER_PHASE
#define GRID_BAR() do { } while (0)
#else
    XcdBarrier bar = xcd_barrier_post((unsigned*)(F.ws + WS_CTL) + CW_BAR, MISC + 8);
#define GRID_BAR() xcd_barrier(bar)
#endif
    const int lo = args.ph_lo, hi = args.ph_hi;
#ifndef DBG_PH
#define DBG_PH -1
#endif
#define IN(k) (lo <= (k) && (k) < hi)
#define ON(k) (DBG_PH < 0 || DBG_PH == (k))
    const int opq = (int)(gridDim.x >> 20);
#define IN2(k) (lo <= (k) && (k) < hi + opq)
#define IN3(k) (lo <= (k) + opq && (k) < hi)
    LAS unsigned char* ring = F.lds;
#define PHASE_WS() Fr Fp = F; Fp.ws = opq_ptr(F.ws); { int t_; asm volatile("v_mbcnt_lo_u32_b32 %0, -1, 0\n\tv_mbcnt_hi_u32_b32 %0, -1, %0" : "=v"(t_)); t_ += F.wave * 64; int b_ = F.blk; asm volatile("" : "+s"(b_)); Fp.tid = t_; Fp.lane = t_ & 63; Fp.wave = __builtin_amdgcn_readfirstlane(t_ >> 6); Fp.blk = b_; Fp.gw = b_ * NWAVES + Fp.wave; } unsigned char* ws = Fp.ws; (void)ws

    if (ON(100) && IN(0)) { p0_setup(F); GRID_BAR(); }

    for (int l = 0; l < DEPTH; ++l) {
        const int pb = 1 + l * NPH; const int lastl = (l == DEPTH - 1) ? 1 : 0;
        const size_t wbo = (l & 1) ? WS_W2 : WS_W, wbn = (l & 1) ? WS_W : WS_W2;
        if (ON(0) && IN(pb + 0)) { PHASE_WS(); if (l == 0) { cvt_range(Fp, 0, Fp.ws + wbo, CVQ1 + Fp.gw, F.NGW, CV_GU); cvt_range(Fp, 0, Fp.ws + wbo, CV_GU + CV_DN + Fp.gw, F.NGW, CV_T64); } cvt_uq(Fp, l, Fp.ws + wbo); if (l == 0) row_phase_a<0>(Fp, l); else row_phase_a<1>(Fp, l); GRID_BAR(); }
        if (ON(1) && IN(pb + 1)) { PHASE_WS(); pg8::Gemm g{(const bf16_t*)(ws + WS_H), (const bf16_t*)(ws + wbo + W_IN), M, INP, 1024}; pg8::StaticOrder S; S.init(M, INP, F.G, Fp.blk);
            pg8::EpiStore E{(bf16_t*)(ws + WS_P), INP};
            pg8::gemm_phase<pg8::EpiStore, pg8::StaticOrder, true, true>(ring, g, S, E, Fp.tid);
            { FRESH_FR(Fq); const int nwg = (M / 256) * (INP / 256), R = (nwg + F.G - 1) / F.G, fi = nwg % F.G ? nwg - (R - 1) * F.G : F.G;
              if (l + 1 < DEPTH) { int j = Fq.blk - fi, n = F.G - fi; if (n <= 0) { j = Fq.blk; n = F.G; } if (j >= 0) mod_items(Fq, l + 1, j, n); }
              cvt_fill(Fq, l, Fq.ws + wbo, 0, CVQ1, fi); }
            GRID_BAR(); }
        if (ON(2) && IN(pb + 2)) { PHASE_WS(); { int slot = 0; for (int it = Fp.blk; it < hg::NITEM; it += F.G, ++slot) hg::scan_dir<0>(Fp, l, it >> 7, (it >> 5) & 3, (it >> 4) & 1, it & 15, -1, 0, 0, nullptr); (void)slot; } mla_prep(Fp, l, Fp.gw, F.NGW); GRID_BAR(); }
        if (ON(3) && IN(pb + 3)) { PHASE_WS(); hg::scan_pass2(Fp); }
        if (ON(3) && IN2(pb + 3)) { PHASE_WS();
            { pg8::Gemm g{(const bf16_t*)(ws + WS_DQN), (const bf16_t*)(ws + wbo + W_UQ), M, 768, 384}; pg8::StaticOrder S; S.init(M, 768, F.G, (Fp.blk + F.G - 52) % F.G, lastl);
              pg8::EpiQ E{(bf16_t*)(ws + WS_Q), (const float*)(ws + WS_ROPE)};
              pg8::gemm_phase<pg8::EpiQ, pg8::StaticOrder, true, true>(ring, g, S, E, Fp.tid); } }
        if (ON(3) && IN3(pb + 3)) { PHASE_WS();
            { pg8::Gemm g{(const bf16_t*)(ws + WS_DKVN), (const bf16_t*)(ws + wbo + W_UKV), M, 1024, 256}; pg8::StaticOrder S; S.init(M, 1024, F.G, Fp.blk);
              pg8::EpiKV E{(bf16_t*)(ws + WS_K), (bf16_t*)(ws + WS_V)};
              pg8::gemm_phase<pg8::EpiKV, pg8::StaticOrder, true, true>(ring, g, S, E, Fp.tid); }
            GRID_BAR(); }
        if (ON(4) && IN2(pb + 4)) { PHASE_WS(); for (int it = Fp.blk; it < 256; it += F.G) { const int b_ = it >> 6, h_ = (it >> 4) & 3, k_ = it & 15; hg::scan_dir<1>(Fp, l, b_, h_, 0, k_, -1, 0, 0, nullptr); hg::scan_dir<2>(Fp, l, b_, h_, 1, k_ ? 16 - k_ : 0, -1, 0, 0, nullptr); } }
        if (ON(4) && IN(pb + 4)) { PHASE_WS(); const int nu = 512 + (l < DEPTH - 1 ? 32 : 0);
            const bf16_t* Qg = (const bf16_t*)(ws + WS_Q); const bf16_t* Kg = (const bf16_t*)(ws + WS_K); const bf16_t* Vg = (const bf16_t*)(ws + WS_V); bf16_t* MO = (bf16_t*)(ws + WS_MO);
            for (int u = Fp.blk; u < nu; u += F.G) {
                const int bh = u < 512 ? (u >> 4) : (u - 512), t0 = u < 512 ? CTX + (u & 15) * 256 : 0, seq = u < 512 ? TPB : CTX, b = bh >> 3, h = bh & 7;
                int tq_; asm volatile("v_mbcnt_lo_u32_b32 %0, -1, 0\n\tv_mbcnt_hi_u32_b32 %0, -1, %0" : "=v"(tq_)); tq_ += Fp.wave * 64;
                if (false) { CvHook hk{Fp, l + 1, Fp.ws + wbn}; att::attn_unit(Qg + ((size_t)bh * TPB + t0) * 96, Kg + (size_t)bh * TPB * 96, Vg + (size_t)bh * TPB * 64, MO + ((size_t)b * TPB + t0) * 512 + h * 64, 512, seq, (LAS char*)ring, tq_, hk); }
                else { att::NoHook hk; att::attn_unit_pp(Qg + ((size_t)bh * TPB + t0) * 96, Kg + (size_t)bh * TPB * 96, Vg + (size_t)bh * TPB * 64, MO + ((size_t)b * TPB + t0) * 512 + h * 64, 512, seq, (LAS char*)ring, tq_, hk); } }
            GRID_BAR(); }
        if (ON(6) && IN(pb + 6)) { PHASE_WS();
            { pg8::Gemm g{(const bf16_t*)(ws + WS_A), (const bf16_t*)(ws + wbo + W_PA), M, 1024, 512}; pg8::StaticOrder S; S.init(M, 1024, F.G, Fp.blk, lastl);
              pg8::EpiMerge<false> E{(const bf16_t*)(ws + WS_P), C_GA, (bf16_t*)(ws + WS_MIX)};
              pg8::gemm_phase<pg8::EpiMerge<false>, pg8::StaticOrder, true, true>(ring, g, S, E, Fp.tid); } }
        if (ON(6) && IN2(pb + 6)) { PHASE_WS();
            { pg8::Gemm g{(const bf16_t*)(ws + WS_MO), (const bf16_t*)(ws + wbo + W_PB), M, 1024, 512}; pg8::StaticOrder S; S.init(M, 1024, F.G, Fp.blk, lastl);
              pg8::EpiMerge<true> E{(const bf16_t*)(ws + WS_P), C_GB, (bf16_t*)(ws + WS_MIX)};
              pg8::gemm_phase<pg8::EpiMerge<true>, pg8::StaticOrder, true, true>(ring, g, S, E, Fp.tid); }
            GRID_BAR(); }
        if (ON(7) && IN(pb + 7)) { PHASE_WS(); pg8::Gemm g{(const bf16_t*)(ws + WS_MIX), (const bf16_t*)(ws + wbo + W_O), M, 1024, 1024}; pg8::StaticOrder S; S.init(M, 1024, F.G, Fp.blk, lastl);
            pg8::EpiWo E{(bf16_t*)(ws + WS_Z), (const float*)(ws + WS_MOD) + (size_t)l * 5 * 6144};
            pg8::gemm_phase<pg8::EpiWo, pg8::StaticOrder, true, true>(ring, g, S, E, Fp.tid); GRID_BAR(); }
        if (ON(8) && IN(pb + 8)) { PHASE_WS(); norm2_route(Fp, l, lastl); GRID_BAR(); }
        if (ON(9) && IN(pb + 9)) { PHASE_WS(); moe_tab(Fp, l); const LAS int* tab = (const LAS int*)(Fp.lds + MOETAB_OFF); const int ntile = tab[48];
            pg8::Gemm g{(const bf16_t*)(ws + WS_H), (const bf16_t*)(ws + wbo + W_GU), XROWS, 1024, 1024}; pg8::MoeGatherOrder S{ntile * 4, F.G, Fp.blk, tab, (const int*)(ws + WS_XP), ROWCAP};
            pg8::EpiGU E{(bf16_t*)(ws + WS_HID)};
            pg8::gemm_phase<pg8::EpiGU, pg8::MoeGatherOrder, true, true>(ring, g, S, E, Fp.tid);
            { FRESH_FR(Fq); cvt_fill(Fq, l, Fq.ws + wbo, CV_GU, CV_GU + CV_DN, F.G / 2); if (l + 1 < DEPTH) cvt_fill(Fq, l + 1, Fq.ws + wbn, CVQ1, CV_GU, F.G / 2); }
            GRID_BAR(); }
        if (ON(10) && IN(pb + 10)) { PHASE_WS(); moe_tab(Fp, l); const LAS int* tab = (const LAS int*)(Fp.lds + MOETAB_OFF); const int ntile = tab[48];
            pg8::Gemm g{(const bf16_t*)(ws + WS_HID), (const bf16_t*)(ws + wbo + W_DN), XROWS, 1024, 512}; pg8::MoeOrder S{ntile * 4, F.G, Fp.blk, tab};
            pg8::EpiStore E{(bf16_t*)(ws + WS_Y), 1024};
            pg8::gemm_phase<pg8::EpiStore, pg8::MoeOrder, true, true>(ring, g, S, E, Fp.tid);
            if (l + 1 < DEPTH) { FRESH_FR(Fq); cvt_fill(Fq, l + 1, Fq.ws + wbn, CV_GU + CV_DN, CV_T64, F.G / 2); }
            GRID_BAR(); }
    }
    if (ON(101) && IN(PH_END - 1)) { PHASE_WS(); row_phase_a<2>(Fp, DEPTH); }
#undef IN
#undef IN2
#undef IN3
#undef ON
}

extern "C" void kernel_launch(void* const* d_in, const int* in_sizes, int n_in, void* d_out, int out_size, void* d_ws, size_t ws_size, hipStream_t stream) {
    static int grid = 0;
    if (grid == 0) {
        if (n_in != 25 || out_size != NB * SEQ * D || ws_size < WS_END) { fprintf(stderr, "kernel_launch: unexpected shapes: n_in %d out %d ws %zu (need %zu)\n", n_in, out_size, ws_size, (size_t)WS_END); grid = -1; return; }
        int dev = 0, cus = 0;
        if (hipGetDevice(&dev) != hipSuccess || hipDeviceGetAttribute(&cus, hipDeviceAttributeMultiprocessorCount, dev) != hipSuccess) { grid = -1; return; }
        if (hipFuncSetAttribute((const void*)fwd, hipFuncAttributeMaxDynamicSharedMemorySize, LDS_BYTES) != hipSuccess) { fprintf(stderr, "kernel_launch: hipFuncSetAttribute failed\n"); grid = -1; return; }
        int per_cu = 0;
        if (hipOccupancyMaxActiveBlocksPerMultiprocessor(&per_cu, (const void*)fwd, NWAVES * 64, LDS_BYTES) != hipSuccess || per_cu < 1) fprintf(stderr, "kernel_launch: occupancy query says %d\n", per_cu);
        (void)hipGetLastError();
        grid = cus > 256 ? 256 : cus;
    }
    if (grid < 0) return;
    if (hipMemsetAsync((char*)d_ws + WS_CTL, 0, CTL_ZERO_BYTES, stream) != hipSuccess) return;
    Args a{};
    for (int i = 0; i < 25; ++i) a.in[i] = (const float*)d_in[i];
    a.out = (float*)d_out; a.ws = (unsigned char*)d_ws;
#if MK_PER_PHASE
    for (int p = 0; p < PH_END; ++p) { a.ph_lo = p; a.ph_hi = p + 1; hipLaunchKernelGGL(fwd, dim3(grid), dim3(NWAVES * 64), LDS_BYTES, stream, a); }
#else
    a.ph_lo = 0; a.ph_hi = PH_END; hipLaunchKernelGGL(fwd, dim3(grid), dim3(NWAVES * 64), LDS_BYTES, stream, a);
#endif
    const hipError_t le = hipPeekAtLastError();
    if (le != hipSuccess) fprintf(stderr, "kernel_launch: launch failed: %s\n", hipGetErrorName(le));
}
```

```cpp
#include <hip/hip_runtime.h>
#include <cstdio>
#include <cstdint>
#ifndef MK_PER_PHASE
#define MK_PER_PHASE 0
#endif
#define GAS __attribute__((address_space(1)))
#define LAS __attribute__((address_space(3)))
constexpr int D = 1024, NB = 4, SEQ = 4096, CTX = 256, TPB = CTX + SEQ  , M = NB * TPB  , DEPTH = 4;
constexpr int IN_DIM = 5280, INP = 5376;
constexpr int C_Q = 0, C_I = 512, C_FF = 1024, C_FB = 1536, C_G = 2048, C_DQ = 2560, C_DKV = 2944, C_KPE = 3200, C_GA = 3232, C_GB = 4256;
constexpr int NE = 16, DE = 512, XROWS = 38912;
constexpr float EPS = 1e-6f;
constexpr size_t MiB = 1u << 20;
constexpr size_t WS_CTL = 0, CTL_ZERO_BYTES = 1 * MiB;
constexpr size_t WS_MOD = 1 * MiB;
constexpr size_t WS_LBT = WS_MOD + 512 * 1024;
constexpr size_t WS_ROPE = WS_LBT + 16 * 1024;
constexpr size_t WS_HIST = WS_ROPE + 4096;
constexpr size_t WS_TILE = WS_HIST + 16384;
constexpr size_t WS_ROUTE = 2 * MiB;
constexpr size_t WS_SLOT = 3 * MiB;
constexpr size_t WS_SD = 3 * MiB + 512 * 1024;
constexpr size_t WS_ST = 136 * MiB;
constexpr size_t WS_W = 4 * MiB, WS_W2 = 517 * MiB;
constexpr size_t W_IN = 0, W_UQ = W_IN + (size_t)INP * 1024 * 2, W_UKV = W_UQ + 768 * 384 * 2, W_PA = W_UKV + 1024 * 256 * 2, W_PB = W_PA + 1024 * 512 * 2,
                 W_O = W_PB + 1024 * 512 * 2, W_GU = W_O + 1024 * 1024 * 2, W_DN = W_GU + (size_t)16 * 1024 * 1024 * 2, W_END = W_DN + (size_t)16 * 1024 * 512 * 2;
static_assert(W_END <= 64 * MiB, "weights");
constexpr size_t WS_Z = 68 * MiB;
constexpr size_t WS_H = 136 * MiB;
constexpr size_t WS_P = 170 * MiB;
constexpr size_t WS_DQN = 349 * MiB, WS_DKVN = 362 * MiB;
constexpr size_t WS_XP = 170 * MiB, WS_HID = 246 * MiB, WS_Y = 284 * MiB;
constexpr int ROWCAP = 2 * M;
constexpr size_t WS_Q = 380 * MiB, WS_K = 406 * MiB, WS_V = 432 * MiB;
constexpr size_t WS_MIX = 380 * MiB;
constexpr size_t WS_OF = 449 * MiB, WS_OB = 466 * MiB;
constexpr size_t WS_A = 483 * MiB, WS_MO = 500 * MiB;
constexpr size_t WS_END = 581 * MiB;
static_assert(WS_P + (size_t)M * INP * 2 <= WS_DQN && WS_DQN + (size_t)M * 384 * 2 <= WS_DKVN && WS_DKVN + (size_t)M * 256 * 2 <= WS_Q, "R1 mixer view");
static_assert(WS_XP + (size_t)XROWS * 2048 <= WS_HID && WS_HID + (size_t)XROWS * 1024 <= WS_Y && WS_Y + (size_t)XROWS * 2048 <= WS_Q, "R1 moe view");
static_assert(WS_Q + (size_t)32 * TPB * 192 <= WS_K && WS_K + (size_t)32 * TPB * 192 <= WS_V && WS_V + (size_t)32 * TPB * 128 <= WS_OF && WS_MIX + (size_t)M * 2048 <= WS_V, "qkv");
static_assert(WS_OF + (size_t)M * 1024 <= WS_OB && WS_OB + (size_t)M * 1024 <= WS_A && WS_A + (size_t)M * 1024 <= WS_MO && WS_MO + (size_t)M * 1024 <= WS_W2 && WS_W2 + W_END <= WS_END, "tail");
namespace pg8 {
#define PG8_LAS __attribute__((address_space(3)))
typedef unsigned short bf16_t;
typedef short bf16x8 __attribute__((ext_vector_type(8)));
typedef float f32x4 __attribute__((ext_vector_type(4)));
typedef unsigned u32x4 __attribute__((ext_vector_type(4)));
constexpr int BM = 256, BK = 64, HALF = 128, HTB = HALF * BK * 2  , STAGE_BYTES = 8 * HTB, NXCD = 8, WGM = 8;

__host__ __device__ __forceinline__ int lds_byte(int r, int c) { const int st = (r >> 4) * 2 + (c >> 5), rr = r & 15, cc = c & 31, ob = rr * 64 + cc * 2; return st * 1024 + (ob ^ (((ob >> 9) & 1) << 5)); }
__host__ __device__ __forceinline__ void stage_rc(int b, int& R, int& C) { const int st = b / 1024, sb = b % 1024, swz = sb ^ (((sb >> 9) & 1) << 5); R = (st >> 1) * 16 + swz / 64; C = (st & 1) * 32 + (swz % 64) / 2; }
__host__ __device__ __forceinline__ int perm32(int rho) { const int n = rho >> 4, i = rho & 15; return 8 * (i >> 2) + 4 * n + (i & 3); }

struct Unit { int pm, pn, pb; };
struct Gemm { const bf16_t* A; const bf16_t* Bt; int M, N, K; };

struct StaticOrder {
    static constexpr bool GATHER = false;
    int nM, nN, nwg, G, c, lat;
    __host__ __device__ void init(int M, int N, int G_, int c_, int lat_ = 0) { lat = lat_; nM = lat_ ? 64 : M / BM; nN = N / BM; nwg = nM * nN; G = G_; c = c_; }
    __host__ __device__ bool next(int i, Unit& u) const {
        const long L = (long)i * G + c; if (L >= nwg) return false;
        int wgid = (int)L; { const int q = nwg / NXCD, r = nwg % NXCD, xcd = wgid % NXCD, off = wgid / NXCD; wgid = (xcd < r ? xcd * (q + 1) : r * (q + 1) + (xcd - r) * q) + off; }
        const int nig = WGM * nN, gid = wgid / nig, fm = gid * WGM, gsz = (nM - fm) < WGM ? (nM - fm) : WGM;
        u.pm = fm + ((wgid % nig) % gsz); u.pn = (wgid % nig) / gsz; u.pb = u.pn; if (lat) u.pm = (u.pm >> 4) * 17 + 1 + (u.pm & 15); return true;
    }
    __device__ __forceinline__ void a_ready(const Unit&) const {}
    __device__ __forceinline__ void done(const Unit&) const {}
};

typedef float f32x2 __attribute__((ext_vector_type(2)));
__device__ __forceinline__ unsigned cvt_pk_bf16(float lo, float hi) { unsigned r; asm volatile("v_cvt_pk_bf16_f32 %0, %1, %2" : "=v"(r) : "v"(lo), "v"(hi)); return r; }
__device__ __forceinline__ u32x4 pack8(f32x4 v0, f32x4 v1) { u32x4 w; w.x = cvt_pk_bf16(v0[0], v0[1]); w.y = cvt_pk_bf16(v0[2], v0[3]); w.z = cvt_pk_bf16(v1[0], v1[1]); w.w = cvt_pk_bf16(v1[2], v1[3]); return w; }
__device__ __forceinline__ float bf_lo(unsigned u) { return __uint_as_float(u << 16); }
__device__ __forceinline__ float bf_hi(unsigned u) { return __uint_as_float(u & 0xffff0000u); }
__device__ __forceinline__ void unpack8(u32x4 w, f32x4& v0, f32x4& v1) { v0 = (f32x4){bf_lo(w.x), bf_hi(w.x), bf_lo(w.y), bf_hi(w.y)}; v1 = (f32x4){bf_lo(w.z), bf_hi(w.z), bf_lo(w.w), bf_hi(w.w)}; }
__device__ __forceinline__ float sigmoidf_(float x) { return __builtin_amdgcn_rcpf(1.0f + __expf(-x)); }
__device__ __forceinline__ f32x4 sigmoid4(f32x4 x) { return (f32x4){sigmoidf_(x[0]), sigmoidf_(x[1]), sigmoidf_(x[2]), sigmoidf_(x[3])}; }

struct EpiStore { static constexpr bool PERM = true, AFTER_DRAIN = false; bf16_t* O; int ldc;
    __device__ __forceinline__ void operator()(const f32x4 (&acc)[2][2][4][2], const Unit& u, int wr, int wc, int fr, int fq) const {
        const int row0 = u.pm * BM + wr * 64 + fr, col0 = u.pn * BM + wc * 32 + 8 * fq;
#pragma unroll
        for (int ai = 0; ai < 2; ++ai)
#pragma unroll
            for (int m = 0; m < 4; ++m) { bf16_t* rowp = O + (size_t)(row0 + ai * HALF + m * 16) * ldc + col0;
#pragma unroll
                for (int bj = 0; bj < 2; ++bj) *(u32x4*)(rowp + bj * HALF) = pack8(acc[ai][bj][m][0], acc[ai][bj][m][1]); }
    }
};
constexpr float QSC = 0.10206207261596575f * 1.4426950408889634f;
struct EpiQ { static constexpr bool PERM = true, AFTER_DRAIN = false; bf16_t* Q; const float* rope;
    __device__ __forceinline__ void operator()(const f32x4 (&acc)[2][2][4][2], const Unit& u, int wr, int wc, int fr, int fq) const {
        const int b = u.pm / 17, tt = (u.pm % 17) * 256 + wr * 64 + fr; const bool lat = (u.pm % 17) != 0;
        const int n0 = u.pn * BM + wc * 32 + 8 * fq, n1 = n0 + HALF, h0 = n0 / 96, e0 = n0 - h0 * 96, h1 = n1 / 96, e1 = n1 - h1 * 96;
        bf16_t* base0 = Q + (size_t)(b * 8 + h0) * TPB * 96 + e0; bf16_t* base1 = Q + (size_t)(b * 8 + h1) * TPB * 96 + e1;
        const bool rp0 = lat && e0 >= 64, rp1 = lat && e1 >= 64; const int ax0 = (e0 - 64) >> 4, ax1 = (e1 - 64) >> 4;
        const float* r0 = rope + (((e0 - 64) & 15) >> 1) * 2; const float* r1 = rope + (((e1 - 64) & 15) >> 1) * 2;
#pragma unroll
        for (int ai = 0; ai < 2; ++ai)
#pragma unroll
            for (int m = 0; m < 4; ++m) { const int t = tt + ai * HALF + m * 16, p = t - 256;
                { f32x4 v0 = acc[ai][0][m][0], v1 = acc[ai][0][m][1];
                  if (rp0) { const int pos = ax0 ? (p & 63) : (p >> 6); const f32x4 c0 = *(const f32x4*)(r0 + pos * 16), c1 = *(const f32x4*)(r0 + pos * 16 + 4);
                      v0 = (f32x4){v0[0] * c0[0] - v0[1] * c0[1], v0[0] * c0[1] + v0[1] * c0[0], v0[2] * c0[2] - v0[3] * c0[3], v0[2] * c0[3] + v0[3] * c0[2]};
                      v1 = (f32x4){v1[0] * c1[0] - v1[1] * c1[1], v1[0] * c1[1] + v1[1] * c1[0], v1[2] * c1[2] - v1[3] * c1[3], v1[2] * c1[3] + v1[3] * c1[2]}; }
                  *(u32x4*)(base0 + (size_t)t * 96) = pack8(v0 * QSC, v1 * QSC); }
                { f32x4 v0 = acc[ai][1][m][0], v1 = acc[ai][1][m][1];
                  if (rp1) { const int pos = ax1 ? (p & 63) : (p >> 6); const f32x4 c0 = *(const f32x4*)(r1 + pos * 16), c1 = *(const f32x4*)(r1 + pos * 16 + 4);
                      v0 = (f32x4){v0[0] * c0[0] - v0[1] * c0[1], v0[0] * c0[1] + v0[1] * c0[0], v0[2] * c0[2] - v0[3] * c0[3], v0[2] * c0[3] + v0[3] * c0[2]};
                      v1 = (f32x4){v1[0] * c1[0] - v1[1] * c1[1], v1[0] * c1[1] + v1[1] * c1[0], v1[2] * c1[2] - v1[3] * c1[3], v1[2] * c1[3] + v1[3] * c1[2]}; }
                  *(u32x4*)(base1 + (size_t)t * 96) = pack8(v0 * QSC, v1 * QSC); }
                asm volatile("" ::: "memory"); }
    }
};
struct EpiKV { static constexpr bool PERM = true, AFTER_DRAIN = false; bf16_t* K; bf16_t* V;
    __device__ __forceinline__ void operator()(const f32x4 (&acc)[2][2][4][2], const Unit& u, int wr, int wc, int fr, int fq) const {
        const int b = u.pm / 17, tt = (u.pm % 17) * 256 + wr * 64 + fr, j0 = wc * 32 + 8 * fq;
#pragma unroll
        for (int bj = 0; bj < 2; ++bj) { const int h = 2 * u.pn + bj; const size_t hb = (size_t)(b * 8 + h) * TPB;
            bf16_t* base = (wc < 2) ? (K + hb * 96 + j0) : (V + hb * 64 + (j0 - 64)); const int pitch = (wc < 2) ? 96 : 64;
#pragma unroll
            for (int ai = 0; ai < 2; ++ai)
#pragma unroll
                for (int m = 0; m < 4; ++m) { const int t = tt + ai * HALF + m * 16; *(u32x4*)(base + (size_t)t * pitch) = pack8(acc[ai][bj][m][0], acc[ai][bj][m][1]); asm volatile("" ::: "memory"); } }
    }
};
template <bool ADD> struct EpiMerge { static constexpr bool PERM = true, AFTER_DRAIN = false, HAS_MID = false; const bf16_t* P; int gcol; bf16_t* MIX;
    __device__ __forceinline__ void operator()(const f32x4 (&acc)[2][2][4][2], const Unit& u, int wr, int wc, int fr, int fq) const {
        const int row0 = u.pm * BM + wr * 64 + fr, col0 = u.pn * BM + wc * 32 + 8 * fq;
#pragma unroll
        for (int ai = 0; ai < 2; ++ai) { u32x4 gt[4][2], mx[4][2];
#pragma unroll
            for (int m = 0; m < 4; ++m)
#pragma unroll
                for (int bj = 0; bj < 2; ++bj) { const int row = row0 + ai * HALF + m * 16, col = col0 + bj * HALF; gt[m][bj] = *(const u32x4*)(P + (size_t)row * INP + gcol + col); if (ADD) mx[m][bj] = *(const u32x4*)(MIX + (size_t)row * 1024 + col); }
#pragma unroll
            for (int m = 0; m < 4; ++m)
#pragma unroll
                for (int bj = 0; bj < 2; ++bj) { const int row = row0 + ai * HALF + m * 16, col = col0 + bj * HALF; f32x4 g0, g1; unpack8(gt[m][bj], g0, g1);
                    f32x4 v0 = sigmoid4(g0) * acc[ai][bj][m][0], v1 = sigmoid4(g1) * acc[ai][bj][m][1];
                    if (ADD) { f32x4 o0, o1; unpack8(mx[m][bj], o0, o1); v0 += o0; v1 += o1; }
                    *(u32x4*)(MIX + (size_t)row * 1024 + col) = pack8(v0, v1); }
            asm volatile("" ::: "memory"); }
    }
};
struct EpiWo { static constexpr bool PERM = false, AFTER_DRAIN = false; bf16_t* Z; const float* modl;
    __device__ __forceinline__ void operator()(const f32x4 (&acc)[2][2][4][2], const Unit& u, int wr, int wc, int fr, int fq) const {
        const int row0 = u.pm * BM + wr * 64 + fr, col0 = u.pn * BM + wc * 32 + 4 * fq; const int ms = (u.pm % 17 == 0) ? 4 : u.pm / 17; const float* gate = modl + ms * 6144 + 2 * 1024;
        f32x4 gv[2][2];
#pragma unroll
        for (int bj = 0; bj < 2; ++bj)
#pragma unroll
            for (int n = 0; n < 2; ++n) gv[bj][n] = *(const f32x4*)(gate + col0 + bj * HALF + n * 16);
#pragma unroll
        for (int ai = 0; ai < 2; ++ai) { unsigned long long zo[4][2][2];
#pragma unroll
            for (int m = 0; m < 4; ++m)
#pragma unroll
                for (int bj = 0; bj < 2; ++bj)
#pragma unroll
                    for (int n = 0; n < 2; ++n) zo[m][bj][n] = *(const unsigned long long*)(Z + (size_t)(row0 + ai * HALF + m * 16) * 1024 + col0 + bj * HALF + n * 16);
#pragma unroll
            for (int m = 0; m < 4; ++m)
#pragma unroll
                for (int bj = 0; bj < 2; ++bj)
#pragma unroll
                    for (int n = 0; n < 2; ++n) { const unsigned lo = (unsigned)zo[m][bj][n], hi = (unsigned)(zo[m][bj][n] >> 32);
                        const f32x4 zn = (f32x4){bf_lo(lo), bf_hi(lo), bf_lo(hi), bf_hi(hi)} + gv[bj][n] * acc[ai][bj][m][n];
                        *(unsigned long long*)(Z + (size_t)(row0 + ai * HALF + m * 16) * 1024 + col0 + bj * HALF + n * 16) = (unsigned long long)cvt_pk_bf16(zn[0], zn[1]) | ((unsigned long long)cvt_pk_bf16(zn[2], zn[3]) << 32); }
            asm volatile("" ::: "memory"); }
    }
};
struct EpiGU { static constexpr bool PERM = true, AFTER_DRAIN = false; bf16_t* HID;
    __device__ __forceinline__ void operator()(const f32x4 (&acc)[2][2][4][2], const Unit& u, int wr, int wc, int fr, int fq) const {
        const int row0 = u.pm * BM + wr * 64 + fr, col0 = u.pn * HALF + wc * 32 + 8 * fq;
#pragma unroll
        for (int ai = 0; ai < 2; ++ai)
#pragma unroll
            for (int m = 0; m < 4; ++m) { const f32x4 g0 = acc[ai][0][m][0], g1 = acc[ai][0][m][1], u0 = acc[ai][1][m][0], u1 = acc[ai][1][m][1];
                *(u32x4*)(HID + (size_t)(row0 + ai * HALF + m * 16) * 512 + col0) = pack8(g0 * sigmoid4(g0) * u0, g1 * sigmoid4(g1) * u1); }
    }
};
struct MoeOrder { static constexpr bool GATHER = false; int nunits, G, c; const PG8_LAS int* tab;
    __device__ __forceinline__ bool next(int i, Unit& u) const { int j, col;
        if (G == 256) { const int q = c >> 3; col = q & 3; j = 64 * i + (q >> 2) * 8 + (c & 7); }
        else { const int L = i * G + c; j = L >> 2; col = L & 3; }
        if (4 * j >= nunits) return false; u.pm = j; u.pn = col; u.pb = tab[64 + j] * 4 + col; return true; }
    __device__ __forceinline__ void a_ready(const Unit&) const {}
    __device__ __forceinline__ void done(const Unit&) const {}
};
struct MoeGatherOrder { static constexpr bool GATHER = true; int nunits, G, c; const PG8_LAS int* tab; const int* rowtok; int cap;
    __device__ __forceinline__ bool next(int i, Unit& u) const { int j, col;
        if (G == 256) { const int q = c >> 3; col = q & 3; j = 64 * i + (q >> 2) * 8 + (c & 7); }
        else { const int L = i * G + c; j = L >> 2; col = L & 3; }
        if (4 * j >= nunits) return false; u.pm = j; u.pn = col; u.pb = tab[64 + j] * 4 + col; return true; }
    __device__ __forceinline__ void rows(const Unit& u, const int (&RA)[2], const int (&CA)[2], int K, unsigned (&v0)[2], unsigned (&v1)[2]) const {
        const int e = tab[64 + u.pm], last = tab[e] - 1, r0 = u.pm * BM - tab[16 + e]; const int* rt = rowtok + (size_t)e * cap;
#pragma unroll
        for (int i = 0; i < 2; ++i) { const int k0 = r0 + RA[i], k1 = k0 + HALF;
            v0[i] = (unsigned)rt[k0 < last ? k0 : last] * (unsigned)(K * 2) + (unsigned)(CA[i] * 2); v1[i] = (unsigned)rt[k1 < last ? k1 : last] * (unsigned)(K * 2) + (unsigned)(CA[i] * 2); } }
    __device__ __forceinline__ void a_ready(const Unit&) const {}
    __device__ __forceinline__ void done(const Unit&) const {}
};
template <class Epi, class Sched, bool ALIGN_EPI = false, bool SP2 = false>
__device__ __forceinline__ void gemm_phase(PG8_LAS unsigned char* lds, const Gemm g, const Sched& S, const Epi& E, int tid_in) {
    int tid_ = tid_in; asm volatile("" : "+v"(tid_));
    const int tid = tid_, wid = __builtin_amdgcn_readfirstlane(tid >> 6), lane = tid & 63, wr = wid >> 2, wc = wid & 3, fr = lane & 15, fq = lane >> 4;
    const int K = g.K, nt = K / BK;
    constexpr bool GATHER = Sched::GATHER; static_assert(!GATHER || SP2, "gathered A rows: SP2 loop only");
    unsigned voffA[2], voffB[2]; int RA[2], CA[2];
#pragma unroll
    for (int i = 0; i < 2; ++i) { int R, C; stage_rc(tid * 16 + i * 8192, R, C); const int Rb = Epi::PERM ? ((R & ~31) + perm32(R & 31)) : R; RA[i] = R; CA[i] = C;
        voffA[i] = (unsigned)(R * K + C) * 2u; voffB[i] = (unsigned)(Rb * K + C) * 2u; }
    unsigned vC0[2] = {voffA[0], voffA[1]}, vC1[2] = {voffA[0], voffA[1]}, vN0[2] = {voffA[0], voffA[1]}, vN1[2] = {voffA[0], voffA[1]};
    const size_t kstep = (size_t)(BK * 2);
    const size_t hstep = (size_t)HALF * K * 2;
    const size_t tstep = 2 * hstep;
    const size_t hstepA = GATHER ? (size_t)0 : hstep;
    const unsigned ldsw = (unsigned)wid * 1024u;
    const int aoff = lds_byte(wr * 64 + fr, fq * 8), boff = lds_byte(wc * 32 + fr, fq * 8);
#define PG8_SA(b, h) (((b) * 2 + (h)) * HTB)
#define PG8_SB(b, h) ((4 + (b) * 2 + (h)) * HTB)
#define PG8_STAGE(bufoff, gbase, voff) do { _Pragma("unroll") for (int _i = 0; _i < 2; ++_i) \
        __builtin_amdgcn_global_load_lds((const unsigned*)((const char*)(gbase) + (voff)[_i]), (PG8_LAS unsigned*)(lds + (bufoff) + ldsw + _i * 8192), 16, 0, 0); } while (0)
#define PG8_LDA(dst, b, h) do { _Pragma("unroll") for (int m = 0; m < 4; ++m) _Pragma("unroll") for (int k = 0; k < 2; ++k) dst[m][k] = *(const PG8_LAS bf16x8*)(lds + PG8_SA(b, h) + aoff + m * 2048 + k * 1024); } while (0)
#define PG8_LDB(dst, b, h) do { _Pragma("unroll") for (int n = 0; n < 2; ++n) _Pragma("unroll") for (int k = 0; k < 2; ++k) dst[n][k] = *(const PG8_LAS bf16x8*)(lds + PG8_SB(b, h) + boff + n * 2048 + k * 1024); } while (0)
#define PG8_MMA(ai, bj, At, Bt) do { __builtin_amdgcn_s_setprio(1); _Pragma("unroll") for (int m = 0; m < 4; ++m) _Pragma("unroll") for (int n = 0; n < 2; ++n) _Pragma("unroll") for (int k = 0; k < 2; ++k) \
        acc[ai][bj][m][n] = __builtin_amdgcn_mfma_f32_16x16x32_bf16(Bt[n][k], At[m][k], acc[ai][bj][m][n], 0, 0, 0); __builtin_amdgcn_s_setprio(0); } while (0)
#define PG8_WAIT_V(n) asm volatile("s_waitcnt vmcnt(" #n ")" ::: "memory")
#define PG8_WAIT_L(n) asm volatile("s_waitcnt lgkmcnt(" #n ")" ::: "memory")
#define PG8_BAR __builtin_amdgcn_s_barrier()
#define PG8_SCHED __builtin_amdgcn_sched_barrier(0)
    Unit cur, nxt; int ui = 0;
    if (!S.next(0, cur)) return;
    f32x4 acc[2][2][4][2];
#pragma unroll
    for (int a = 0; a < 2; ++a)
#pragma unroll
        for (int b = 0; b < 2; ++b)
#pragma unroll
            for (int m = 0; m < 4; ++m)
#pragma unroll
                for (int n = 0; n < 2; ++n) acc[a][b][m][n] = (f32x4){0.f, 0.f, 0.f, 0.f};
    bf16x8 At[4][2], B0[2][2], B1[2][2];
    const char* cA = GATHER ? (const char*)g.A : (const char*)g.A + (size_t)cur.pm * tstep; const char* cB = (const char*)g.Bt + (size_t)cur.pb * tstep;
    if constexpr (GATHER) S.rows(cur, RA, CA, K, vC0, vC1);
    S.a_ready(cur);
    if constexpr (SP2) {
        PG8_STAGE(PG8_SB(0, 0), cB, voffB); PG8_STAGE(PG8_SB(0, 1), cB + hstep, voffB); PG8_STAGE(PG8_SA(0, 0), cA, vC0); PG8_STAGE(PG8_SA(0, 1), cA + hstepA, vC1);
        if (wr == 1) PG8_BAR;
        PG8_WAIT_V(2); PG8_BAR;
        PG8_STAGE(PG8_SB(1, 0), cB + kstep, voffB); PG8_STAGE(PG8_SA(1, 0), cA + kstep, vC0); PG8_STAGE(PG8_SB(1, 1), cB + hstep + kstep, voffB);
        PG8_WAIT_V(6); PG8_BAR;
    } else {
        PG8_STAGE(PG8_SB(0, 0), cB, voffB); PG8_STAGE(PG8_SA(0, 0), cA, voffA); PG8_STAGE(PG8_SB(0, 1), cB + hstep, voffB); PG8_STAGE(PG8_SA(0, 1), cA + hstep, voffA);
        if (wr == 1) PG8_BAR;
        PG8_WAIT_V(4); PG8_BAR;
        PG8_STAGE(PG8_SB(1, 0), cB + kstep, voffB); PG8_STAGE(PG8_SA(1, 0), cA + kstep, voffA); PG8_STAGE(PG8_SB(1, 1), cB + hstep + kstep, voffB);
        PG8_WAIT_V(6); PG8_BAR;
    }
    for (;;) {
        const bool has_next = S.next(ui + 1, nxt);
        const char* nA = (has_next && !GATHER) ? (const char*)g.A + (size_t)nxt.pm * tstep : cA;
        if constexpr (GATHER) { if (has_next) S.rows(nxt, RA, CA, K, vN0, vN1); else { vN0[0] = vC0[0]; vN0[1] = vC0[1]; vN1[0] = vC1[0]; vN1[1] = vC1[1]; } }
        const char* nB = has_next ? (const char*)g.Bt + (size_t)nxt.pb * tstep : cB;
        for (int t = 0; t < nt; t += 2) {
            const bool last = (t == nt - 2);
            const char* a1 = cA + (size_t)(t + 1) * kstep;
            const char* a2 = last ? nA : cA + (size_t)(t + 2) * kstep; const char* b2 = last ? nB : cB + (size_t)(t + 2) * kstep;
            const char* a3 = a2 + kstep; const char* b3 = b2 + kstep;
            if (last && has_next) S.a_ready(nxt);
            unsigned w0[2], w1[2];
            if constexpr (GATHER) { w0[0] = last ? vN0[0] : vC0[0]; w0[1] = last ? vN0[1] : vC0[1]; w1[0] = last ? vN1[0] : vC1[0]; w1[1] = last ? vN1[1] : vC1[1]; } else { w0[0] = w1[0] = voffA[0]; w0[1] = w1[1] = voffA[1]; }
            if constexpr (SP2) {
            PG8_LDB(B0, 0, 0); PG8_LDB(B1, 0, 1); PG8_SCHED; PG8_LDA(At, 0, 0); PG8_STAGE(PG8_SA(1, 1), a1 + hstepA, vC1);
            PG8_WAIT_V(8); PG8_WAIT_L(0); PG8_BAR; PG8_MMA(0, 0, At, B0); PG8_MMA(0, 1, At, B1); PG8_BAR; PG8_SCHED;
            PG8_LDA(At, 0, 1); PG8_STAGE(PG8_SB(0, 0), b2, voffB); PG8_STAGE(PG8_SB(0, 1), b2 + hstep, voffB); PG8_STAGE(PG8_SA(0, 0), a2, w0);
            PG8_WAIT_V(8); PG8_WAIT_L(0); PG8_BAR; PG8_MMA(1, 0, At, B0); PG8_MMA(1, 1, At, B1); PG8_BAR; PG8_SCHED;
            PG8_LDB(B0, 1, 0); PG8_LDB(B1, 1, 1); PG8_SCHED; PG8_LDA(At, 1, 0); PG8_STAGE(PG8_SA(0, 1), a2 + hstepA, w1);
            PG8_WAIT_V(8); PG8_WAIT_L(0); PG8_BAR; PG8_MMA(0, 0, At, B0); PG8_MMA(0, 1, At, B1); PG8_BAR; PG8_SCHED;
            PG8_LDA(At, 1, 1); PG8_STAGE(PG8_SB(1, 0), b3, voffB); PG8_STAGE(PG8_SB(1, 1), b3 + hstep, voffB); PG8_STAGE(PG8_SA(1, 0), a3, w0);
            PG8_WAIT_V(8); PG8_WAIT_L(0); PG8_BAR; PG8_MMA(1, 0, At, B0); PG8_MMA(1, 1, At, B1); PG8_BAR; PG8_SCHED;
            } else {
            PG8_LDB(B0, 0, 0); PG8_SCHED; PG8_LDA(At, 0, 0); PG8_STAGE(PG8_SA(1, 1), a1 + hstep, voffA);
            PG8_WAIT_L(8); PG8_BAR; PG8_WAIT_L(0); PG8_MMA(0, 0, At, B0); PG8_BAR; PG8_SCHED;
            PG8_LDB(B1, 0, 1); PG8_STAGE(PG8_SB(0, 0), b2, voffB);
            PG8_BAR; PG8_WAIT_L(0); PG8_MMA(0, 1, At, B1); PG8_BAR;
            PG8_LDA(At, 0, 1); PG8_STAGE(PG8_SA(0, 0), a2, voffA);
            PG8_BAR; PG8_WAIT_L(0); PG8_MMA(1, 0, At, B0); PG8_BAR; PG8_SCHED;
            PG8_STAGE(PG8_SB(0, 1), b2 + hstep, voffB);
            PG8_WAIT_V(6); PG8_BAR; PG8_MMA(1, 1, At, B1); PG8_BAR;
            PG8_LDB(B0, 1, 0); PG8_SCHED; PG8_LDA(At, 1, 0); PG8_STAGE(PG8_SA(0, 1), a2 + hstep, voffA);
            PG8_WAIT_L(8); PG8_BAR; PG8_WAIT_L(0); PG8_MMA(0, 0, At, B0); PG8_BAR; PG8_SCHED;
            PG8_LDB(B1, 1, 1); PG8_STAGE(PG8_SB(1, 0), b3, voffB);
            PG8_BAR; PG8_WAIT_L(0); PG8_MMA(0, 1, At, B1); PG8_BAR;
            PG8_LDA(At, 1, 1); PG8_STAGE(PG8_SA(1, 0), a3, voffA);
            PG8_BAR; PG8_WAIT_L(0); PG8_MMA(1, 0, At, B0); PG8_BAR; PG8_SCHED;
            PG8_STAGE(PG8_SB(1, 1), b3 + hstep, voffB);
            PG8_WAIT_V(6); PG8_BAR; PG8_MMA(1, 1, At, B1); PG8_BAR;
            }
        }
        if constexpr (ALIGN_EPI) { if (wr == 0) PG8_BAR; }
        if constexpr (!Epi::AFTER_DRAIN) { int ln2; asm volatile("v_mbcnt_lo_u32_b32 %0, -1, 0\n\tv_mbcnt_hi_u32_b32 %0, -1, %0" : "=v"(ln2)); const int fr2 = ln2 & 15, fq2 = ln2 >> 4; E(acc, cur, wr, wc, fr2, fq2); S.done(cur); }
        if (!has_next) break;
#pragma unroll
        for (int a = 0; a < 2; ++a)
#pragma unroll
            for (int b = 0; b < 2; ++b)
#pragma unroll
                for (int m = 0; m < 4; ++m)
#pragma unroll
                    for (int n = 0; n < 2; ++n) acc[a][b][m][n] = (f32x4){0.f, 0.f, 0.f, 0.f};
        cur = nxt; cA = nA; cB = nB; ++ui;
        if constexpr (GATHER) { vC0[0] = vN0[0]; vC0[1] = vN0[1]; vC1[0] = vN1[0]; vC1[1] = vN1[1]; }
        if constexpr (ALIGN_EPI) { if (wr == 1) PG8_BAR; }
    }
    PG8_WAIT_V(0);
    if constexpr (!ALIGN_EPI) { if (wr == 0) PG8_BAR; }
    PG8_BAR;
    if constexpr (Epi::AFTER_DRAIN) { E.fused(acc, cur, wr, wc, fr, fq, lds, wid, lane); S.done(cur); }
#undef PG8_SA
#undef PG8_SB
#undef PG8_STAGE
#undef PG8_LDA
#undef PG8_LDB
#undef PG8_MMA
#undef PG8_WAIT_V
#undef PG8_WAIT_L
#undef PG8_BAR
#undef PG8_SCHED
}
}

namespace att {
typedef unsigned short bf16_t;
typedef short bf16x8 __attribute__((ext_vector_type(8)));
typedef short s16x4 __attribute__((ext_vector_type(4)));
typedef float f32x16 __attribute__((ext_vector_type(16)));
typedef unsigned u32x4 __attribute__((ext_vector_type(4)));
constexpr int NW = 8, QBLK = 32, KVBLK = 64, DQK = 96, DV = 64;
constexpr float SCALE = 0.10206207261596575f;
constexpr float THR = 8.f;
constexpr int SHM_V = KVBLK * DV * 2  , SHM_K = KVBLK * 256  ;
constexpr int NBUF = 4;
constexpr int LDS_V = 0, LDS_K = NBUF * SHM_V, LDS_WS = LDS_K + NBUF * SHM_K, LDS_BYTES = LDS_WS + NW * 64 * 4;
#define KSWZ(row, colB) ((row) * 256 + ((colB) ^ (((row) & 7) << 4)))
#define SBAR() __builtin_amdgcn_sched_barrier(0)
__device__ __forceinline__ int crow(int r, int hi) { return (r & 3) + 8 * (r >> 2) + 4 * hi; }
__device__ __forceinline__ unsigned cvtpk(float lo, float hi) { unsigned r; asm volatile("v_cvt_pk_bf16_f32 %0, %1, %2" : "=v"(r) : "v"(lo), "v"(hi)); return r; }
template <bool FIRST> __device__ __forceinline__ void partialSM(f32x16& p0, f32x16& p1, float& m_reg, f32x16& negm, float& alpha) {
  constexpr float THRL = THR * 1.4426950408889634f;
  float pmax = p0[0];
#pragma unroll
  for (int r = 1; r < 16; ++r) pmax = fmaxf(pmax, p0[r]);
#pragma unroll
  for (int r = 0; r < 16; ++r) pmax = fmaxf(pmax, p1[r]);
  { auto rr = __builtin_amdgcn_permlane32_swap(__float_as_uint(pmax), __float_as_uint(pmax), false, false);
    pmax = fmaxf(__uint_as_float(rr[0]), __uint_as_float(rr[1])); }
  if (!FIRST && __builtin_expect(__all(pmax <= THRL), 1)) { alpha = 1.f; }
  else { const float delta = FIRST ? pmax : fmaxf(pmax, 0.f); alpha = FIRST ? 1.f : __builtin_amdgcn_exp2f(-delta); m_reg += delta;
#pragma unroll
    for (int r = 0; r < 16; ++r) { negm[r] -= delta; p0[r] -= delta; p1[r] -= delta; } }
#pragma unroll
  for (int r = 0; r < 16; ++r) p0[r] = __builtin_amdgcn_exp2f(p0[r]);
}
__device__ __forceinline__ void finishSM(f32x16& p0, f32x16& p1, bf16x8& pa0, bf16x8& pa1, bf16x8& pa2, bf16x8& pa3) {
#pragma unroll
  for (int r = 0; r < 16; ++r) p1[r] = __builtin_amdgcn_exp2f(p1[r]);
#define PK4(P, BASE, OUT) do { unsigned a0 = cvtpk(P[BASE + 0], P[BASE + 1]), a1 = cvtpk(P[BASE + 2], P[BASE + 3]);   \
    unsigned b0 = cvtpk(P[BASE + 4], P[BASE + 5]), b1 = cvtpk(P[BASE + 6], P[BASE + 7]);                              \
    auto r0 = __builtin_amdgcn_permlane32_swap(a0, b0, false, false); auto r1 = __builtin_amdgcn_permlane32_swap(a1, b1, false, false); \
    u32x4 w = {r0[0], r1[0], r0[1], r1[1]}; OUT = *reinterpret_cast<bf16x8*>(&w); } while (0)
  PK4(p0, 0, pa0); PK4(p0, 8, pa1); PK4(p1, 0, pa2); PK4(p1, 8, pa3);
#undef PK4
}
template <int OFF> __device__ __forceinline__ bf16x8 krd(int addr) { bf16x8 r; asm volatile("ds_read_b128 %0, %1 offset:%2" : "=&v"(r) : "v"(addr), "i"(OFF) : "memory"); return r; }
template <int KOFF> __device__ __forceinline__ void qkt(f32x16& p0, f32x16& p1, const int (&ka)[6], const bf16x8* qr, const f32x16& negm) {
#define KA(d0) krd<KOFF>(ka[d0])
#define KB(d0) krd<KOFF + 8192>(ka[d0])
  const bf16x8 a0 = KA(0), b0 = KB(0), a1 = KA(1), b1 = KB(1), a2 = KA(2), b2 = KB(2);
  asm volatile("s_waitcnt lgkmcnt(4)" ::: "memory"); SBAR();
  p0 = __builtin_amdgcn_mfma_f32_32x32x16_bf16(a0, qr[0], negm, 0, 0, 0); p1 = __builtin_amdgcn_mfma_f32_32x32x16_bf16(b0, qr[0], negm, 0, 0, 0);
  const bf16x8 a3 = KA(3), b3 = KB(3);
  asm volatile("s_waitcnt lgkmcnt(4)" ::: "memory"); SBAR();
  p0 = __builtin_amdgcn_mfma_f32_32x32x16_bf16(a1, qr[1], p0, 0, 0, 0); p1 = __builtin_amdgcn_mfma_f32_32x32x16_bf16(b1, qr[1], p1, 0, 0, 0);
  const bf16x8 a4 = KA(4), b4 = KB(4);
  asm volatile("s_waitcnt lgkmcnt(4)" ::: "memory"); SBAR();
  p0 = __builtin_amdgcn_mfma_f32_32x32x16_bf16(a2, qr[2], p0, 0, 0, 0); p1 = __builtin_amdgcn_mfma_f32_32x32x16_bf16(b2, qr[2], p1, 0, 0, 0);
  const bf16x8 a5 = KA(5), b5 = KB(5);
  asm volatile("s_waitcnt lgkmcnt(4)" ::: "memory"); SBAR();
  p0 = __builtin_amdgcn_mfma_f32_32x32x16_bf16(a3, qr[3], p0, 0, 0, 0); p1 = __builtin_amdgcn_mfma_f32_32x32x16_bf16(b3, qr[3], p1, 0, 0, 0);
  asm volatile("s_waitcnt lgkmcnt(2)" ::: "memory"); SBAR();
  p0 = __builtin_amdgcn_mfma_f32_32x32x16_bf16(a4, qr[4], p0, 0, 0, 0); p1 = __builtin_amdgcn_mfma_f32_32x32x16_bf16(b4, qr[4], p1, 0, 0, 0);
  asm volatile("s_waitcnt lgkmcnt(0)" ::: "memory"); SBAR();
  p0 = __builtin_amdgcn_mfma_f32_32x32x16_bf16(a5, qr[5], p0, 0, 0, 0); p1 = __builtin_amdgcn_mfma_f32_32x32x16_bf16(b5, qr[5], p1, 0, 0, 0);
#undef KA
#undef KB
}
template <int KOFF> __device__ __forceinline__ void kpre(const int (&ka)[6], bf16x8 (&kf)[6]) {
  kf[0] = krd<KOFF>(ka[0]); kf[1] = krd<KOFF + 8192>(ka[0]); kf[2] = krd<KOFF>(ka[1]); kf[3] = krd<KOFF + 8192>(ka[1]); kf[4] = krd<KOFF>(ka[2]); kf[5] = krd<KOFF + 8192>(ka[2]); }
template <int KOFF> __device__ __forceinline__ void qkt_pre(f32x16& p0, f32x16& p1, const int (&ka)[6], const bf16x8* qr, const f32x16& negm, const bf16x8 (&kf)[6]) {
#define KA(d0) krd<KOFF>(ka[d0])
#define KB(d0) krd<KOFF + 8192>(ka[d0])
  const bf16x8 a3 = KA(3), b3 = KB(3), a4 = KA(4), b4 = KB(4);
  p0 = __builtin_amdgcn_mfma_f32_32x32x16_bf16(kf[0], qr[0], negm, 0, 0, 0); p1 = __builtin_amdgcn_mfma_f32_32x32x16_bf16(kf[1], qr[0], negm, 0, 0, 0);
  const bf16x8 a5 = KA(5), b5 = KB(5); SBAR();
  p0 = __builtin_amdgcn_mfma_f32_32x32x16_bf16(kf[2], qr[1], p0, 0, 0, 0); p1 = __builtin_amdgcn_mfma_f32_32x32x16_bf16(kf[3], qr[1], p1, 0, 0, 0);
  p0 = __builtin_amdgcn_mfma_f32_32x32x16_bf16(kf[4], qr[2], p0, 0, 0, 0); p1 = __builtin_amdgcn_mfma_f32_32x32x16_bf16(kf[5], qr[2], p1, 0, 0, 0);
  asm volatile("s_waitcnt lgkmcnt(4)" ::: "memory"); SBAR();
  p0 = __builtin_amdgcn_mfma_f32_32x32x16_bf16(a3, qr[3], p0, 0, 0, 0); p1 = __builtin_amdgcn_mfma_f32_32x32x16_bf16(b3, qr[3], p1, 0, 0, 0);
  asm volatile("s_waitcnt lgkmcnt(2)" ::: "memory"); SBAR();
  p0 = __builtin_amdgcn_mfma_f32_32x32x16_bf16(a4, qr[4], p0, 0, 0, 0); p1 = __builtin_amdgcn_mfma_f32_32x32x16_bf16(b4, qr[4], p1, 0, 0, 0);
  asm volatile("s_waitcnt lgkmcnt(0)" ::: "memory"); SBAR();
  p0 = __builtin_amdgcn_mfma_f32_32x32x16_bf16(a5, qr[5], p0, 0, 0, 0); p1 = __builtin_amdgcn_mfma_f32_32x32x16_bf16(b5, qr[5], p1, 0, 0, 0);
#undef KA
#undef KB
}
template <int KOFF> __device__ __forceinline__ void qkt_fin(f32x16& p0, f32x16& p1, const int (&ka)[6], const bf16x8* qr, const f32x16& negm, f32x16& q0, f32x16& q1, bf16x8& pa0, bf16x8& pa1, bf16x8& pa2, bf16x8& pa3) {
#define KA(d0) krd<KOFF>(ka[d0])
#define KB(d0) krd<KOFF + 8192>(ka[d0])
#define PK4(P, BASE, OUT) do { unsigned a0_ = cvtpk(P[BASE + 0], P[BASE + 1]), a1_ = cvtpk(P[BASE + 2], P[BASE + 3]);   \
    unsigned b0_ = cvtpk(P[BASE + 4], P[BASE + 5]), b1_ = cvtpk(P[BASE + 6], P[BASE + 7]);                              \
    auto r0_ = __builtin_amdgcn_permlane32_swap(a0_, b0_, false, false); auto r1_ = __builtin_amdgcn_permlane32_swap(a1_, b1_, false, false); \
    u32x4 w_ = {r0_[0], r1_[0], r0_[1], r1_[1]}; OUT = *reinterpret_cast<bf16x8*>(&w_); } while (0)
#define EX(i) q1[i] = __builtin_amdgcn_exp2f(q1[i])
  const bf16x8 a0 = KA(0), b0 = KB(0), a1 = KA(1), b1 = KB(1), a2 = KA(2), b2 = KB(2);
  asm volatile("s_waitcnt lgkmcnt(4)" ::: "memory"); SBAR();
  p0 = __builtin_amdgcn_mfma_f32_32x32x16_bf16(a0, qr[0], negm, 0, 0, 0); p1 = __builtin_amdgcn_mfma_f32_32x32x16_bf16(b0, qr[0], negm, 0, 0, 0);
  PK4(q0, 0, pa0); EX(0); EX(1);
  const bf16x8 a3 = KA(3), b3 = KB(3);
  asm volatile("s_waitcnt lgkmcnt(4)" ::: "memory"); SBAR();
  p0 = __builtin_amdgcn_mfma_f32_32x32x16_bf16(a1, qr[1], p0, 0, 0, 0); p1 = __builtin_amdgcn_mfma_f32_32x32x16_bf16(b1, qr[1], p1, 0, 0, 0);
  PK4(q0, 8, pa1); EX(2); EX(3);
  const bf16x8 a4 = KA(4), b4 = KB(4);
  asm volatile("s_waitcnt lgkmcnt(4)" ::: "memory"); SBAR();
  p0 = __builtin_amdgcn_mfma_f32_32x32x16_bf16(a2, qr[2], p0, 0, 0, 0); p1 = __builtin_amdgcn_mfma_f32_32x32x16_bf16(b2, qr[2], p1, 0, 0, 0);
  EX(4); EX(5); EX(6); EX(7);
  const bf16x8 a5 = KA(5), b5 = KB(5);
  asm volatile("s_waitcnt lgkmcnt(4)" ::: "memory"); SBAR();
  p0 = __builtin_amdgcn_mfma_f32_32x32x16_bf16(a3, qr[3], p0, 0, 0, 0); p1 = __builtin_amdgcn_mfma_f32_32x32x16_bf16(b3, qr[3], p1, 0, 0, 0);
  EX(8); EX(9); EX(10); EX(11);
  asm volatile("s_waitcnt lgkmcnt(2)" ::: "memory"); SBAR();
  p0 = __builtin_amdgcn_mfma_f32_32x32x16_bf16(a4, qr[4], p0, 0, 0, 0); p1 = __builtin_amdgcn_mfma_f32_32x32x16_bf16(b4, qr[4], p1, 0, 0, 0);
  EX(12); EX(13); EX(14); EX(15);
  asm volatile("s_waitcnt lgkmcnt(0)" ::: "memory"); SBAR();
  p0 = __builtin_amdgcn_mfma_f32_32x32x16_bf16(a5, qr[5], p0, 0, 0, 0); p1 = __builtin_amdgcn_mfma_f32_32x32x16_bf16(b5, qr[5], p1, 0, 0, 0);
  PK4(q1, 0, pa2); PK4(q1, 8, pa3);
#undef EX
#undef PK4
#undef KA
#undef KB
}
__device__ __forceinline__ int v_st(int k, int c) { const int kk = (k & ~0xC) | ((k & 4) << 1) | ((k & 8) >> 1); return ((kk >> 3) * 2 + (c >> 5)) * 512 + ((kk & 7) * 32 + (c & 31)) * 2; }
__device__ __forceinline__ int v_rd_base(int lane) { return ((lane & 3) << 3) | (((lane >> 2) & 3) << 6) | (((lane >> 4) & 1) << 5) | (((lane >> 5) & 1) << 8); }
constexpr int v_rd_off(int d0, int ks, int half) { return d0 * 512 + ks * 2048 + half * 1024; }
template <int OFF> __device__ __forceinline__ s16x4 tr_read(int vb) {
  s16x4 r; asm volatile("ds_read_b64_tr_b16 %0, %1 offset:%2" : "=&v"(r) : "v"(vb), "i"(OFF) : "memory"); return r; }
template <int VOFF, bool SPLIT> __device__ __forceinline__ void pv_d0(f32x16* o, int vb, bf16x8 pa0, bf16x8 pa1, bf16x8 pa2, bf16x8 pa3) {
#define PK(L, H) (bf16x8){L[0], L[1], L[2], L[3], H[0], H[1], H[2], H[3]}
  if constexpr (SPLIT) {
    const bf16x8 ones = {0x3F80, 0x3F80, 0x3F80, 0x3F80, 0x3F80, 0x3F80, 0x3F80, 0x3F80};
    { const s16x4 l0 = tr_read<VOFF + v_rd_off(0, 0, 0)>(vb), h0 = tr_read<VOFF + v_rd_off(0, 0, 1)>(vb), m0 = tr_read<VOFF + v_rd_off(1, 0, 0)>(vb), g0 = tr_read<VOFF + v_rd_off(1, 0, 1)>(vb);
      const s16x4 l1 = tr_read<VOFF + v_rd_off(0, 1, 0)>(vb), h1 = tr_read<VOFF + v_rd_off(0, 1, 1)>(vb), m1 = tr_read<VOFF + v_rd_off(1, 1, 0)>(vb), g1 = tr_read<VOFF + v_rd_off(1, 1, 1)>(vb);
      asm volatile("s_waitcnt lgkmcnt(4)" ::: "memory"); SBAR();
      o[0] = __builtin_amdgcn_mfma_f32_32x32x16_bf16(pa0, PK(l0, h0), o[0], 0, 0, 0); o[1] = __builtin_amdgcn_mfma_f32_32x32x16_bf16(pa0, PK(m0, g0), o[1], 0, 0, 0);
      asm volatile("s_waitcnt lgkmcnt(0)" ::: "memory"); SBAR();
      o[0] = __builtin_amdgcn_mfma_f32_32x32x16_bf16(pa1, PK(l1, h1), o[0], 0, 0, 0); o[1] = __builtin_amdgcn_mfma_f32_32x32x16_bf16(pa1, PK(m1, g1), o[1], 0, 0, 0); SBAR(); }
    { const s16x4 l2 = tr_read<VOFF + v_rd_off(0, 2, 0)>(vb), h2 = tr_read<VOFF + v_rd_off(0, 2, 1)>(vb), m2 = tr_read<VOFF + v_rd_off(1, 2, 0)>(vb), g2 = tr_read<VOFF + v_rd_off(1, 2, 1)>(vb);
      const s16x4 l3 = tr_read<VOFF + v_rd_off(0, 3, 0)>(vb), h3 = tr_read<VOFF + v_rd_off(0, 3, 1)>(vb), m3 = tr_read<VOFF + v_rd_off(1, 3, 0)>(vb), g3 = tr_read<VOFF + v_rd_off(1, 3, 1)>(vb);
      o[2] = __builtin_amdgcn_mfma_f32_32x32x16_bf16(pa0, ones, o[2], 0, 0, 0); o[2] = __builtin_amdgcn_mfma_f32_32x32x16_bf16(pa1, ones, o[2], 0, 0, 0);
      o[2] = __builtin_amdgcn_mfma_f32_32x32x16_bf16(pa2, ones, o[2], 0, 0, 0); o[2] = __builtin_amdgcn_mfma_f32_32x32x16_bf16(pa3, ones, o[2], 0, 0, 0);
      asm volatile("s_waitcnt lgkmcnt(4)" ::: "memory"); SBAR();
      o[0] = __builtin_amdgcn_mfma_f32_32x32x16_bf16(pa2, PK(l2, h2), o[0], 0, 0, 0); o[1] = __builtin_amdgcn_mfma_f32_32x32x16_bf16(pa2, PK(m2, g2), o[1], 0, 0, 0);
      asm volatile("s_waitcnt lgkmcnt(0)" ::: "memory"); SBAR();
      o[0] = __builtin_amdgcn_mfma_f32_32x32x16_bf16(pa3, PK(l3, h3), o[0], 0, 0, 0); o[1] = __builtin_amdgcn_mfma_f32_32x32x16_bf16(pa3, PK(m3, g3), o[1], 0, 0, 0); }
  } else {

  const s16x4 l0 = tr_read<VOFF + v_rd_off(0, 0, 0)>(vb), h0 = tr_read<VOFF + v_rd_off(0, 0, 1)>(vb), m0 = tr_read<VOFF + v_rd_off(1, 0, 0)>(vb), g0 = tr_read<VOFF + v_rd_off(1, 0, 1)>(vb);
  const s16x4 l1 = tr_read<VOFF + v_rd_off(0, 1, 0)>(vb), h1 = tr_read<VOFF + v_rd_off(0, 1, 1)>(vb), m1 = tr_read<VOFF + v_rd_off(1, 1, 0)>(vb), g1 = tr_read<VOFF + v_rd_off(1, 1, 1)>(vb);
  const s16x4 l2 = tr_read<VOFF + v_rd_off(0, 2, 0)>(vb), h2 = tr_read<VOFF + v_rd_off(0, 2, 1)>(vb), m2 = tr_read<VOFF + v_rd_off(1, 2, 0)>(vb), g2 = tr_read<VOFF + v_rd_off(1, 2, 1)>(vb);
  const s16x4 l3 = tr_read<VOFF + v_rd_off(0, 3, 0)>(vb), h3 = tr_read<VOFF + v_rd_off(0, 3, 1)>(vb), m3 = tr_read<VOFF + v_rd_off(1, 3, 0)>(vb), g3 = tr_read<VOFF + v_rd_off(1, 3, 1)>(vb);
  asm volatile("s_waitcnt lgkmcnt(12)" ::: "memory"); SBAR();
  o[0] = __builtin_amdgcn_mfma_f32_32x32x16_bf16(pa0, PK(l0, h0), o[0], 0, 0, 0); o[1] = __builtin_amdgcn_mfma_f32_32x32x16_bf16(pa0, PK(m0, g0), o[1], 0, 0, 0);
  asm volatile("s_waitcnt lgkmcnt(8)" ::: "memory"); SBAR();
  o[0] = __builtin_amdgcn_mfma_f32_32x32x16_bf16(pa1, PK(l1, h1), o[0], 0, 0, 0); o[1] = __builtin_amdgcn_mfma_f32_32x32x16_bf16(pa1, PK(m1, g1), o[1], 0, 0, 0);
  asm volatile("s_waitcnt lgkmcnt(4)" ::: "memory"); SBAR();
  o[0] = __builtin_amdgcn_mfma_f32_32x32x16_bf16(pa2, PK(l2, h2), o[0], 0, 0, 0); o[1] = __builtin_amdgcn_mfma_f32_32x32x16_bf16(pa2, PK(m2, g2), o[1], 0, 0, 0);
  asm volatile("s_waitcnt lgkmcnt(0)" ::: "memory"); SBAR();
  o[0] = __builtin_amdgcn_mfma_f32_32x32x16_bf16(pa3, PK(l3, h3), o[0], 0, 0, 0); o[1] = __builtin_amdgcn_mfma_f32_32x32x16_bf16(pa3, PK(m3, g3), o[1], 0, 0, 0);
  { const bf16x8 ones = {0x3F80, 0x3F80, 0x3F80, 0x3F80, 0x3F80, 0x3F80, 0x3F80, 0x3F80};
    o[2] = __builtin_amdgcn_mfma_f32_32x32x16_bf16(pa0, ones, o[2], 0, 0, 0); o[2] = __builtin_amdgcn_mfma_f32_32x32x16_bf16(pa1, ones, o[2], 0, 0, 0);
    o[2] = __builtin_amdgcn_mfma_f32_32x32x16_bf16(pa2, ones, o[2], 0, 0, 0); o[2] = __builtin_amdgcn_mfma_f32_32x32x16_bf16(pa3, ones, o[2], 0, 0, 0); }
  }
#undef PK
}
template <int KOFF, int VOFF> __device__ __forceinline__ void m_phase(f32x16& p0, f32x16& p1, const int (&ka)[6], const bf16x8* qr, const f32x16& negm, const bf16x8 (&kf)[6], f32x16* o, int vb, bf16x8 pa0, bf16x8 pa1, bf16x8 pa2, bf16x8 pa3) {
#define KA(d0) krd<KOFF>(ka[d0])
#define KB(d0) krd<KOFF + 8192>(ka[d0])
#define PK(L, H) (bf16x8){L[0], L[1], L[2], L[3], H[0], H[1], H[2], H[3]}
  const bf16x8 a3 = KA(3), b3 = KB(3), a4 = KA(4), b4 = KB(4);
  p0 = __builtin_amdgcn_mfma_f32_32x32x16_bf16(kf[0], qr[0], negm, 0, 0, 0); p1 = __builtin_amdgcn_mfma_f32_32x32x16_bf16(kf[1], qr[0], negm, 0, 0, 0);
  const bf16x8 a5 = KA(5), b5 = KB(5); SBAR();
  p0 = __builtin_amdgcn_mfma_f32_32x32x16_bf16(kf[2], qr[1], p0, 0, 0, 0); p1 = __builtin_amdgcn_mfma_f32_32x32x16_bf16(kf[3], qr[1], p1, 0, 0, 0);
  p0 = __builtin_amdgcn_mfma_f32_32x32x16_bf16(kf[4], qr[2], p0, 0, 0, 0); p1 = __builtin_amdgcn_mfma_f32_32x32x16_bf16(kf[5], qr[2], p1, 0, 0, 0);
  asm volatile("s_waitcnt lgkmcnt(4)" ::: "memory"); SBAR();
  p0 = __builtin_amdgcn_mfma_f32_32x32x16_bf16(a3, qr[3], p0, 0, 0, 0); p1 = __builtin_amdgcn_mfma_f32_32x32x16_bf16(b3, qr[3], p1, 0, 0, 0);
  const s16x4 l0 = tr_read<VOFF + v_rd_off(0, 0, 0)>(vb), h0 = tr_read<VOFF + v_rd_off(0, 0, 1)>(vb), m0 = tr_read<VOFF + v_rd_off(1, 0, 0)>(vb), g0 = tr_read<VOFF + v_rd_off(1, 0, 1)>(vb);
  const s16x4 l1 = tr_read<VOFF + v_rd_off(0, 1, 0)>(vb), h1 = tr_read<VOFF + v_rd_off(0, 1, 1)>(vb);
  asm volatile("s_waitcnt lgkmcnt(8)" ::: "memory"); SBAR();
  p0 = __builtin_amdgcn_mfma_f32_32x32x16_bf16(a4, qr[4], p0, 0, 0, 0); p1 = __builtin_amdgcn_mfma_f32_32x32x16_bf16(b4, qr[4], p1, 0, 0, 0);
  const s16x4 m1 = tr_read<VOFF + v_rd_off(1, 1, 0)>(vb), g1 = tr_read<VOFF + v_rd_off(1, 1, 1)>(vb);
  const s16x4 l2 = tr_read<VOFF + v_rd_off(0, 2, 0)>(vb), h2 = tr_read<VOFF + v_rd_off(0, 2, 1)>(vb), m2 = tr_read<VOFF + v_rd_off(1, 2, 0)>(vb), g2 = tr_read<VOFF + v_rd_off(1, 2, 1)>(vb);
  asm volatile("s_waitcnt lgkmcnt(12)" ::: "memory"); SBAR();
  p0 = __builtin_amdgcn_mfma_f32_32x32x16_bf16(a5, qr[5], p0, 0, 0, 0); p1 = __builtin_amdgcn_mfma_f32_32x32x16_bf16(b5, qr[5], p1, 0, 0, 0);
  asm volatile("s_waitcnt lgkmcnt(8)" ::: "memory"); SBAR();
  o[0] = __builtin_amdgcn_mfma_f32_32x32x16_bf16(pa0, PK(l0, h0), o[0], 0, 0, 0); o[1] = __builtin_amdgcn_mfma_f32_32x32x16_bf16(pa0, PK(m0, g0), o[1], 0, 0, 0);
  const s16x4 l3 = tr_read<VOFF + v_rd_off(0, 3, 0)>(vb), h3 = tr_read<VOFF + v_rd_off(0, 3, 1)>(vb), m3 = tr_read<VOFF + v_rd_off(1, 3, 0)>(vb), g3 = tr_read<VOFF + v_rd_off(1, 3, 1)>(vb);
  asm volatile("s_waitcnt lgkmcnt(8)" ::: "memory"); SBAR();
  o[0] = __builtin_amdgcn_mfma_f32_32x32x16_bf16(pa1, PK(l1, h1), o[0], 0, 0, 0); o[1] = __builtin_amdgcn_mfma_f32_32x32x16_bf16(pa1, PK(m1, g1), o[1], 0, 0, 0);
  asm volatile("s_waitcnt lgkmcnt(4)" ::: "memory"); SBAR();
  o[0] = __builtin_amdgcn_mfma_f32_32x32x16_bf16(pa2, PK(l2, h2), o[0], 0, 0, 0); o[1] = __builtin_amdgcn_mfma_f32_32x32x16_bf16(pa2, PK(m2, g2), o[1], 0, 0, 0);
  asm volatile("s_waitcnt lgkmcnt(0)" ::: "memory"); SBAR();
  o[0] = __builtin_amdgcn_mfma_f32_32x32x16_bf16(pa3, PK(l3, h3), o[0], 0, 0, 0); o[1] = __builtin_amdgcn_mfma_f32_32x32x16_bf16(pa3, PK(m3, g3), o[1], 0, 0, 0);
  { const bf16x8 ones = {0x3F80, 0x3F80, 0x3F80, 0x3F80, 0x3F80, 0x3F80, 0x3F80, 0x3F80};
    o[2] = __builtin_amdgcn_mfma_f32_32x32x16_bf16(pa0, ones, o[2], 0, 0, 0); o[2] = __builtin_amdgcn_mfma_f32_32x32x16_bf16(pa1, ones, o[2], 0, 0, 0);
    o[2] = __builtin_amdgcn_mfma_f32_32x32x16_bf16(pa2, ones, o[2], 0, 0, 0); o[2] = __builtin_amdgcn_mfma_f32_32x32x16_bf16(pa3, ones, o[2], 0, 0, 0); }
#undef PK
#undef KA
#undef KB
}
__device__ __forceinline__ unsigned short f2bf(float f) { unsigned u = __float_as_uint(f); return (unsigned short)((u + 0x7fffu + ((u >> 16) & 1u)) >> 16); }

struct NoHook { static constexpr bool ACTIVE = false; __device__ __forceinline__ void issue(int) {} __device__ __forceinline__ void finish() {} };
template <class HK> __device__ __forceinline__ void attn_unit(const bf16_t* __restrict__ Qb, const bf16_t* __restrict__ Kh, const bf16_t* __restrict__ Vh, bf16_t* __restrict__ Ob, int opitch, int seq, LAS char* lds, int tid_in, HK& hk) {
  int tid_ = tid_in; asm volatile("" : "+v"(tid_));
  const int tid = tid_, wid = tid >> 6, lane = tid & 63, r32 = lane & 31, hi = lane >> 5;
  LAS char* V_lds = lds + LDS_V; LAS char* K_lds = lds + LDS_K;
  LAS float* ws = (LAS float*)(lds + LDS_WS) + wid * 64; LAS float* li_l = ws; LAS float* al_l = ws + 32;
  float m_reg = 0.f; f32x16 o[3] = {}; f32x16 negm = {}; bf16x8 qr[6];
  const bf16_t* Qw = Qb + (size_t)(wid * QBLK + r32) * DQK + hi * 8;
#pragma unroll
  for (int d0 = 0; d0 < 6; ++d0) qr[d0] = *(const bf16x8*)(Qw + d0 * 16);
  const int vr = tid >> 3, vc = (tid & 7) * 8, vst = v_st(vr, vc);
  const int c1 = (tid + 512) % 768, kr0 = tid / 12, kc0 = (tid % 12) * 8, kr1 = c1 / 12, kc1 = (c1 % 12) * 8;
  const int kst0 = KSWZ(kr0, kc0 * 2), kst1 = KSWZ(kr1, kc1 * 2);
  const int vb0 = (int)(uintptr_t)V_lds + v_rd_base(lane);
  int ka[6];
#pragma unroll
  for (int d0 = 0; d0 < 6; ++d0) ka[d0] = (int)(uintptr_t)K_lds + r32 * 256 + ((d0 * 32 + hi * 16) ^ ((r32 & 7) << 4));
  bf16x8 sv0, sk00, sk01, sv1, sk10, sk11;
#define SLOAD0(k0) do { sv0 = *(const bf16x8*)(Vh + (size_t)((k0) + vr) * DV + vc); sk00 = *(const bf16x8*)(Kh + (size_t)((k0) + kr0) * DQK + kc0); sk01 = *(const bf16x8*)(Kh + (size_t)((k0) + kr1) * DQK + kc1); } while (0)
#define SLOAD1(k0) do { sv1 = *(const bf16x8*)(Vh + (size_t)((k0) + vr) * DV + vc); sk10 = *(const bf16x8*)(Kh + (size_t)((k0) + kr0) * DQK + kc0); sk11 = *(const bf16x8*)(Kh + (size_t)((k0) + kr1) * DQK + kc1); } while (0)
#define SWRITE0(b) do { *(LAS bf16x8*)(V_lds + (b) * SHM_V + vst) = sv0; *(LAS bf16x8*)(K_lds + (b) * SHM_K + kst0) = sk00; *(LAS bf16x8*)(K_lds + (b) * SHM_K + kst1) = sk01; } while (0)
#define SWRITE1(b) do { *(LAS bf16x8*)(V_lds + (b) * SHM_V + vst) = sv1; *(LAS bf16x8*)(K_lds + (b) * SHM_K + kst0) = sk10; *(LAS bf16x8*)(K_lds + (b) * SHM_K + kst1) = sk11; } while (0)
#define SWAIT() asm volatile("s_waitcnt vmcnt(3)" ::: "memory")
#define SWAITH(n) do { if constexpr (HK::ACTIVE) asm volatile("s_waitcnt vmcnt(" #n ")" ::: "memory"); else asm volatile("s_waitcnt vmcnt(3)" ::: "memory"); } while (0)
#define RESC(a) do { if (__any((a) < 1.f)) { if (hi == 0) al_l[r32] = (a); asm volatile("s_waitcnt lgkmcnt(0)" ::: "memory"); \
    _Pragma("unroll") for (int d = 0; d < 3; ++d) _Pragma("unroll") for (int r = 0; r < 16; ++r) o[d][r] *= al_l[crow(r, hi)]; } } while (0)
  f32x16 pA0, pA1, pB0, pB1; float alA, alB; bf16x8 pa0, pa1, pa2, pa3; const int NT = seq / KVBLK;
  SLOAD0(0); asm volatile("s_waitcnt vmcnt(0)" ::: "memory"); SWRITE0(0); __syncthreads();
  qkt<0>(pA0, pA1, ka, qr, negm); partialSM<true>(pA0, pA1, m_reg, negm, alA);
  if constexpr (HK::ACTIVE) hk.issue(0);
  SLOAD1(KVBLK); if (2 < NT) SLOAD0(2 * KVBLK);
  SWAIT(); SWRITE1(1); __syncthreads();
#define ATT_STEP(j_, PC0, PC1, ALC, PP0, PP1, ALP, KB, VB, WB, LD, WR, DO_LD, DO_WR, HOOK, WN) do { \
    SBAR(); { f32x16 nm_; if constexpr (HK::ACTIVE) { _Pragma("unroll") for (int r_ = 0; r_ < 16; ++r_) nm_[r_] = -m_reg; } else nm_ = negm; qkt_fin<(KB) * SHM_K>(PC0, PC1, ka, qr, nm_, PP0, PP1, pa0, pa1, pa2, pa3); } SBAR(); \
    if constexpr (HK::ACTIVE && HOOK) hk.finish(); if (DO_LD) SLOAD##LD(((j_) + 2) * KVBLK); if constexpr (HK::ACTIVE && HOOK) hk.issue(((j_) >> 2) + 1); SBAR(); \
    pv_d0<(VB) * SHM_V, HK::ACTIVE>(o, vb0, pa0, pa1, pa2, pa3); if constexpr (HK::ACTIVE) { f32x16 dm_ = {}; partialSM<false>(PC0, PC1, m_reg, dm_, ALC); } else partialSM<false>(PC0, PC1, m_reg, negm, ALC); \
    if (DO_WR) { SWAITH(WN); SWRITE##WR(WB); } \
    RESC(ALC); __syncthreads(); } while (0)
  int j = 1;
  for (; j < NT - 3; j += 4) {
    ATT_STEP(j,     pB0, pB1, alB, pA0, pA1, alA, 1, 0, 2, 1, 0, true, true, true, 11);
    ATT_STEP(j + 1, pA0, pA1, alA, pB0, pB1, alB, 2, 1, 3, 0, 1, true, true, false, 7);
    ATT_STEP(j + 2, pB0, pB1, alB, pA0, pA1, alA, 3, 2, 0, 1, 0, true, true, false, 3);
    ATT_STEP(j + 3, pA0, pA1, alA, pB0, pB1, alB, 0, 3, 1, 0, 1, true, true, false, 3);
  }
  if constexpr (HK::ACTIVE) hk.finish();
  ATT_STEP(j,     pB0, pB1, alB, pA0, pA1, alA, 1, 0, 2, 1, 0, true, true, false, 3);
  ATT_STEP(j + 1, pA0, pA1, alA, pB0, pB1, alB, 2, 1, 3, 0, 1, false, true, false, 3);
  ATT_STEP(j + 2, pB0, pB1, alB, pA0, pA1, alA, 3, 2, 0, 1, 0, false, false, false, 3);
#undef ATT_STEP
  finishSM(pB0, pB1, pa0, pa1, pa2, pa3); SBAR();
  pv_d0<3 * SHM_V, HK::ACTIVE>(o, vb0, pa0, pa1, pa2, pa3);
  float rli[16];
#pragma unroll
  for (int r = 0; r < 16; ++r) rli[r] = __builtin_amdgcn_rcpf(o[2][r]);
  bf16_t* Ow = Ob + (size_t)(wid * QBLK) * opitch;
#pragma unroll
  for (int r = 0; r < 16; ++r) { const int orow = crow(r, hi);
#pragma unroll
    for (int d0 = 0; d0 < 2; ++d0) Ow[(size_t)orow * opitch + d0 * 32 + r32] = f2bf(o[d0][r] * rli[r]); }
  __syncthreads();
#undef SLOAD0
#undef SLOAD1
#undef SWRITE0
#undef SWRITE1
#undef SWAIT
#undef SWAITH
#undef RESC
}

constexpr int PP_CNT_OFF = 131072 + 320 + 20 * 4;
template <class HK> __device__ __forceinline__ void attn_unit_pp(const bf16_t* __restrict__ Qb, const bf16_t* __restrict__ Kh, const bf16_t* __restrict__ Vh, bf16_t* __restrict__ Ob, int opitch, int seq, LAS char* lds, int tid_in, HK&) {
  int tid_ = tid_in; asm volatile("" : "+v"(tid_));
  const int tid = tid_, wid = tid >> 6, lane = tid & 63, r32 = lane & 31, hi = lane >> 5;
  int grp; { const unsigned simd = ((unsigned)__builtin_amdgcn_s_getreg(63492) >> 4) & 3u; unsigned old_ = 0u; if (lane == 0) old_ = __hip_atomic_fetch_add((LAS unsigned*)(lds + PP_CNT_OFF) + simd, 1u, __ATOMIC_RELAXED, __HIP_MEMORY_SCOPE_WORKGROUP); grp = __builtin_amdgcn_readfirstlane(old_) & 1; }
  LAS char* V_lds = lds + LDS_V; LAS char* K_lds = lds + LDS_K;
  LAS float* ws = (LAS float*)(lds + LDS_WS) + wid * 64; LAS float* al_l = ws + 32;
  float m_reg = 0.f; f32x16 o[3] = {}; f32x16 negm = {}; bf16x8 qr[6];
  const bf16_t* Qw = Qb + (size_t)(wid * QBLK + r32) * DQK + hi * 8;
#pragma unroll
  for (int d0 = 0; d0 < 6; ++d0) qr[d0] = *(const bf16x8*)(Qw + d0 * 16);
  const int vr = tid >> 3, vc = (tid & 7) * 8, vst = v_st(vr, vc);
  const int c1 = (tid + 512) % 768, kr0 = tid / 12, kc0 = (tid % 12) * 8, kr1 = c1 / 12, kc1 = (c1 % 12) * 8;
  const int kst0 = KSWZ(kr0, kc0 * 2), kst1 = KSWZ(kr1, kc1 * 2);
  const int vb0 = (int)(uintptr_t)V_lds + v_rd_base(lane);
  int ka[6];
#pragma unroll
  for (int d0 = 0; d0 < 6; ++d0) ka[d0] = (int)(uintptr_t)K_lds + r32 * 256 + ((d0 * 32 + hi * 16) ^ ((r32 & 7) << 4));
  bf16x8 sv0, sk00, sk01, sv1, sk10, sk11;
#define SLOAD0(k0) do { sv0 = *(const bf16x8*)(Vh + (size_t)((k0) + vr) * DV + vc); sk00 = *(const bf16x8*)(Kh + (size_t)((k0) + kr0) * DQK + kc0); sk01 = *(const bf16x8*)(Kh + (size_t)((k0) + kr1) * DQK + kc1); } while (0)
#define SLOAD1(k0) do { sv1 = *(const bf16x8*)(Vh + (size_t)((k0) + vr) * DV + vc); sk10 = *(const bf16x8*)(Kh + (size_t)((k0) + kr0) * DQK + kc0); sk11 = *(const bf16x8*)(Kh + (size_t)((k0) + kr1) * DQK + kc1); } while (0)
#define SWRITE0(b) do { *(LAS bf16x8*)(V_lds + (b) * SHM_V + vst) = sv0; *(LAS bf16x8*)(K_lds + (b) * SHM_K + kst0) = sk00; *(LAS bf16x8*)(K_lds + (b) * SHM_K + kst1) = sk01; } while (0)
#define SWRITE1(b) do { *(LAS bf16x8*)(V_lds + (b) * SHM_V + vst) = sv1; *(LAS bf16x8*)(K_lds + (b) * SHM_K + kst0) = sk10; *(LAS bf16x8*)(K_lds + (b) * SHM_K + kst1) = sk11; } while (0)
#define SWAIT() asm volatile("s_waitcnt vmcnt(3)" ::: "memory")
#define RESC(a) do { if (__any((a) < 1.f)) { if (hi == 0) al_l[r32] = (a); asm volatile("s_waitcnt lgkmcnt(0)" ::: "memory"); \
    _Pragma("unroll") for (int d = 0; d < 3; ++d) _Pragma("unroll") for (int r = 0; r < 16; ++r) o[d][r] *= al_l[crow(r, hi)]; } } while (0)
#define PBAR() do { asm volatile("s_waitcnt lgkmcnt(0)" ::: "memory"); __builtin_amdgcn_s_barrier(); asm volatile("" ::: "memory"); } while (0)
  f32x16 p0, p1; float al; bf16x8 pa0, pa1, pa2, pa3; const int NT = seq / KVBLK;
  SLOAD0(0); SLOAD1(KVBLK); asm volatile("s_waitcnt vmcnt(0)" ::: "memory"); SWRITE0(0); SWRITE1(1);
  SLOAD0(2 * KVBLK); SLOAD1(3 * KVBLK);
  __syncthreads();
  bf16x8 kf[6]; kpre<0>(ka, kf);
  if (grp == 1) PBAR();
#define PP_STEP(t_, KB, VBP, WB, SL, FIRST_) do { \
    SBAR(); if (FIRST_) qkt_pre<(KB) * SHM_K>(p0, p1, ka, qr, negm, kf); else m_phase<(KB) * SHM_K, (VBP) * SHM_V>(p0, p1, ka, qr, negm, kf, o, vb0, pa0, pa1, pa2, pa3); SBAR(); \
    PBAR(); \
    partialSM<FIRST_>(p0, p1, m_reg, negm, al); if (!(FIRST_)) RESC(al); finishSM(p0, p1, pa0, pa1, pa2, pa3); SBAR(); \
    if ((t_) + 2 < NT) { SWAIT(); SWRITE##SL(WB); } SLOAD##SL(((t_) + 4 < NT ? (t_) + 4 : NT - 1) * KVBLK); \
    SBAR(); kpre<(((KB) + 1) & 3) * SHM_K>(ka, kf); \
    PBAR(); } while (0)
  PP_STEP(0, 0, 3, 2, 0, true); PP_STEP(1, 1, 0, 3, 1, false); PP_STEP(2, 2, 1, 0, 0, false); PP_STEP(3, 3, 2, 1, 1, false);
#pragma unroll 1
  for (int t = 4; t < NT; t += 4) { PP_STEP(t, 0, 3, 2, 0, false); PP_STEP(t + 1, 1, 0, 3, 1, false); PP_STEP(t + 2, 2, 1, 0, 0, false); PP_STEP(t + 3, 3, 2, 1, 1, false); }
#undef PP_STEP
  SBAR(); pv_d0<3 * SHM_V, false>(o, vb0, pa0, pa1, pa2, pa3);
  if (grp == 0) PBAR();
  float rli[16];
#pragma unroll
  for (int r = 0; r < 16; ++r) rli[r] = __builtin_amdgcn_rcpf(o[2][r]);
  bf16_t* Ow = Ob + (size_t)(wid * QBLK) * opitch;
#pragma unroll
  for (int r = 0; r < 16; ++r) { const int orow = crow(r, hi);
#pragma unroll
    for (int d0 = 0; d0 < 2; ++d0) Ow[(size_t)orow * opitch + d0 * 32 + r32] = f2bf(o[d0][r] * rli[r]); }
  __syncthreads();
#undef PBAR
#undef SLOAD0
#undef SLOAD1
#undef SWRITE0
#undef SWRITE1
#undef SWAIT
#undef RESC
}
#undef KSWZ
#undef SBAR
}

typedef unsigned short bf16_t;
typedef unsigned u32x4 __attribute__((ext_vector_type(4)));
typedef unsigned u32x2 __attribute__((ext_vector_type(2)));
typedef float f32x4 __attribute__((ext_vector_type(4)));
typedef float f32x2 __attribute__((ext_vector_type(2)));
typedef GAS unsigned gu32;
#define RLX_AGENT __ATOMIC_RELAXED, __HIP_MEMORY_SCOPE_AGENT
#define LDS_WAIT() asm volatile("s_waitcnt lgkmcnt(0)" ::: "memory")
#define VM_WAIT() asm volatile("s_waitcnt vmcnt(0)" ::: "memory")
__device__ __forceinline__ unsigned f2bf(float f) { unsigned u = __builtin_bit_cast(unsigned, f); return (u + 0x7fffu + ((u >> 16) & 1u)) >> 16; }
__device__ __forceinline__ unsigned pk2(float lo, float hi) { return f2bf(lo) | (f2bf(hi) << 16); }
__device__ __forceinline__ float bflo(unsigned u) { return __uint_as_float(u << 16); }
__device__ __forceinline__ float bfhi(unsigned u) { return __uint_as_float(u & 0xffff0000u); }
__device__ __forceinline__ float bf1(bf16_t h) { return __uint_as_float(((unsigned)h) << 16); }
__device__ __forceinline__ float sigm(float x) { return 1.0f / (1.0f + __expf(-x)); }
__device__ __forceinline__ float lane_xor(float v, int lane, int o) { return __int_as_float(__builtin_amdgcn_ds_bpermute((lane ^ o) << 2, __float_as_int(v))); }
__device__ __forceinline__ float wave_sum(float v, int lane) {
#pragma unroll
    for (int o = 1; o < 64; o <<= 1) v += lane_xor(v, lane, o);
    return v;
}
#define XB_TMO      128
#define XB_XCNT(j)  (256  + 64 * (j))
#define XB_XSUB(j)  (1280 + 64 * (j))
#define XB_XGEN(j)  (2304 + 64 * (j))
#define XB_TOP      3328
#define XB_TOPGEN   3392
#define XCD_BAR_WORDS 3456
#define XB_SPIN_CAP (1u << 18)

__device__ __forceinline__ unsigned xb_ld(unsigned* p)              { return __hip_atomic_load(p, __ATOMIC_RELAXED, __HIP_MEMORY_SCOPE_AGENT); }
__device__ __forceinline__ unsigned xb_add(unsigned* p, unsigned v) { return __hip_atomic_fetch_add(p, v, __ATOMIC_RELAXED, __HIP_MEMORY_SCOPE_AGENT); }
__device__ __forceinline__ unsigned xb_xcc_id() { return (unsigned)__builtin_amdgcn_s_getreg((3 << 11) | 20) & 0xFu; }
#define XB_SPIN(cond, bar) do { unsigned _sp = 0; while (cond) { __builtin_amdgcn_s_sleep(1); \
    if ((++_sp & 255u) == 0u) { if (xb_ld(&(bar)[XB_TMO])) break; if (_sp > XB_SPIN_CAP) { atomicAdd(&(bar)[XB_TMO], 1u); break; } } } } while (0)

struct XcdBarrier {
    unsigned* bar; unsigned x;
    volatile LAS unsigned* st;
};

__device__ __forceinline__ XcdBarrier xcd_barrier_post(unsigned* bar, volatile LAS unsigned* st) {
    XcdBarrier b; b.bar = bar; b.x = xb_xcc_id(); b.st = st;
    if (threadIdx.x == 0) (void)xb_add(&bar[XB_XCNT(b.x)], 1u);
    return b;
}
__device__ __forceinline__ void xcd_barrier_complete(unsigned* bar, unsigned x, unsigned& nloc, unsigned& nx) {
    const unsigned G = gridDim.x * gridDim.y * gridDim.z;
    unsigned sum, cnt, mine, sp = 0u;
    for (;;) {
        sum = 0u; cnt = 0u; mine = 0u;
#pragma unroll
        for (unsigned j = 0; j < 16; ++j) { const unsigned c = xb_ld(&bar[XB_XCNT(j)]); sum += c; cnt += (c > 0u) ? 1u : 0u; mine = (j == x) ? c : mine; }
        if (sum == G) break;
        __builtin_amdgcn_s_sleep(1);
        if ((++sp & 255u) == 0u) { if (xb_ld(&bar[XB_TMO])) break; if (sp > XB_SPIN_CAP) { atomicAdd(&bar[XB_TMO], 1u); break; } }
    }
    nloc = mine > 0u ? mine : 1u; nx = cnt > 0u ? cnt : 1u;
}

__device__ __forceinline__ void xcd_barrier(const XcdBarrier& b) {
    asm volatile("s_waitcnt vmcnt(0)" ::: "memory");
    __syncthreads();
    if (threadIdx.x == 0) {
        unsigned* bar = b.bar;
        __builtin_amdgcn_s_waitcnt(0);
        unsigned nloc = b.st[0], nx = b.st[1];
        if (nloc == 0u) { xcd_barrier_complete(bar, b.x, nloc, nx); b.st[0] = nloc; b.st[1] = nx; }
        const unsigned old = xb_add(&bar[XB_XSUB(b.x)], 1u);
        const unsigned gen = old / nloc;
        if (old + 1u == (gen + 1u) * nloc) {
            __builtin_amdgcn_fence(__ATOMIC_RELEASE, "agent");
            asm volatile("s_waitcnt vmcnt(0)" ::: "memory");
            const unsigned og = xb_add(&bar[XB_TOP], 1u);
            const unsigned tg = og / nx;
            if (og + 1u == (tg + 1u) * nx) xb_add(&bar[XB_TOPGEN], 1u);
            else XB_SPIN(xb_ld(&bar[XB_TOPGEN]) == tg, bar);
            __builtin_amdgcn_fence(__ATOMIC_ACQUIRE, "agent");
            xb_add(&bar[XB_XGEN(b.x)], 1u);
            asm volatile("s_waitcnt vmcnt(0)" ::: "memory");
        } else {
            XB_SPIN(xb_ld(&bar[XB_XGEN(b.x)]) == gen, bar);
            __builtin_amdgcn_fence(__ATOMIC_ACQUIRE, "agent");
            asm volatile("s_waitcnt vmcnt(0)" ::: "memory");
        }
    }
    __syncthreads();
}

constexpr int NWAVES = 8;
constexpr int RING_BYTES = 131072, MISC_OFF = RING_BYTES + 320, MOETAB_OFF = RING_BYTES + 1024, LDS_BYTES = 147456;
constexpr int CW_BAR = 4096;
struct Fr {
    LAS unsigned char* lds; int tid, lane, wave, gw, NGW, G, blk;
    const float* in[25]; float* out; unsigned char* ws;
};
enum { I_X = 0, I_C, I_CTX, I_CCTX, I_WMOD, I_BMOD, I_N1G, I_N2G, I_WIN, I_GF, I_GB, I_HGG, I_QNG, I_KVNG, I_WUQ, I_WUKV, I_WPA, I_WPB, I_WO, I_WR, I_RB, I_WG, I_WU, I_WD, I_FG };

__device__ __forceinline__ void mod_items(const Fr& F, int lm, int j, int n) {
    LAS float* sc = (LAS float*)F.lds; LAS float* red = sc + 5120;
    for (int i = F.tid; i < 5120; i += 512) { const int s = i >> 10, k = i & 1023; const float x = (s < 4) ? F.in[I_C][s * 1024 + k] : F.in[I_CCTX][k]; sc[i] = x * sigm(x); }
    __syncthreads();
    float* MOD = (float*)(F.ws + WS_MOD);
    for (int cg = j; cg < 192; cg += n) {
        const int cl = F.tid & 31, ks = F.tid >> 5;
        const float* wp = F.in[I_WMOD] + ((size_t)lm * 1024 + ks * 64) * 6144 + cg * 32 + cl;
        float a0 = 0.f, a1 = 0.f, a2 = 0.f, a3 = 0.f, a4 = 0.f; float w[64];
#pragma unroll
        for (int k = 0; k < 64; ++k) w[k] = wp[(size_t)k * 6144];
#pragma unroll
        for (int k = 0; k < 64; ++k) { const int kk = ks * 64 + k; a0 += sc[kk] * w[k]; a1 += sc[1024 + kk] * w[k]; a2 += sc[2048 + kk] * w[k]; a3 += sc[3072 + kk] * w[k]; a4 += sc[4096 + kk] * w[k]; }
        red[(ks * 5 + 0) * 32 + cl] = a0; red[(ks * 5 + 1) * 32 + cl] = a1; red[(ks * 5 + 2) * 32 + cl] = a2; red[(ks * 5 + 3) * 32 + cl] = a3; red[(ks * 5 + 4) * 32 + cl] = a4;
        __syncthreads();
        if (F.tid < 160) { const int s = F.tid >> 5, c = F.tid & 31; float v = F.in[I_BMOD][lm * 6144 + cg * 32 + c];
#pragma unroll
            for (int q = 0; q < 16; ++q) v += red[(q * 5 + s) * 32 + c];
            MOD[(size_t)(lm * 5 + s) * 6144 + cg * 32 + c] = v; }
        __syncthreads();
    }
}
__device__ __forceinline__ void p0_setup(const Fr& F) {
    mod_items(F, 0, F.blk, F.G);
    const int gi = F.blk * 512 + F.tid;
    if (gi < 1024) { const int dir = gi >> 9, j = gi & 511; const float* gm = F.in[dir ? I_GB : I_GF];
        const float g0 = gm[j], g1 = gm[512 + j], g2 = gm[1024 + j], g3 = gm[1536 + j], mx = fmaxf(fmaxf(g0, g1), fmaxf(g2, g3));
        const float e0 = __expf(g0 - mx), e1 = __expf(g1 - mx), e2 = __expf(g2 - mx), e3 = __expf(g3 - mx), inv = 1.0f / (e0 + e1 + e2 + e3);
        float* LBT = (float*)(F.ws + WS_LBT);
        LBT[(0 * 2 + dir) * 512 + j] = 0.f; LBT[(1 * 2 + dir) * 512 + j] = e1 * inv; LBT[(2 * 2 + dir) * 512 + j] = (e1 + e2) * inv; LBT[(3 * 2 + dir) * 512 + j] = (e1 + e2 + e3) * inv; }
    if (gi >= 1024 && gi < 1536) { const int idx = gi - 1024, pos = idx >> 3, i = idx & 7; const float ang = (float)pos * exp2f(-(float)i * 1.6609640474436813f);
        float* RP = (float*)(F.ws + WS_ROPE); RP[idx * 2] = __cosf(ang); RP[idx * 2 + 1] = __sinf(ang); }
}

__device__ __forceinline__ void tr_item(const float* wsrc  , int ldw, int K, bf16_t* WT  , int k0, LAS float* scr, int lane) {
#pragma unroll 8
    for (int i = 0; i < 32; ++i) { const int kk = 2 * i + (lane >> 5); scr[kk * 33 + (lane & 31)] = wsrc ? wsrc[(size_t)(k0 + kk) * ldw] : 0.f; }
    LDS_WAIT(); asm volatile("" ::: "memory");
    const int c = lane & 7;
#pragma unroll
    for (int j = 0; j < 4; ++j) { const int n = (lane >> 3) + 8 * j; const LAS float* s = scr + (8 * c) * 33 + n;
        u32x4 o; o.x = pk2(s[0 * 33], s[1 * 33]); o.y = pk2(s[2 * 33], s[3 * 33]); o.z = pk2(s[4 * 33], s[5 * 33]); o.w = pk2(s[6 * 33], s[7 * 33]);
        *(u32x4*)(WT + (size_t)n * K + k0 + 8 * c) = o; }
    LDS_WAIT(); asm volatile("" ::: "memory");
}
__device__ __forceinline__ void tr64_item(const float* src  , int ldw, bool valid, bf16_t* dst  , int K, LAS bf16_t* scr, int lane) {
    const int g = lane >> 4, n4 = (lane & 15) * 4; f32x4 v[16];
#pragma unroll
    for (int i = 0; i < 16; ++i) v[i] = valid ? *(const f32x4*)(src + (size_t)(16 * g + i) * ldw + n4) : (f32x4){0.f, 0.f, 0.f, 0.f};
#pragma unroll
    for (int c = 0; c < 4; ++c)
#pragma unroll
        for (int ip = 0; ip < 8; ++ip) *(LAS unsigned*)(scr + (n4 + c) * 72 + 16 * g + 2 * ip) = pk2(v[2 * ip][c], v[2 * ip + 1][c]);
    LDS_WAIT(); asm volatile("" ::: "memory");
#pragma unroll
    for (int j = 0; j < 8; ++j) { const int n = (lane >> 3) + 8 * j; *(u32x4*)(dst + (size_t)n * K + 8 * (lane & 7)) = *(const LAS u32x4*)(scr + n * 72 + 8 * (lane & 7)); }
    LDS_WAIT(); asm volatile("" ::: "memory");
}
constexpr int CV_IN = 16 * 84, CV_UQ = 6 * 24, CV_UKV = 4 * 16, CV_PA = 8 * 16, CV_PB = 8 * 16, CV_O = 16 * 16, CV_GU = 16 * 256, CV_DN = 16 * 128;
constexpr int CV_NITEMS = CV_IN + CV_UQ + CV_UKV + CV_PA + CV_PB + CV_O + CV_GU + CV_DN;
constexpr int CW_QHEAD = 8192, CW_ARR = 8192 + 64 * 8, CW_GCNT = 16384;
struct CvDesc { const float* src; const float* srcz; bf16_t* dst; int ldw, K; bool valid; bool edge; bool none; };
constexpr int CV_T64 = CV_GU + CV_DN + CV_IN + CV_O + CV_PA + CV_PB + CV_UKV;
__device__ __forceinline__ CvDesc cvt_decode(const Fr& F, int l, int it, unsigned char* wb) {
    CvDesc d; d.valid = true; d.edge = false; d.none = false; d.srcz = nullptr; int r = it; const int c4 = 4 * (F.lane & 15);
    if (r < CV_GU) { const int e = r >> 8, q = r & 255, kb = q >> 4, nb = q & 15, n0 = nb * 64, pn = n0 >> 8, w = n0 & 255;
        d.src = (w < 128 ? F.in[I_WG] : F.in[I_WU]) + ((size_t)(l * 16 + e) * 1024 + kb * 64) * 512 + 128 * pn + (w & 127); d.ldw = 512; d.K = 1024;
        d.dst = (bf16_t*)(wb + W_GU) + ((size_t)e * 1024 + n0) * 1024 + kb * 64; return d; } r -= CV_GU;
    if (r < CV_DN) { const int e = r >> 7, q = r & 127, kb = q >> 4, nb = q & 15;
        d.src = F.in[I_WD] + ((size_t)(l * 16 + e) * 512 + kb * 64) * 1024 + nb * 64; d.ldw = 1024; d.K = 512; d.dst = (bf16_t*)(wb + W_DN) + ((size_t)e * 1024 + nb * 64) * 512 + kb * 64; return d; } r -= CV_DN;
    if (r < CV_IN) { const int kb = r / 84, nb = r % 84;
        d.src = F.in[I_WIN] + ((size_t)l * 1024 + kb * 64) * IN_DIM + nb * 64; d.srcz = F.in[I_WIN] + ((size_t)l * 1024 + kb * 64) * IN_DIM; d.ldw = IN_DIM; d.K = 1024; d.valid = nb * 64 + c4 < IN_DIM; d.edge = nb * 64 + 32 == IN_DIM; d.none = nb * 64 >= IN_DIM; d.dst = (bf16_t*)(wb + W_IN) + (size_t)nb * 64 * 1024 + kb * 64; return d; } r -= CV_IN;
    if (r < CV_O) { const int kb = r >> 4, nb = r & 15;
        d.src = F.in[I_WO] + ((size_t)l * 1024 + kb * 64) * 1024 + nb * 64; d.ldw = 1024; d.K = 1024; d.dst = (bf16_t*)(wb + W_O) + (size_t)nb * 64 * 1024 + kb * 64; return d; } r -= CV_O;
    if (r < CV_PA) { const int kb = r >> 4, nb = r & 15;
        d.src = F.in[I_WPA] + ((size_t)l * 512 + kb * 64) * 1024 + nb * 64; d.ldw = 1024; d.K = 512; d.dst = (bf16_t*)(wb + W_PA) + (size_t)nb * 64 * 512 + kb * 64; return d; } r -= CV_PA;
    if (r < CV_PB) { const int kb = r >> 4, nb = r & 15;
        d.src = F.in[I_WPB] + ((size_t)l * 512 + kb * 64) * 1024 + nb * 64; d.ldw = 1024; d.K = 512; d.dst = (bf16_t*)(wb + W_PB) + (size_t)nb * 64 * 512 + kb * 64; return d; } r -= CV_PB;
    { const int kb = r >> 4, nb = r & 15;
        d.src = F.in[I_WUKV] + ((size_t)l * 256 + kb * 64) * 1024 + nb * 64; d.ldw = 1024; d.K = 256; d.dst = (bf16_t*)(wb + W_UKV) + (size_t)nb * 64 * 256 + kb * 64; return d; }
}
__device__ __forceinline__ void cvt_range(const Fr& F, int l, unsigned char* wb, int first, int stride, int end) {
    LAS float* scr = (LAS float*)(F.lds + F.wave * 16384); LAS bf16_t* scb = (LAS bf16_t*)scr;
    const int g = F.lane >> 4, n4 = (F.lane & 15) * 4;
    int it = first; CvDesc d; f32x4 v[16];
    if (it < end) { d = cvt_decode(F, l, it, wb);
#pragma unroll
        for (int i = 0; i < 16; ++i) v[i] = d.valid ? __builtin_nontemporal_load((const f32x4*)(d.src + (size_t)(16 * g + i) * d.ldw + n4)) : (f32x4){0.f, 0.f, 0.f, 0.f}; }
    while (it < end) {
        const int itn = it + stride; CvDesc dn = d; f32x4 vn[16];
        if (itn < end) { dn = cvt_decode(F, l, itn, wb);
#pragma unroll
            for (int i = 0; i < 16; ++i) vn[i] = dn.valid ? __builtin_nontemporal_load((const f32x4*)(dn.src + (size_t)(16 * g + i) * dn.ldw + n4)) : (f32x4){0.f, 0.f, 0.f, 0.f}; }
#pragma unroll
        for (int c = 0; c < 4; ++c)
#pragma unroll
            for (int ip = 0; ip < 8; ++ip) *(LAS unsigned*)(scb + (n4 + c) * 72 + 16 * g + 2 * ip) = pk2(v[2 * ip][c], v[2 * ip + 1][c]);
        LDS_WAIT(); asm volatile("" ::: "memory");
#pragma unroll
        for (int j = 0; j < 8; ++j) { const int n = (F.lane >> 3) + 8 * j; *(u32x4*)(d.dst + (size_t)n * d.K + 8 * (F.lane & 7)) = *(const LAS u32x4*)(scb + n * 72 + 8 * (F.lane & 7)); }
        LDS_WAIT(); asm volatile("" ::: "memory");
        it = itn; d = dn;
#pragma unroll
        for (int i = 0; i < 16; ++i) v[i] = vn[i];
    }
}
__device__ __forceinline__ void cvt_pull(const Fr& F, int l, unsigned char* wb, gu32*  ) {
    cvt_range(F, l, wb, F.gw, F.NGW, CV_T64);
    LAS float* scr = (LAS float*)(F.lds + F.wave * 16384); const int ln = F.lane & 31;
    for (int r = F.gw; r < CV_UQ; r += F.NGW) { const int kb = r / 24, nb = r % 24, n = nb * 32 + ln, h = n / 96, e = n - h * 96; const int sc = e < 64 ? n : h * 96 + 64 + ((e - 64) >> 4) * 16 + ((e - 64) & 1) * 8 + (((e - 64) & 15) >> 1);
        tr_item(F.in[I_WUQ] + (size_t)l * 384 * 768 + sc, 768, 384, (bf16_t*)(wb + W_UQ) + (size_t)nb * 32 * 384, kb * 64, scr, F.lane); }
}
__device__ __forceinline__ void cvt_issue(const CvDesc& d, int hf, f32x4 (&v)[8], int lane) { const int g = lane >> 3, n4 = 32 * hf + (lane & 7) * 4;
#pragma unroll
    for (int i = 0; i < 8; ++i) v[i] = (!d.none && !(d.edge && hf == 1)) ? *(const f32x4*)(d.src + (size_t)(8 * g + i) * d.ldw + n4) : (f32x4){0.f, 0.f, 0.f, 0.f}; }
__device__ __forceinline__ void cvt_finish(const CvDesc& d, int hf, const f32x4 (&v)[8], int lane) { const int g = lane >> 3, n4 = 32 * hf + (lane & 7) * 4;
#pragma unroll
    for (int cc = 0; cc < 4; ++cc) { u32x4 w; w.x = pk2(v[0][cc], v[1][cc]); w.y = pk2(v[2][cc], v[3][cc]); w.z = pk2(v[4][cc], v[5][cc]); w.w = pk2(v[6][cc], v[7][cc]);
        *(u32x4*)(d.dst + (size_t)(n4 + cc) * d.K + 8 * g) = w; } }
__device__ __forceinline__ void cvt_issue_q(const CvDesc& d, int qt, f32x4 (&v)[4], int lane) { const int g = lane >> 2, n4 = 16 * qt + (lane & 3) * 4; const bool ok = !d.none && !(d.edge && qt >= 2); const float* sp = ok ? d.src + n4 : d.srcz + (lane & 3) * 4;
#pragma unroll
    for (int i = 0; i < 4; ++i) v[i] = __builtin_nontemporal_load((const f32x4*)(sp + (size_t)(4 * g + i) * d.ldw)); }
__device__ __forceinline__ void cvt_finish_q(const CvDesc& d, int qt, const f32x4 (&v)[4], int lane) { const int g = lane >> 2, n4 = 16 * qt + (lane & 3) * 4; const unsigned keep = (!d.none && !(d.edge && qt >= 2)) ? 0xffffffffu : 0u;
#pragma unroll
    for (int cc = 0; cc < 4; ++cc) { u32x2 w; w.x = att::cvtpk(v[0][cc], v[1][cc]) & keep; w.y = att::cvtpk(v[2][cc], v[3][cc]) & keep; __builtin_nontemporal_store(w, (u32x2*)(d.dst + (size_t)(n4 + cc) * d.K + 4 * g)); } }
struct CvHook { static constexpr bool ACTIVE = true; const Fr& F; int l; unsigned char* wb; f32x4 v[4]; int q;
    static __device__ __forceinline__ int lane_now() { int t_; asm volatile("v_mbcnt_lo_u32_b32 %0, -1, 0\n\tv_mbcnt_hi_u32_b32 %0, -1, %0" : "=v"(t_)); return t_; }
    __device__ __forceinline__ void issue(int slot) { int qq = slot * F.NGW + F.gw; if (qq >= 4 * CV_T64) qq -= 4 * CV_T64; q = qq; const CvDesc d = cvt_decode(F, l, qq >> 2, wb); cvt_issue_q(d, qq & 3, v, lane_now()); }
    __device__ __forceinline__ void finish() { const CvDesc d = cvt_decode(F, l, q >> 2, wb); cvt_finish_q(d, q & 3, v, lane_now()); }
};
__device__ __forceinline__ void cvt_uq(const Fr& F, int l, unsigned char* wb) {
    LAS float* scr = (LAS float*)(F.lds + F.wave * 16384); const int ln = F.lane & 31;
    for (int r = F.gw; r < CV_UQ; r += F.NGW) { const int kb = r / 24, nb = r % 24, n = nb * 32 + ln, h = n / 96, e = n - h * 96; const int sc = e < 64 ? n : h * 96 + 64 + ((e - 64) >> 4) * 16 + ((e - 64) & 1) * 8 + (((e - 64) & 15) >> 1);
        tr_item(F.in[I_WUQ] + (size_t)l * 384 * 768 + sc, 768, 384, (bf16_t*)(wb + W_UQ) + (size_t)nb * 32 * 384, kb * 64, scr, F.lane); }
}
__device__ __forceinline__ void moe_tab(const Fr& F, int l) {
    LAS int* tab = (LAS int*)(F.lds + MOETAB_OFF); gu32* gc = (gu32*)(F.ws + WS_CTL) + CW_GCNT + 64 * l;
    if (F.tid < 16) tab[F.tid] = (int)__hip_atomic_load(gc + F.tid, RLX_AGENT);
    __syncthreads();
    if (F.tid == 0) { int run = 0;
#pragma unroll 1
        for (int e = 0; e < 16; ++e) { const int nt = (tab[e] + 255) >> 8; tab[16 + e] = run * 256;
#pragma clang loop vectorize(disable) unroll(disable)
            for (int j = 0; j < nt; ++j) tab[64 + run + j] = e;
            run += nt; }
        tab[48] = run; }
    __syncthreads();
}
template <int MODE> __device__ __forceinline__ void row_phase_a(const Fr& F, int l) {
    bf16_t* Z = (bf16_t*)(F.ws + WS_Z); const float* MOD = (const float*)(F.ws + WS_MOD);
    const LAS int* tab = (const LAS int*)(F.lds + MOETAB_OFF); if (MODE != 0) moe_tab(F, l - 1);
    for (int r0 = F.gw; r0 < M; r0 += 2 * F.NGW) {
        int rr[2], bb[2], tt[2], ms[2]; bool ok[2]; f32x4 v[2][4]; u32x2 ya[2][4], yc[2][4]; float w1[2], w2[2]; int s1[2], s2[2];
#pragma unroll
        for (int u = 0; u < 2; ++u) { rr[u] = r0 + u * F.NGW; ok[u] = rr[u] < M; const int rc = ok[u] ? rr[u] : 0; bb[u] = rc / TPB; tt[u] = rc - bb[u] * TPB; ms[u] = tt[u] < CTX ? 4 : bb[u];
            if (MODE == 2 && tt[u] < CTX) ok[u] = false;
            if (MODE != 0 && ok[u]) { const int* rt = (const int*)(F.ws + WS_ROUTE) + 8 * rr[u]; s1[u] = tab[16 + rt[0]] + rt[2]; s2[u] = tab[16 + rt[1]] + rt[3]; w1[u] = __int_as_float(rt[4]); w2[u] = __int_as_float(rt[5]); } }
#pragma unroll
        for (int u = 0; u < 2; ++u) if (ok[u]) {
            if (MODE == 0) { const f32x4* src = (const f32x4*)(tt[u] < CTX ? F.in[I_CTX] + (size_t)(bb[u] * CTX + tt[u]) * 1024 : F.in[I_X] + (size_t)(bb[u] * SEQ + tt[u] - CTX) * 1024) + F.lane;
#pragma unroll
                for (int j = 0; j < 4; ++j) v[u][j] = src[64 * j]; }
            else { const u32x2* zr = (const u32x2*)(Z + (size_t)rr[u] * 1024) + F.lane;
                const u32x2* y1 = (const u32x2*)((const bf16_t*)(F.ws + WS_Y) + (size_t)s1[u] * 1024) + F.lane; const u32x2* y2 = (const u32x2*)((const bf16_t*)(F.ws + WS_Y) + (size_t)s2[u] * 1024) + F.lane;
#pragma unroll
                for (int j = 0; j < 4; ++j) { const u32x2 zz = zr[64 * j]; v[u][j] = (f32x4){bflo(zz.x), bfhi(zz.x), bflo(zz.y), bfhi(zz.y)}; ya[u][j] = y1[64 * j]; yc[u][j] = y2[64 * j]; } } }
#pragma unroll
        for (int u = 0; u < 2; ++u) if (ok[u]) {
            if (MODE != 0) { const f32x4* g5 = (const f32x4*)(MOD + (size_t)((l - 1) * 5 + ms[u]) * 6144 + 5 * 1024) + F.lane;
#pragma unroll
                for (int j = 0; j < 4; ++j) { const u32x2 a = ya[u][j], c = yc[u][j]; const float p = w1[u], q = w2[u];
                    const f32x4 f = (f32x4){p * bflo(a.x) + q * bflo(c.x), p * bfhi(a.x) + q * bfhi(c.x), p * bflo(a.y) + q * bflo(c.y), p * bfhi(a.y) + q * bfhi(c.y)};
                    v[u][j] = v[u][j] + g5[64 * j] * f; } }
            if (MODE != 2) { u32x2* zw = (u32x2*)(Z + (size_t)rr[u] * 1024) + F.lane;
#pragma unroll
                for (int j = 0; j < 4; ++j) { u32x2 w; w.x = pk2(v[u][j].x, v[u][j].y); w.y = pk2(v[u][j].z, v[u][j].w); zw[64 * j] = w; } }
            float ss = 0.f;
#pragma unroll
            for (int j = 0; j < 4; ++j) ss += (v[u][j].x * v[u][j].x + v[u][j].y * v[u][j].y) + (v[u][j].z * v[u][j].z + v[u][j].w * v[u][j].w);
            const float rstd = 1.0f / sqrtf(wave_sum(ss, F.lane) * (1.0f / 1024.0f) + EPS);
            if (MODE == 2) { const f32x4* fg = (const f32x4*)F.in[I_FG] + F.lane; f32x4* o = (f32x4*)(F.out + (size_t)(bb[u] * SEQ + tt[u] - CTX) * 1024) + F.lane;
#pragma unroll
                for (int j = 0; j < 4; ++j) o[64 * j] = v[u][j] * rstd * fg[64 * j]; }
            else { const f32x4* g1 = (const f32x4*)(F.in[I_N1G] + l * 1024) + F.lane; const f32x4* sh = (const f32x4*)(MOD + (size_t)(l * 5 + ms[u]) * 6144) + F.lane; const f32x4* scl = sh + 256;
                u32x2* h = (u32x2*)((bf16_t*)(F.ws + WS_H) + (size_t)rr[u] * 1024) + F.lane;
#pragma unroll
                for (int j = 0; j < 4; ++j) { const f32x4 y = v[u][j] * rstd * g1[64 * j] * (1.0f + scl[64 * j]) + sh[64 * j]; u32x2 w; w.x = pk2(y.x, y.y); w.y = pk2(y.z, y.w); h[64 * j] = w; } } }
    }
}

__device__ __forceinline__ void scan_naive(const Fr& F, int l, int item) {
    const int dir = item & 1, h = (item >> 1) & 3, b = item >> 3;
    const bf16_t* P = (const bf16_t*)(F.ws + WS_P); bf16_t* O = (bf16_t*)(F.ws + (dir ? WS_OB : WS_OF));
    LAS float* qs = (LAS float*)F.lds; LAS float* fs = qs + 2048; LAS float* vs = fs + 2048; LAS float* os = vs + 2048;
    const int v = F.tid & 127, kq = F.tid >> 7;
    const float lb = ((const float*)(F.ws + WS_LBT))[(l * 2 + dir) * 512 + h * 128 + v];
    const int cf = dir ? C_FB : C_FF;
    float S[32];
#pragma unroll
    for (int i = 0; i < 32; ++i) S[i] = 0.f;
    for (int s0 = 0; s0 < TPB; s0 += 16) {
#pragma unroll
        for (int j = 0; j < 4; ++j) { const int tt = kq + 4 * j, s = s0 + tt; const int t = dir ? (s < CTX ? CTX - 1 - s : CTX + TPB - 1 - s) : s;
            const bf16_t* pr = P + (size_t)(b * TPB + t) * INP + h * 128 + v;
            qs[tt * 128 + v] = bf1(pr[C_Q]); vs[tt * 128 + v] = bf1(pr[C_I]); fs[tt * 128 + v] = lb + (1.0f - lb) * sigm(bf1(pr[cf])); }
        __syncthreads();
#pragma unroll 1
        for (int tt = 0; tt < 16; ++tt) { const float iv = vs[tt * 128 + v]; float o = 0.f;
#pragma unroll
            for (int k4 = 0; k4 < 8; ++k4) { const f32x4 f = *(const LAS f32x4*)(fs + tt * 128 + kq * 32 + 4 * k4), q = *(const LAS f32x4*)(qs + tt * 128 + kq * 32 + 4 * k4);
                S[4 * k4 + 0] = f.x * S[4 * k4 + 0] + (1.0f - f.x) * iv; o += q.x * S[4 * k4 + 0];
                S[4 * k4 + 1] = f.y * S[4 * k4 + 1] + (1.0f - f.y) * iv; o += q.y * S[4 * k4 + 1];
                S[4 * k4 + 2] = f.z * S[4 * k4 + 2] + (1.0f - f.z) * iv; o += q.z * S[4 * k4 + 2];
                S[4 * k4 + 3] = f.w * S[4 * k4 + 3] + (1.0f - f.w) * iv; o += q.w * S[4 * k4 + 3]; }
            os[(tt * 4 + kq) * 128 + v] = o; }
        __syncthreads();
#pragma unroll
        for (int j = 0; j < 4; ++j) { const int tt = kq + 4 * j, s = s0 + tt; const int t = dir ? (s < CTX ? CTX - 1 - s : CTX + TPB - 1 - s) : s;
            const float o = (os[(tt * 4 + 0) * 128 + v] + os[(tt * 4 + 1) * 128 + v]) + (os[(tt * 4 + 2) * 128 + v] + os[(tt * 4 + 3) * 128 + v]);
            O[(size_t)(b * TPB + t) * 512 + h * 128 + v] = (bf16_t)f2bf(o); }
        __syncthreads();
    }
}
namespace hg {
typedef short bf16x8 __attribute__((ext_vector_type(8)));
typedef short s16x4 __attribute__((ext_vector_type(4)));
constexpr int NSC = 16, NITEM = 32 * NSC, QP = 136  , TP = 40  ;
constexpr int L_QS = 0, L_KS = 8704, L_KT = 17408, L_VT = 27648, L_DL = 37888, L_PQ = 38400;
__device__ __forceinline__ int tok_row(int b, int dir, int s) { const int t = dir ? (s < CTX ? CTX - 1 - s : CTX + TPB - 1 - s) : s; return b * TPB + t; }
__device__ __forceinline__ bf16x8 cat8(s16x4 lo, s16x4 hi) { return (bf16x8){lo[0], lo[1], lo[2], lo[3], hi[0], hi[1], hi[2], hi[3]}; }
typedef float f32x2_t __attribute__((ext_vector_type(2))); typedef __bf16 bf16x2_t __attribute__((ext_vector_type(2)));
__device__ __forceinline__ unsigned cvtpk(float lo, float hi) { f32x2_t v = {lo, hi}; bf16x2_t b = __builtin_convertvector(v, bf16x2_t); return __builtin_bit_cast(unsigned, b); }
__device__ __forceinline__ bf16x8 pack88(f32x4 a, f32x4 b) { u32x4 w; w.x = cvtpk(a[0], a[1]); w.y = cvtpk(a[2], a[3]); w.z = cvtpk(b[0], b[1]); w.w = cvtpk(b[2], b[3]); return __builtin_bit_cast(bf16x8, w); }
#define HG_MFMA(a, b, c) __builtin_amdgcn_mfma_f32_16x16x32_bf16(a, b, c, 0, 0, 0)
__device__ __forceinline__ float fsig(float x) { return __builtin_amdgcn_rcpf(1.0f + __builtin_amdgcn_exp2f(-1.4426950408889634f * x)); }
__device__ __forceinline__ int sc_nch(int sc) { return sc == 0 ? 8 : ((sc <= 4 || sc >= 12) ? 9 : 8); }
__device__ __forceinline__ int sc_base(int sc) { return sc == 0 ? 0 : (sc <= 4 ? CTX + 288 * (sc - 1) : (sc <= 11 ? CTX + 1152 + 256 * (sc - 5) : CTX + 2944 + 288 * (sc - 12))); }
constexpr int L_SSB = 42496, L_OL = 43520, OLP = 132;
template <int MODE> __device__ __forceinline__ void scan_dir(const Fr& F, int l, int b, int h, int dir, int sc, int cvl, int cvit, int cvst, unsigned char* cvwb) {
    constexpr bool P3 = MODE != 0;
    const int item = ((b * 4 + h) * 2 + dir) * NSC + sc, NCH = sc_nch(sc), sbase = sc_base(sc);
    const bf16_t* P = (const bf16_t*)(F.ws + WS_P);
    float* St = (float*)(F.ws + WS_ST) + (size_t)item * 16384; float* Dg = (float*)(F.ws + WS_SD) + item * 128;
    LAS bf16_t* qs = (LAS bf16_t*)(F.lds + L_QS); LAS bf16_t* ks = (LAS bf16_t*)(F.lds + L_KS); LAS bf16_t* kT = (LAS bf16_t*)(F.lds + L_KT); LAS bf16_t* vT = (LAS bf16_t*)(F.lds + L_VT);
    LAS float* dl = (LAS float*)(F.lds + L_DL); LAS float* pq = (LAS float*)(F.lds + L_PQ);
    LAS float* ssb = (LAS float*)(F.lds + L_SSB); LAS bf16_t* OL = (LAS bf16_t*)(F.lds + L_OL);
    const int kp = F.tid & 63, tg = F.tid >> 6, k0 = 2 * kp, g = F.lane >> 4, c16 = F.lane & 15, vs = 16 * F.wave;
    const f32x2 lb = *(const f32x2*)((const float*)(F.ws + WS_LBT) + (l * 2 + dir) * 512 + h * 128 + k0);
    const int cfo = dir ? C_FB : C_FF;
    const int kperm = (k0 & ~31) | (((k0 & 15) >> 2) << 3) | (((k0 >> 4) & 1) << 2) | (k0 & 3);
    const int tslot = (tg & 3) * 8 + (tg >> 2) * 4;
    const long rstep = dir ? -(long)INP : (long)INP;
    f32x4 S[8];
#pragma unroll
    for (int kt = 0; kt < 8; ++kt) {
        if (P3) {
#pragma unroll
            for (int i = 0; i < 4; ++i) S[kt][i] = St[(16 * kt + 4 * g + i) * 128 + vs + c16]; }
        else S[kt] = (f32x4){0.f, 0.f, 0.f, 0.f}; }
    float D0 = 1.0f, D1 = 1.0f;
    unsigned rf[4], rq[4], rv[4], nf[4], nq[4], nv[4];
    const bf16_t* pld = P + (size_t)tok_row(b, dir, sbase + 4 * tg) * INP + h * 128 + k0;
#define HG_LOAD(F_, Q_, V_) do { const bf16_t* pr = pld; _Pragma("unroll") for (int j = 0; j < 4; ++j) { \
        F_[j] = *(const unsigned*)(pr + cfo); V_[j] = *(const unsigned*)(pr + C_I); if (P3) Q_[j] = *(const unsigned*)(pr + C_Q); pr += rstep; } pld += 32 * rstep; } while (0)
    HG_LOAD(rf, rq, rv); HG_LOAD(nf, nq, nv);
    const size_t row0 = (size_t)tok_row(b, dir, sbase + c16); const long tstep = dir ? -1L : 1L;
    const bf16_t* gp = P + row0 * INP + C_G + h * 128 + vs + 4 * g; bf16_t* ap = (bf16_t*)(F.ws + WS_A) + row0 * 512 + h * 128 + vs + 4 * g;
    int tau = MODE == 2 ? 32 * NCH - 1 - c16 : c16;
    const bool cvon = MODE == 0 && cvl >= 0; CvDesc cvd; f32x4 cvv[8]; bool cvload = false; int cvh = 0;
    f32x4 gn4 = {0.f, 0.f, 0.f, 0.f}; if (MODE == 2) gn4 = *(const f32x4*)(F.in[I_HGG] + l * 512 + h * 128 + vs + 4 * g);
#pragma unroll 1
    for (int ch = 0; ch < NCH; ++ch) {
        if (cvon && (ch & 1) == 0) { if (cvload) { cvt_finish(cvd, cvh, cvv, F.lane); cvload = false; }
            const int hi = cvit + (ch >> 1) * cvst; if (ch < 8 && hi < 2 * CV_T64) { cvd = cvt_decode(F, cvl, hi >> 1, cvwb); cvh = hi & 1; cvt_issue(cvd, cvh, cvv, F.lane); cvload = true; } }
        float c0 = 1.0f, c1 = 1.0f, cp0[4], cp1[4], kf0[4], kf1[4];
#pragma unroll
        for (int j = 0; j < 4; ++j) { const float f0 = lb.x + (1.0f - lb.x) * fsig(bflo(rf[j])), f1 = lb.y + (1.0f - lb.y) * fsig(bfhi(rf[j])); c0 *= f0; c1 *= f1; cp0[j] = c0; cp1[j] = c1; kf0[j] = 1.0f - f0; kf1[j] = 1.0f - f1; }
        *(LAS f32x2*)(pq + tg * 128 + k0) = (f32x2){c0, c1};
        __syncthreads();
        float pre0 = 1.0f, pre1 = 1.0f, tot0 = 1.0f, tot1 = 1.0f;
#pragma unroll
        for (int t = 0; t < 8; ++t) { const f32x2 p = *(const LAS f32x2*)(pq + t * 128 + k0); if (t < tg) { pre0 *= p.x; pre1 *= p.y; } tot0 *= p.x; tot1 *= p.y; }
        if (tg == 0) *(LAS f32x2*)(dl + k0) = (f32x2){tot0, tot1};
        D0 *= tot0; D1 *= tot1;
        float ka0[4], ka1[4];
#pragma unroll
        for (int j = 0; j < 4; ++j) { cp0[j] *= pre0; cp1[j] *= pre1; ka0[j] = kf0[j] * __builtin_amdgcn_rcpf(cp0[j]); ka1[j] = kf1[j] * __builtin_amdgcn_rcpf(cp1[j]); }
        if (P3) {
#pragma unroll
            for (int j = 0; j < 4; ++j) { *(LAS unsigned*)(qs + (4 * tg + j) * QP + kperm) = cvtpk(bflo(rq[j]) * cp0[j], bfhi(rq[j]) * cp1[j]); *(LAS unsigned*)(ks + (4 * tg + j) * QP + kperm) = cvtpk(ka0[j], ka1[j]); } }
        { u32x2 w; w.x = cvtpk(ka0[0], ka0[1]); w.y = cvtpk(ka0[2], ka0[3]); *(LAS u32x2*)(kT + k0 * TP + tslot) = w; w.x = cvtpk(ka1[0], ka1[1]); w.y = cvtpk(ka1[2], ka1[3]); *(LAS u32x2*)(kT + (k0 + 1) * TP + tslot) = w;
          w.x = (rv[0] & 0xffffu) | (rv[1] << 16); w.y = (rv[2] & 0xffffu) | (rv[3] << 16); *(LAS u32x2*)(vT + k0 * TP + tslot) = w;
          w.x = (rv[0] >> 16) | (rv[1] & 0xffff0000u); w.y = (rv[2] >> 16) | (rv[3] & 0xffff0000u); *(LAS u32x2*)(vT + (k0 + 1) * TP + tslot) = w; }
#pragma unroll
        for (int j = 0; j < 4; ++j) { rf[j] = nf[j]; rv[j] = nv[j]; if (P3) rq[j] = nq[j]; }
        if (ch + 2 < NCH) HG_LOAD(nf, nq, nv);
        __syncthreads();
        const bf16x8 vf = *(const LAS bf16x8*)(vT + (vs + c16) * TP + 8 * g);
        f32x4 o0 = {0.f, 0.f, 0.f, 0.f}, o1 = o0;
        if (P3) {
            bf16x8 qf[2][4], ka[2][4];
#pragma unroll
            for (int t2 = 0; t2 < 2; ++t2)
#pragma unroll
                for (int kb = 0; kb < 4; ++kb) { qf[t2][kb] = *(const LAS bf16x8*)(qs + (16 * t2 + c16) * QP + 32 * kb + 8 * g); ka[t2][kb] = *(const LAS bf16x8*)(ks + (16 * t2 + c16) * QP + 32 * kb + 8 * g); }
            f32x4 a00 = {0.f, 0.f, 0.f, 0.f}, a01 = a00, a11 = a00;
#pragma unroll
            for (int kb = 0; kb < 4; ++kb) { a00 = HG_MFMA(ka[0][kb], qf[0][kb], a00); a01 = HG_MFMA(ka[0][kb], qf[1][kb], a01); a11 = HG_MFMA(ka[1][kb], qf[1][kb], a11); }
#pragma unroll
            for (int i = 0; i < 4; ++i) { if (c16 < 4 * g + i) { a00[i] = 0.f; a11[i] = 0.f; } }
            const bf16x8 B0 = pack88(a00, (f32x4){0.f, 0.f, 0.f, 0.f}), B1 = pack88(a01, a11);
#pragma unroll
            for (int kb = 0; kb < 4; ++kb) { const bf16x8 Sf = pack88(S[2 * kb], S[2 * kb + 1]); o0 = HG_MFMA(Sf, qf[0][kb], o0); o1 = HG_MFMA(Sf, qf[1][kb], o1); }
            o0 = HG_MFMA(vf, B0, o0); o1 = HG_MFMA(vf, B1, o1);
            if (MODE == 1) { u32x2 w0, w1; w0.x = cvtpk(o0[0], o0[1]); w0.y = cvtpk(o0[2], o0[3]); w1.x = cvtpk(o1[0], o1[1]); w1.y = cvtpk(o1[2], o1[3]);
                *(LAS u32x2*)(OL + tau * OLP + vs + 4 * g) = w0; *(LAS u32x2*)(OL + (tau + 16) * OLP + vs + 4 * g) = w1; tau += 32; }
        }
#pragma unroll
        for (int kt = 0; kt < 8; ++kt) { const bf16x8 kTf = *(const LAS bf16x8*)(kT + (16 * kt + c16) * TP + 8 * g);
            S[kt] = HG_MFMA(kTf, vf, S[kt]); S[kt] = S[kt] * *(const LAS f32x4*)(dl + 16 * kt + 4 * g); }
        if (MODE == 2) {
            const u32x2 f0 = *(const LAS u32x2*)(OL + tau * OLP + vs + 4 * g), f1 = *(const LAS u32x2*)(OL + (tau - 16) * OLP + vs + 4 * g);
            o0 += (f32x4){bflo(f0.x), bfhi(f0.x), bflo(f0.y), bfhi(f0.y)}; o1 += (f32x4){bflo(f1.x), bfhi(f1.x), bflo(f1.y), bfhi(f1.y)};
            float s0 = (o0[0] * o0[0] + o0[1] * o0[1]) + (o0[2] * o0[2] + o0[3] * o0[3]), s1 = (o1[0] * o1[0] + o1[1] * o1[1]) + (o1[2] * o1[2] + o1[3] * o1[3]);
            s0 += lane_xor(s0, F.lane, 16); s0 += lane_xor(s0, F.lane, 32); s1 += lane_xor(s1, F.lane, 16); s1 += lane_xor(s1, F.lane, 32);
            if (g == 0) { ssb[F.wave * 32 + c16] = s0; ssb[F.wave * 32 + 16 + c16] = s1; }
            const u32x2 g0 = *(const u32x2*)gp, g1 = *(const u32x2*)(gp + 16 * tstep * INP);
            __syncthreads();
            float t0 = 0.f, t1 = 0.f;
#pragma unroll
            for (int w = 0; w < 8; ++w) { t0 += ssb[w * 32 + c16]; t1 += ssb[w * 32 + 16 + c16]; }
            const float r0 = 1.0f / sqrtf(t0 * (1.0f / 128.0f) + EPS), r1 = 1.0f / sqrtf(t1 * (1.0f / 128.0f) + EPS);
            const f32x4 gg0 = {bflo(g0.x), bfhi(g0.x), bflo(g0.y), bfhi(g0.y)}, gg1 = {bflo(g1.x), bfhi(g1.x), bflo(g1.y), bfhi(g1.y)};
            f32x4 y0, y1;
#pragma unroll
            for (int i = 0; i < 4; ++i) { y0[i] = o0[i] * r0 * gn4[i] * (gg0[i] * fsig(gg0[i])); y1[i] = o1[i] * r1 * gn4[i] * (gg1[i] * fsig(gg1[i])); }
            u32x2 w0, w1; w0.x = cvtpk(y0[0], y0[1]); w0.y = cvtpk(y0[2], y0[3]); w1.x = cvtpk(y1[0], y1[1]); w1.y = cvtpk(y1[2], y1[3]);
            *(u32x2*)ap = w0; *(u32x2*)(ap + 16 * tstep * 512) = w1;
            gp += 32 * tstep * INP; ap += 32 * tstep * 512; tau -= 32;
        }
    }
    if (cvon && cvload) cvt_finish(cvd, cvh, cvv, F.lane);
    __syncthreads();
#undef HG_LOAD
    if (MODE == 0) {
#pragma unroll
        for (int kt = 0; kt < 8; ++kt)
#pragma unroll
            for (int i = 0; i < 4; ++i) St[(16 * kt + 4 * g + i) * 128 + vs + c16] = S[kt][i];
        if (tg == 0) *(f32x2*)(Dg + k0) = (f32x2){D0, D1}; }
}
#undef HG_MFMA
__device__ __forceinline__ void scan_pass2(const Fr& F) {
    float* St = (float*)(F.ws + WS_ST); const float* Dg = (const float*)(F.ws + WS_SD);
    for (int idx = F.blk * 512 + F.tid; idx < 32 * 4096; idx += F.G * 512) { const int seq = idx >> 12, e4 = idx & 4095, kk = e4 >> 5;
        float z = 0.f; asm volatile("" : "+v"(z));
        f32x4 S = {z, z, z, z};
#pragma unroll
        for (int sc = 0; sc < NSC; ++sc) { f32x4* up = (f32x4*)(St + (size_t)(seq * NSC + sc) * 16384) + e4; const f32x4 u = *up; const float d = Dg[(seq * NSC + sc) * 128 + kk]; *up = S; S = S * d + u; } }
}
}
__device__ __forceinline__ void mla_prep(const Fr& F, int l, int gw, int ngw) {
    const bf16_t* P = (const bf16_t*)(F.ws + WS_P); const float* RP = (const float*)(F.ws + WS_ROPE);
    bf16_t* DQN = (bf16_t*)(F.ws + WS_DQN); bf16_t* DKVN = (bf16_t*)(F.ws + WS_DKVN); bf16_t* Kb = (bf16_t*)(F.ws + WS_K);
    const float* qg = F.in[I_QNG] + l * 384; const float* kg = F.in[I_KVNG] + l * 256;
    const f32x2 g0 = ((const f32x2*)qg)[F.lane], g1 = ((const f32x2*)qg)[F.lane + 64], g2 = ((const f32x2*)qg)[F.lane + 128]; const f32x4 gk = ((const f32x4*)kg)[F.lane];
    const int ax = (F.lane >> 3) & 1, i = F.lane & 7;
    for (int r0 = gw; r0 < M; r0 += 4 * ngw) {
        unsigned q0[4], q1[4], q2[4]; u32x2 kv[4]; bf16_t p1[4], p2[4];
#pragma unroll
        for (int u = 0; u < 4; ++u) { const int r = r0 + u * ngw; if (r < M) { const bf16_t* pr = P + (size_t)r * INP; const unsigned* src = (const unsigned*)(pr + C_DQ) + F.lane;
            q0[u] = src[0]; q1[u] = src[64]; q2[u] = src[128]; kv[u] = ((const u32x2*)(pr + C_DKV))[F.lane]; p1[u] = pr[C_KPE + ax * 16 + i]; p2[u] = pr[C_KPE + ax * 16 + 8 + i]; } }
#pragma unroll
        for (int u = 0; u < 4; ++u) { const int r = r0 + u * ngw; if (r < M) { const int b = r / TPB, t = r - b * TPB;
            { const float x0 = bflo(q0[u]), x1 = bfhi(q0[u]), x2 = bflo(q1[u]), x3 = bfhi(q1[u]), x4 = bflo(q2[u]), x5 = bfhi(q2[u]);
              const float rstd = 1.0f / sqrtf(wave_sum((x0 * x0 + x1 * x1) + (x2 * x2 + x3 * x3) + (x4 * x4 + x5 * x5), F.lane) * (1.0f / 384.0f) + EPS);
              unsigned* dst = (unsigned*)(DQN + (size_t)r * 384) + F.lane;
              dst[0] = pk2(x0 * rstd * g0.x, x1 * rstd * g0.y); dst[64] = pk2(x2 * rstd * g1.x, x3 * rstd * g1.y); dst[128] = pk2(x4 * rstd * g2.x, x5 * rstd * g2.y); }
            { const float x0 = bflo(kv[u].x), x1 = bfhi(kv[u].x), x2 = bflo(kv[u].y), x3 = bfhi(kv[u].y);
              const float rstd = 1.0f / sqrtf(wave_sum((x0 * x0 + x1 * x1) + (x2 * x2 + x3 * x3), F.lane) * (1.0f / 256.0f) + EPS);
              u32x2 w; w.x = pk2(x0 * rstd * gk.x, x1 * rstd * gk.y); w.y = pk2(x2 * rstd * gk.z, x3 * rstd * gk.w);
              ((u32x2*)(DKVN + (size_t)r * 256))[F.lane] = w; }
            if (F.lane < 16) { float x1 = bf1(p1[u]), x2 = bf1(p2[u]);
                if (t >= CTX) { const int p = t - CTX, pos = ax ? (p & 63) : (p >> 6); const float c = RP[(pos * 8 + i) * 2], sn = RP[(pos * 8 + i) * 2 + 1]; const float y1 = x1 * c - x2 * sn, y2 = x1 * sn + x2 * c; x1 = y1; x2 = y2; }
                const unsigned w = pk2(x1, x2);
#pragma unroll
                for (int hh = 0; hh < 8; ++hh) *(unsigned*)(Kb + ((size_t)(b * 8 + hh) * TPB + t) * 96 + 64 + ax * 16 + 2 * i) = w; } } }
    }
}
__device__ __forceinline__ void hg_readout(const Fr& F, int l) {
    const bf16_t* P = (const bf16_t*)(F.ws + WS_P); const bf16_t* OF = (const bf16_t*)(F.ws + WS_OF); const bf16_t* OB = (const bf16_t*)(F.ws + WS_OB); bf16_t* A = (bf16_t*)(F.ws + WS_A);
    const float* gain = F.in[I_HGG] + l * 512;
    const f32x4 ga = ((const f32x4*)gain)[2 * F.lane], gb = ((const f32x4*)gain)[2 * F.lane + 1]; const float gn[8] = {ga.x, ga.y, ga.z, ga.w, gb.x, gb.y, gb.z, gb.w};
    for (int r0 = F.gw; r0 < M; r0 += 4 * F.NGW) {
        u32x4 a4[4], c4[4], g4[4];
#pragma unroll
        for (int u = 0; u < 4; ++u) { const int r = r0 + u * F.NGW; if (r < M) { a4[u] = ((const u32x4*)(OF + (size_t)r * 512))[F.lane]; c4[u] = ((const u32x4*)(OB + (size_t)r * 512))[F.lane]; g4[u] = ((const u32x4*)(P + (size_t)r * INP + C_G))[F.lane]; } }
#pragma unroll
        for (int u = 0; u < 4; ++u) { const int r = r0 + u * F.NGW; if (r < M) { const u32x4 a = a4[u], c = c4[u], g = g4[u];
            float o[8] = {bflo(a.x) + bflo(c.x), bfhi(a.x) + bfhi(c.x), bflo(a.y) + bflo(c.y), bfhi(a.y) + bfhi(c.y), bflo(a.z) + bflo(c.z), bfhi(a.z) + bfhi(c.z), bflo(a.w) + bflo(c.w), bfhi(a.w) + bfhi(c.w)};
            const float gg[8] = {bflo(g.x), bfhi(g.x), bflo(g.y), bfhi(g.y), bflo(g.z), bfhi(g.z), bflo(g.w), bfhi(g.w)};
            float ss = 0.f;
#pragma unroll
            for (int i = 0; i < 8; ++i) ss += o[i] * o[i];
            ss += lane_xor(ss, F.lane, 1); ss += lane_xor(ss, F.lane, 2); ss += lane_xor(ss, F.lane, 4); ss += lane_xor(ss, F.lane, 8);
            const float rstd = 1.0f / sqrtf(ss * (1.0f / 128.0f) + EPS);
#pragma unroll
            for (int i = 0; i < 8; ++i) o[i] = o[i] * rstd * gn[i] * (gg[i] * sigm(gg[i]));
            u32x4 w; w.x = pk2(o[0], o[1]); w.y = pk2(o[2], o[3]); w.z = pk2(o[4], o[5]); w.w = pk2(o[6], o[7]);
            ((u32x4*)(A + (size_t)r * 512))[F.lane] = w; } }
    }
}
__device__ __forceinline__ void top2of4(float a, float b, float c, float d, int& i1, int& i2) {
    float bv = a; i1 = 0; if (b > bv) { bv = b; i1 = 1; } if (c > bv) { bv = c; i1 = 2; } if (d > bv) { bv = d; i1 = 3; }
    const float NI = -3.0e38f; const float a2 = i1 == 0 ? NI : a, b2 = i1 == 1 ? NI : b, c2 = i1 == 2 ? NI : c, d2 = i1 == 3 ? NI : d;
    bv = a2; i2 = 0; if (b2 > bv) { bv = b2; i2 = 1; } if (c2 > bv) { bv = c2; i2 = 2; } if (d2 > bv) { bv = d2; i2 = 3; }
}
__device__ __forceinline__ float sel4(int i, float a, float b, float c, float d) { return i == 0 ? a : (i == 1 ? b : (i == 2 ? c : d)); }
__device__ __forceinline__ void norm2_route(const Fr& F, int l, int skip_ctx) {
    LAS float* wrT = (LAS float*)F.lds; LAS int* hist = (LAS int*)(F.lds + 65536); LAS int* gbase = hist + 16;
    { f32x4 wv[8];
#pragma unroll
      for (int j = 0; j < 8; ++j) wv[j] = ((const f32x4*)F.in[I_WR])[512 * j + F.tid];
#pragma unroll
      for (int j = 0; j < 8; ++j) { const int i4 = 512 * j + F.tid, k = i4 >> 2, e0 = (i4 & 3) * 4;
          wrT[(e0 + 0) * 1024 + k] = wv[j].x; wrT[(e0 + 1) * 1024 + k] = wv[j].y; wrT[(e0 + 2) * 1024 + k] = wv[j].z; wrT[(e0 + 3) * 1024 + k] = wv[j].w; } }
    if (F.tid < 16) hist[F.tid] = 0;
    __syncthreads();
    const bf16_t* Z = (const bf16_t*)(F.ws + WS_Z); const float* MOD = (const float*)(F.ws + WS_MOD);
    LAS float* lg = (LAS float*)(hist + 64);
    f32x4 g2v[4];
#pragma unroll
    for (int j = 0; j < 4; ++j) g2v[j] = ((const f32x4*)(F.in[I_N2G] + l * 1024))[F.lane + 64 * j];
    int ri = 0; u32x2 vn[4];
    { const u32x2* zr = (const u32x2*)(Z + (size_t)F.gw * 1024) + F.lane;
#pragma unroll
      for (int j = 0; j < 4; ++j) vn[j] = zr[64 * j]; }
    for (int r = F.gw; r < M; r += F.NGW, ++ri) {
        const int b = r / TPB, t = r - b * TPB, ms = t < CTX ? 4 : b;
        f32x4 v[4]; float ss = 0.f;
#pragma unroll
        for (int j = 0; j < 4; ++j) v[j] = (f32x4){bflo(vn[j].x), bfhi(vn[j].x), bflo(vn[j].y), bfhi(vn[j].y)};
        if (r + F.NGW < M) { const u32x2* zr = (const u32x2*)(Z + (size_t)(r + F.NGW) * 1024) + F.lane;
#pragma unroll
            for (int j = 0; j < 4; ++j) vn[j] = zr[64 * j]; }
        if (skip_ctx && t < CTX) continue;
        const f32x4* sh = (const f32x4*)(MOD + (size_t)(l * 5 + ms) * 6144 + 3 * 1024) + F.lane; const f32x4* scl = sh + 256;
        f32x4 shv[4], scv[4];
#pragma unroll
        for (int j = 0; j < 4; ++j) { shv[j] = sh[64 * j]; scv[j] = scl[64 * j]; }
#pragma unroll
        for (int j = 0; j < 4; ++j) ss += (v[j].x * v[j].x + v[j].y * v[j].y) + (v[j].z * v[j].z + v[j].w * v[j].w);
        const float rstd = 1.0f / sqrtf(wave_sum(ss, F.lane) * (1.0f / 1024.0f) + EPS);
        u32x2* h = (u32x2*)((bf16_t*)(F.ws + WS_H) + (size_t)r * 1024) + F.lane;
#pragma unroll
        for (int j = 0; j < 4; ++j) { v[j] = v[j] * rstd * g2v[j] * (1.0f + scv[j]) + shv[j]; u32x2 w; w.x = pk2(v[j].x, v[j].y); w.y = pk2(v[j].z, v[j].w); h[64 * j] = w; }
        float p[16];
#pragma unroll
        for (int e = 0; e < 16; ++e) { float a = 0.f;
#pragma unroll
            for (int j = 0; j < 4; ++j) { const f32x4 w = *(const LAS f32x4*)(wrT + e * 1024 + 4 * F.lane + 256 * j); a += (v[j].x * w.x + v[j].y * w.y) + (v[j].z * w.z + v[j].w * w.w); }
            p[e] = a; }
        const bool h5 = (F.lane >> 5) & 1, h4 = (F.lane >> 4) & 1, h3 = (F.lane >> 3) & 1, h2 = (F.lane >> 2) & 1; float q[8], r4[4], s2[2];
#pragma unroll
        for (int j = 0; j < 8; ++j) q[j] = (h5 ? p[8 + j] : p[j]) + lane_xor(h5 ? p[j] : p[8 + j], F.lane, 32);
#pragma unroll
        for (int j = 0; j < 4; ++j) r4[j] = (h4 ? q[4 + j] : q[j]) + lane_xor(h4 ? q[j] : q[4 + j], F.lane, 16);
#pragma unroll
        for (int j = 0; j < 2; ++j) s2[j] = (h3 ? r4[2 + j] : r4[j]) + lane_xor(h3 ? r4[j] : r4[2 + j], F.lane, 8);
        float tt = (h2 ? s2[1] : s2[0]) + lane_xor(h2 ? s2[0] : s2[1], F.lane, 4);
        tt += lane_xor(tt, F.lane, 1); tt += lane_xor(tt, F.lane, 2);
        if ((F.lane & 3) == 0) lg[(F.wave * 9 + ri) * 16 + (((F.lane >> 5) & 1) << 3 | ((F.lane >> 4) & 1) << 2 | ((F.lane >> 3) & 1) << 1 | ((F.lane >> 2) & 1))] = tt;
    }
    const int rl = F.gw + F.lane * F.NGW; const bool valid = F.lane < 9 && rl < M && !(skip_ctx && (rl % TPB) < CTX);
    int e1 = 0, e2 = 0, k1 = 0, k2 = 0; float w1 = 0.f, w2 = 0.f;
    LDS_WAIT();
    if (valid) { float sc[16], rb[16];
#pragma unroll
        for (int e = 0; e < 16; ++e) { sc[e] = sigm(lg[(F.wave * 9 + F.lane) * 16 + e]); rb[e] = F.in[I_RB][e]; }
        float gs[4];
#pragma unroll
        for (int g = 0; g < 4; ++g) { const float a = sc[4 * g] + rb[4 * g], bq = sc[4 * g + 1] + rb[4 * g + 1], c = sc[4 * g + 2] + rb[4 * g + 2], d = sc[4 * g + 3] + rb[4 * g + 3];
            const float hi1 = fmaxf(a, bq), lo1 = fminf(a, bq), hi2 = fmaxf(c, d), lo2 = fminf(c, d); gs[g] = fmaxf(hi1, hi2) + fmaxf(fminf(hi1, hi2), fmaxf(lo1, lo2)); }
        int gi = 0; float gv = gs[0]; if (gs[1] > gv) { gv = gs[1]; gi = 1; } if (gs[2] > gv) { gv = gs[2]; gi = 2; } if (gs[3] > gv) { gv = gs[3]; gi = 3; }
        const float u0 = sel4(gi, sc[0], sc[4], sc[8], sc[12]), u1 = sel4(gi, sc[1], sc[5], sc[9], sc[13]), u2 = sel4(gi, sc[2], sc[6], sc[10], sc[14]), u3 = sel4(gi, sc[3], sc[7], sc[11], sc[15]);
        const float b0 = sel4(gi, rb[0], rb[4], rb[8], rb[12]), b1 = sel4(gi, rb[1], rb[5], rb[9], rb[13]), b2 = sel4(gi, rb[2], rb[6], rb[10], rb[14]), b3 = sel4(gi, rb[3], rb[7], rb[11], rb[15]);
        int i1, i2; top2of4(u0 + b0, u1 + b1, u2 + b2, u3 + b3, i1, i2);
        const float s1 = sel4(i1, u0, u1, u2, u3), s2v = sel4(i2, u0, u1, u2, u3), inv = 1.0f / (s1 + s2v);
        e1 = gi * 4 + i1; e2 = gi * 4 + i2; w1 = s1 * inv; w2 = s2v * inv;
        k1 = __hip_atomic_fetch_add(hist + e1, 1, __ATOMIC_RELAXED, __HIP_MEMORY_SCOPE_WORKGROUP); k2 = __hip_atomic_fetch_add(hist + e2, 1, __ATOMIC_RELAXED, __HIP_MEMORY_SCOPE_WORKGROUP); }
    __syncthreads();
    if (F.tid < 16) gbase[F.tid] = (int)__hip_atomic_fetch_add((gu32*)(F.ws + WS_CTL) + CW_GCNT + 64 * l + F.tid, (unsigned)hist[F.tid], RLX_AGENT);
    __syncthreads();
    if (valid) { const int g1 = gbase[e1] + k1, g2 = gbase[e2] + k2;
        int* rt = (int*)(F.ws + WS_ROUTE) + 8 * rl; rt[0] = e1; rt[1] = e2; rt[2] = g1; rt[3] = g2; rt[4] = __float_as_int(w1); rt[5] = __float_as_int(w2);
        int* RT = (int*)(F.ws + WS_XP); RT[(size_t)e1 * ROWCAP + g1] = rl; RT[(size_t)e2 * ROWCAP + g2] = rl; }
}
__device__ __forceinline__ unsigned char* opq_ptr(unsigned char* p) { GAS unsigned char* g = (GAS unsigned char*)p; asm volatile("" : "+s"(g)); return (unsigned char*)g; }
#define FRESH_FR(Fq) Fr Fq = F; Fq.ws = opq_ptr(F.ws); { int t_; asm volatile("v_mbcnt_lo_u32_b32 %0, -1, 0\n\tv_mbcnt_hi_u32_b32 %0, -1, %0" : "=v"(t_)); Fq.lane = t_; Fq.tid = t_ + F.wave * 64; }
constexpr int CVQ1 = 2592;
__device__ __forceinline__ void cvt_fill(const Fr& F, int l, unsigned char* wb, int i0, int i1, int first_idle) {
    int j = F.blk - first_idle, n = F.G - first_idle; if (n <= 0) { j = F.blk; n = F.G; }
    if (j >= 0) cvt_range(F, l, wb, i0 + j * NWAVES + F.wave, n * NWAVES, i1);
}
constexpr int NPH = 11;
constexpr int PH_END = 1 + DEPTH * NPH + 1;
struct Args { const float* in[25]; float* out; unsigned char* ws; int ph_lo, ph_hi; };
__global__ void __launch_bounds__(NWAVES * 64, 2) fwd(Args args) {
    extern __shared__ __attribute__((aligned(16))) unsigned char lds_raw[];
    Fr F;
    F.lds = (LAS unsigned char*)lds_raw;
    F.tid = threadIdx.x; F.lane = F.tid & 63; F.wave = __builtin_amdgcn_readfirstlane(F.tid >> 6);
    F.G = gridDim.x; F.blk = blockIdx.x; F.gw = F.blk * NWAVES + F.wave; F.NGW = F.G * NWAVES;
#pragma unroll
    for (int i = 0; i < 25; ++i) F.in[i] = args.in[i];
    F.out = args.out; F.ws = args.ws;
    volatile LAS unsigned* MISC = (volatile LAS unsigned*)(F.lds + MISC_OFF);
    if (F.tid < 32) MISC[F.tid] = 0u;
    __syncthreads();
#if MK_PER_PHASE
#define GRID_BAR() do { } while (0)
#else
    XcdBarrier bar = xcd_barrier_post((unsigned*)(F.ws + WS_CTL) + CW_BAR, MISC + 8);
#define GRID_BAR() xcd_barrier(bar)
#endif
    const int lo = args.ph_lo, hi = args.ph_hi;
#ifndef DBG_PH
#define DBG_PH -1
#endif
#define IN(k) (lo <= (k) && (k) < hi)
#define ON(k) (DBG_PH < 0 || DBG_PH == (k))
    const int opq = (int)(gridDim.x >> 20);
#define IN2(k) (lo <= (k) && (k) < hi + opq)
#define IN3(k) (lo <= (k) + opq && (k) < hi)
    LAS unsigned char* ring = F.lds;
#define PHASE_WS() Fr Fp = F; Fp.ws = opq_ptr(F.ws); { int t_; asm volatile("v_mbcnt_lo_u32_b32 %0, -1, 0\n\tv_mbcnt_hi_u32_b32 %0, -1, %0" : "=v"(t_)); t_ += F.wave * 64; int b_ = F.blk; asm volatile("" : "+s"(b_)); Fp.tid = t_; Fp.lane = t_ & 63; Fp.wave = __builtin_amdgcn_readfirstlane(t_ >> 6); Fp.blk = b_; Fp.gw = b_ * NWAVES + Fp.wave; } unsigned char* ws = Fp.ws; (void)ws

    if (ON(100) && IN(0)) { p0_setup(F); GRID_BAR(); }

    for (int l = 0; l < DEPTH; ++l) {
        const int pb = 1 + l * NPH; const int lastl = (l == DEPTH - 1) ? 1 : 0;
        const size_t wbo = (l & 1) ? WS_W2 : WS_W, wbn = (l & 1) ? WS_W : WS_W2;
        if (ON(0) && IN(pb + 0)) { PHASE_WS(); if (l == 0) { cvt_range(Fp, 0, Fp.ws + wbo, CVQ1 + Fp.gw, F.NGW, CV_GU); cvt_range(Fp, 0, Fp.ws + wbo, CV_GU + CV_DN + Fp.gw, F.NGW, CV_T64); } cvt_uq(Fp, l, Fp.ws + wbo); if (l == 0) row_phase_a<0>(Fp, l); else row_phase_a<1>(Fp, l); GRID_BAR(); }
        if (ON(1) && IN(pb + 1)) { PHASE_WS(); pg8::Gemm g{(const bf16_t*)(ws + WS_H), (const bf16_t*)(ws + wbo + W_IN), M, INP, 1024}; pg8::StaticOrder S; S.init(M, INP, F.G, Fp.blk);
            pg8::EpiStore E{(bf16_t*)(ws + WS_P), INP};
            pg8::gemm_phase<pg8::EpiStore, pg8::StaticOrder, true, true>(ring, g, S, E, Fp.tid);
            { FRESH_FR(Fq); const int nwg = (M / 256) * (INP / 256), R = (nwg + F.G - 1) / F.G, fi = nwg % F.G ? nwg - (R - 1) * F.G : F.G;
              if (l + 1 < DEPTH) { int j = Fq.blk - fi, n = F.G - fi; if (n <= 0) { j = Fq.blk; n = F.G; } if (j >= 0) mod_items(Fq, l + 1, j, n); }
              cvt_fill(Fq, l, Fq.ws + wbo, 0, CVQ1, fi); }
            GRID_BAR(); }
        if (ON(2) && IN(pb + 2)) { PHASE_WS(); { int slot = 0; for (int it = Fp.blk; it < hg::NITEM; it += F.G, ++slot) hg::scan_dir<0>(Fp, l, it >> 7, (it >> 5) & 3, (it >> 4) & 1, it & 15, -1, 0, 0, nullptr); (void)slot; } mla_prep(Fp, l, Fp.gw, F.NGW); GRID_BAR(); }
        if (ON(3) && IN(pb + 3)) { PHASE_WS(); hg::scan_pass2(Fp); }
        if (ON(3) && IN2(pb + 3)) { PHASE_WS();
            { pg8::Gemm g{(const bf16_t*)(ws + WS_DQN), (const bf16_t*)(ws + wbo + W_UQ), M, 768, 384}; pg8::StaticOrder S; S.init(M, 768, F.G, (Fp.blk + F.G - 52) % F.G, lastl);
              pg8::EpiQ E{(bf16_t*)(ws + WS_Q), (const float*)(ws + WS_ROPE)};
              pg8::gemm_phase<pg8::EpiQ, pg8::StaticOrder, true, true>(ring, g, S, E, Fp.tid); } }
        if (ON(3) && IN3(pb + 3)) { PHASE_WS();
            { pg8::Gemm g{(const bf16_t*)(ws + WS_DKVN), (const bf16_t*)(ws + wbo + W_UKV), M, 1024, 256}; pg8::StaticOrder S; S.init(M, 1024, F.G, Fp.blk);
              pg8::EpiKV E{(bf16_t*)(ws + WS_K), (bf16_t*)(ws + WS_V)};
              pg8::gemm_phase<pg8::EpiKV, pg8::StaticOrder, true, true>(ring, g, S, E, Fp.tid); }
            GRID_BAR(); }
        if (ON(4) && IN2(pb + 4)) { PHASE_WS(); for (int it = Fp.blk; it < 256; it += F.G) { const int b_ = it >> 6, h_ = (it >> 4) & 3, k_ = it & 15; hg::scan_dir<1>(Fp, l, b_, h_, 0, k_, -1, 0, 0, nullptr); hg::scan_dir<2>(Fp, l, b_, h_, 1, k_ ? 16 - k_ : 0, -1, 0, 0, nullptr); } }
        if (ON(4) && IN(pb + 4)) { PHASE_WS(); const int nu = 512 + (l < DEPTH - 1 ? 32 : 0);
            const bf16_t* Qg = (const bf16_t*)(ws + WS_Q); const bf16_t* Kg = (const bf16_t*)(ws + WS_K); const bf16_t* Vg = (const bf16_t*)(ws + WS_V); bf16_t* MO = (bf16_t*)(ws + WS_MO);
            for (int u = Fp.blk; u < nu; u += F.G) {
                const int bh = u < 512 ? (u >> 4) : (u - 512), t0 = u < 512 ? CTX + (u & 15) * 256 : 0, seq = u < 512 ? TPB : CTX, b = bh >> 3, h = bh & 7;
                int tq_; asm volatile("v_mbcnt_lo_u32_b32 %0, -1, 0\n\tv_mbcnt_hi_u32_b32 %0, -1, %0" : "=v"(tq_)); tq_ += Fp.wave * 64;
                if (false) { CvHook hk{Fp, l + 1, Fp.ws + wbn}; att::attn_unit(Qg + ((size_t)bh * TPB + t0) * 96, Kg + (size_t)bh * TPB * 96, Vg + (size_t)bh * TPB * 64, MO + ((size_t)b * TPB + t0) * 512 + h * 64, 512, seq, (LAS char*)ring, tq_, hk); }
                else { att::NoHook hk; att::attn_unit_pp(Qg + ((size_t)bh * TPB + t0) * 96, Kg + (size_t)bh * TPB * 96, Vg + (size_t)bh * TPB * 64, MO + ((size_t)b * TPB + t0) * 512 + h * 64, 512, seq, (LAS char*)ring, tq_, hk); } }
            GRID_BAR(); }
        if (ON(6) && IN(pb + 6)) { PHASE_WS();
            { pg8::Gemm g{(const bf16_t*)(ws + WS_A), (const bf16_t*)(ws + wbo + W_PA), M, 1024, 512}; pg8::StaticOrder S; S.init(M, 1024, F.G, Fp.blk, lastl);
              pg8::EpiMerge<false> E{(const bf16_t*)(ws + WS_P), C_GA, (bf16_t*)(ws + WS_MIX)};
              pg8::gemm_phase<pg8::EpiMerge<false>, pg8::StaticOrder, true, true>(ring, g, S, E, Fp.tid); } }
        if (ON(6) && IN2(pb + 6)) { PHASE_WS();
            { pg8::Gemm g{(const bf16_t*)(ws + WS_MO), (const bf16_t*)(ws + wbo + W_PB), M, 1024, 512}; pg8::StaticOrder S; S.init(M, 1024, F.G, Fp.blk, lastl);
              pg8::EpiMerge<true> E{(const bf16_t*)(ws + WS_P), C_GB, (bf16_t*)(ws + WS_MIX)};
              pg8::gemm_phase<pg8::EpiMerge<true>, pg8::StaticOrder, true, true>(ring, g, S, E, Fp.tid); }
            GRID_BAR(); }
        if (ON(7) && IN(pb + 7)) { PHASE_WS(); pg8::Gemm g{(const bf16_t*)(ws + WS_MIX), (const bf16_t*)(ws + wbo + W_O), M, 1024, 1024}; pg8::StaticOrder S; S.init(M, 1024, F.G, Fp.blk, lastl);
            pg8::EpiWo E{(bf16_t*)(ws + WS_Z), (const float*)(ws + WS_MOD) + (size_t)l * 5 * 6144};
            pg8::gemm_phase<pg8::EpiWo, pg8::StaticOrder, true, true>(ring, g, S, E, Fp.tid); GRID_BAR(); }
        if (ON(8) && IN(pb + 8)) { PHASE_WS(); norm2_route(Fp, l, lastl); GRID_BAR(); }
        if (ON(9) && IN(pb + 9)) { PHASE_WS(); moe_tab(Fp, l); const LAS int* tab = (const LAS int*)(Fp.lds + MOETAB_OFF); const int ntile = tab[48];
            pg8::Gemm g{(const bf16_t*)(ws + WS_H), (const bf16_t*)(ws + wbo + W_GU), XROWS, 1024, 1024}; pg8::MoeGatherOrder S{ntile * 4, F.G, Fp.blk, tab, (const int*)(ws + WS_XP), ROWCAP};
            pg8::EpiGU E{(bf16_t*)(ws + WS_HID)};
            pg8::gemm_phase<pg8::EpiGU, pg8::MoeGatherOrder, true, true>(ring, g, S, E, Fp.tid);
            { FRESH_FR(Fq); cvt_fill(Fq, l, Fq.ws + wbo, CV_GU, CV_GU + CV_DN, F.G / 2); if (l + 1 < DEPTH) cvt_fill(Fq, l + 1, Fq.ws + wbn, CVQ1, CV_GU, F.G / 2); }
            GRID_BAR(); }
        if (ON(10) && IN(pb + 10)) { PHASE_WS(); moe_tab(Fp, l); const LAS int* tab = (const LAS int*)(Fp.lds + MOETAB_OFF); const int ntile = tab[48];
            pg8::Gemm g{(const bf16_t*)(ws + WS_HID), (const bf16_t*)(ws + wbo + W_DN), XROWS, 1024, 512}; pg8::MoeOrder S{ntile * 4, F.G, Fp.blk, tab};
            pg8::EpiStore E{(bf16_t*)(ws + WS_Y), 1024};
            pg8::gemm_phase<pg8::EpiStore, pg8::MoeOrder, true, true>(ring, g, S, E, Fp.tid);
            if (l + 1 < DEPTH) { FRESH_FR(Fq); cvt_fill(Fq, l + 1, Fq.ws + wbn, CV_GU + CV_DN, CV_T64, F.G / 2); }
            GRID_BAR(); }
    }
    if (ON(101) && IN(PH_END - 1)) { PHASE_WS(); row_phase_a<2>(Fp, DEPTH); }
#undef IN
#undef IN2
#undef IN3
#undef ON
}

extern "C" void kernel_launch(void* const* d_in, const int* in_sizes, int n_in, void* d_out, int out_size, void* d_ws, size_t ws_size, hipStream_t stream) {
    static int grid = 0;
    if (grid == 0) {
        if (n_in != 25 || out_size != NB * SEQ * D || ws_size < WS_END) { fprintf(stderr, "kernel_launch: unexpected shapes: n_in %d out %d ws %zu (need %zu)\n", n_in, out_size, ws_size, (size_t)WS_END); grid = -1; return; }
        int dev = 0, cus = 0;
        if (hipGetDevice(&dev) != hipSuccess || hipDeviceGetAttribute(&cus, hipDeviceAttributeMultiprocessorCount, dev) != hipSuccess) { grid = -1; return; }
        if (hipFuncSetAttribute((const void*)fwd, hipFuncAttributeMaxDynamicSharedMemorySize, LDS_BYTES) != hipSuccess) { fprintf(stderr, "kernel_launch: hipFuncSetAttribute failed\n"); grid = -1; return; }
        int per_cu = 0;
        if (hipOccupancyMaxActiveBlocksPerMultiprocessor(&per_cu, (const void*)fwd, NWAVES * 64, LDS_BYTES) != hipSuccess || per_cu < 1) fprintf(stderr, "kernel_launch: occupancy query says %d\n", per_cu);
        (void)hipGetLastError();
        grid = cus > 256 ? 256 : cus;
    }
    if (grid < 0) return;
    if (hipMemsetAsync((char*)d_ws + WS_CTL, 0, CTL_ZERO_BYTES, stream) != hipSuccess) return;
    Args a{};
    for (int i = 0; i < 25; ++i) a.in[i] = (const float*)d_in[i];
    a.out = (float*)d_out; a.ws = (unsigned char*)d_ws;
#if MK_PER_PHASE
    for (int p = 0; p < PH_END; ++p) { a.ph_lo = p; a.ph_hi = p + 1; hipLaunchKernelGGL(fwd, dim3(grid), dim3(NWAVES * 64), LDS_BYTES, stream, a); }
#else
    a.ph_lo = 0; a.ph_hi = PH_END; hipLaunchKernelGGL(fwd, dim3(grid), dim3(NWAVES * 64), LDS_BYTES, stream, a);
#endif
    const hipError_t le = hipPeekAtLastError();
    if (le != hipSuccess) fprintf(stderr, "kernel_launch: launch failed: %s\n", hipGetErrorName(le));
}
```
